# Optimizing an MI355X kernel written in HIP

```python
import math
import jax, jax.numpy as jnp
from jax import lax
import numpy as np

D_MODEL = 1024
BATCH = 16
SEQ = 4096
DEPTH = 1

D_MIX = D_MODEL
D_SSM = D_MIX // 2
D_FNO = D_MIX - D_SSM
SSM_GROUP = 16
N_SSM_GROUPS = D_SSM // SSM_GROUP
SSM_STATE = 64
N_FOURIER_GROUPS = 4
FOURIER_GROUP = D_FNO // N_FOURIER_GROUPS
DT_MIN = 1e-3
DT_MAX = 1e-1
PEER_HEADS = 8
PEER_NKEYS = 128
PEER_EXPERTS = PEER_NKEYS * PEER_NKEYS
PEER_TOPK = 16
PEER_QDIM = 256
PEER_HALF = PEER_QDIM // 2
PEER_BLOCK = 128
RMS_EPS = 1e-6

kernel_name = "hybrid_s5_fnet_peer_encoder_block"


def rmsnorm(x, g):
    xf = x.astype(jnp.float32)
    y = xf * lax.rsqrt(jnp.mean(xf * xf, axis=-1, keepdims=True) + RMS_EPS)
    return (y * g.astype(jnp.float32)).astype(x.dtype)


def _ssm_combine(e_i, e_j):
    a_i, b_i = e_i
    a_j, b_j = e_j
    return a_j * a_i, a_j * b_i + b_j


def s5_scan(u, a_re, a_im, log_step, b_re, b_im, c_re, c_im, reverse):
    f32 = jnp.float32
    lam = lax.complex(a_re.astype(f32), a_im.astype(f32))
    step = jnp.exp(log_step.astype(f32))[:, None]
    lam_bar = jnp.exp(lam * step)
    b = lax.complex(b_re.astype(f32), b_im.astype(f32))
    b_bar = ((lam_bar - 1.0) / lam)[..., None] * b
    c = lax.complex(c_re.astype(f32), c_im.astype(f32))
    bu = jnp.einsum("gpc,bsgc->bsgp", b_bar, u.astype(jnp.complex64))
    a = jnp.broadcast_to(lam_bar, (1, u.shape[1]) + lam_bar.shape)
    _, states = lax.associative_scan(_ssm_combine, (a, bu), axis=1, reverse=reverse)
    return jnp.einsum("gcp,bsgp->bsgc", c, states).real


def token_mixer(h, w_in, ssm_a_re, ssm_a_im, ssm_log_step, ssm_b_re, ssm_b_im,
                ssm_c_re, ssm_c_im, ssm_d, w_glu, w_fourier, w_out):
    bsz, seq, _ = h.shape
    f32 = jnp.float32
    z = h @ w_in
    u = z[..., :D_SSM].astype(f32).reshape(bsz, seq, N_SSM_GROUPS, SSM_GROUP)
    y = (s5_scan(u, ssm_a_re[0], ssm_a_im[0], ssm_log_step[0], ssm_b_re[0], ssm_b_im[0],
                 ssm_c_re[0], ssm_c_im[0], reverse=False)
         + s5_scan(u, ssm_a_re[1], ssm_a_im[1], ssm_log_step[1], ssm_b_re[1], ssm_b_im[1],
                   ssm_c_re[1], ssm_c_im[1], reverse=True)
         + ssm_d.astype(f32) * u)
    y = jax.nn.gelu(y.reshape(bsz, seq, D_SSM), approximate=False)
    y_ssm = (y * jax.nn.sigmoid(y @ w_glu.astype(f32))).astype(h.dtype)
    f = z[..., D_SSM:].astype(f32).reshape(bsz, seq, N_FOURIER_GROUPS, FOURIER_GROUP)
    f = jnp.fft.fft2(f, axes=(1, 3), norm="ortho").real.astype(h.dtype)
    y_fno = jnp.einsum("bsgc,gcd->bsgd", f, w_fourier).reshape(bsz, seq, D_FNO)
    return jnp.concatenate([y_ssm, y_fno], axis=-1) @ w_out


def peer_ffn(h, w_query, sub_keys, expert_u, expert_v):
    bsz, seq, d = h.shape
    tokens = h.reshape(-1, PEER_BLOCK, d)

    def block(xb):
        t = xb.shape[0]
        q = (xb @ w_query).reshape(t, PEER_HEADS, 2, PEER_HALF)
        scores = jnp.einsum("thpd,hpkd->thpk", q, sub_keys).astype(jnp.float32)
        s_val, s_idx = lax.top_k(scores, PEER_TOPK)
        cand = s_val[:, :, 0, :, None] + s_val[:, :, 1, None, :]
        cand_idx = s_idx[:, :, 0, :, None] * PEER_NKEYS + s_idx[:, :, 1, None, :]
        n_cand = PEER_TOPK * PEER_TOPK
        top_val, top_pos = lax.top_k(cand.reshape(t, PEER_HEADS, n_cand), PEER_TOPK)
        expert_idx = jnp.take_along_axis(cand_idx.reshape(t, PEER_HEADS, n_cand), top_pos, axis=-1)
        gate = jax.nn.softmax(top_val, axis=-1)
        u_sel = expert_u[expert_idx]
        v_sel = expert_v[expert_idx]
        pre = jnp.einsum("thkd,td->thk", u_sel, xb).astype(jnp.float32)
        act = (jax.nn.gelu(pre, approximate=False) * gate).astype(xb.dtype)
        return jnp.einsum("thk,thkd->td", act, v_sel)

    return lax.map(block, tokens).reshape(bsz, seq, d)


def setup_inputs(seed: int = 0) -> dict:
    key = jax.random.key(seed)
    ks = jax.random.split(key, 20)
    nrm = jax.random.normal
    G, P, Cg = N_SSM_GROUPS, SSM_STATE, SSM_GROUP
    n_idx = jnp.arange(P, dtype=jnp.float32)
    x = nrm(ks[0], (BATCH, SEQ, D_MODEL), jnp.float32)
    norm1_g = 1.0 + 0.02 * nrm(ks[1], (DEPTH, D_MODEL), jnp.float32)
    w_in = nrm(ks[2], (DEPTH, D_MODEL, D_MIX), jnp.float32) * D_MODEL ** -0.5
    ssm_a_re = -0.5 + 0.01 * nrm(ks[3], (DEPTH, 2, G, P), jnp.float32)
    ssm_a_im = math.pi * n_idx + 0.01 * nrm(ks[4], (DEPTH, 2, G, P), jnp.float32)
    ssm_log_step = jax.random.uniform(ks[5], (DEPTH, 2, G), jnp.float32,
                                      math.log(DT_MIN), math.log(DT_MAX))
    b_scale = (2.0 * Cg) ** -0.5
    ssm_b_re = nrm(ks[6], (DEPTH, 2, G, P, Cg), jnp.float32) * b_scale
    ssm_b_im = nrm(ks[7], (DEPTH, 2, G, P, Cg), jnp.float32) * b_scale
    c_scale = P ** -0.5
    ssm_c_re = nrm(ks[8], (DEPTH, 2, G, Cg, P), jnp.float32) * c_scale
    ssm_c_im = nrm(ks[9], (DEPTH, 2, G, Cg, P), jnp.float32) * c_scale
    ssm_d = nrm(ks[10], (DEPTH, G, Cg), jnp.float32)
    w_glu = nrm(ks[11], (DEPTH, D_SSM, D_SSM), jnp.float32) * D_SSM ** -0.5
    w_fourier = nrm(ks[12], (DEPTH, N_FOURIER_GROUPS, FOURIER_GROUP, FOURIER_GROUP),
                    jnp.float32) * FOURIER_GROUP ** -0.5
    w_out = nrm(ks[13], (DEPTH, D_MIX, D_MODEL), jnp.float32) * D_MIX ** -0.5
    norm2_g = 1.0 + 0.02 * nrm(ks[14], (DEPTH, D_MODEL), jnp.float32)
    w_query = nrm(ks[15], (DEPTH, D_MODEL, PEER_HEADS * PEER_QDIM), jnp.float32) * D_MODEL ** -0.5
    sub_keys = nrm(ks[16], (DEPTH, PEER_HEADS, 2, PEER_NKEYS, PEER_HALF), jnp.float32) * PEER_HALF ** -0.5
    expert_u = nrm(ks[17], (DEPTH, PEER_EXPERTS, D_MODEL), jnp.float32) * D_MODEL ** -0.5
    expert_v = nrm(ks[18], (DEPTH, PEER_EXPERTS, D_MODEL), jnp.float32) * PEER_HEADS ** -0.5
    final_g = 1.0 + 0.02 * nrm(ks[19], (D_MODEL,), jnp.float32)
    return {"x": x, "norm1_g": norm1_g, "w_in": w_in, "ssm_a_re": ssm_a_re,
            "ssm_a_im": ssm_a_im, "ssm_log_step": ssm_log_step, "ssm_b_re": ssm_b_re,
            "ssm_b_im": ssm_b_im, "ssm_c_re": ssm_c_re, "ssm_c_im": ssm_c_im,
            "ssm_d": ssm_d, "w_glu": w_glu, "w_fourier": w_fourier, "w_out": w_out,
            "norm2_g": norm2_g, "w_query": w_query, "sub_keys": sub_keys,
            "expert_u": expert_u, "expert_v": expert_v, "final_g": final_g}


def reference(x, norm1_g, w_in, ssm_a_re, ssm_a_im, ssm_log_step, ssm_b_re, ssm_b_im,
              ssm_c_re, ssm_c_im, ssm_d, w_glu, w_fourier, w_out, norm2_g, w_query,
              sub_keys, expert_u, expert_v, final_g):
    for layer in range(DEPTH):
        h = rmsnorm(x, norm1_g[layer])
        x = x + token_mixer(h, w_in[layer], ssm_a_re[layer], ssm_a_im[layer],
                            ssm_log_step[layer], ssm_b_re[layer], ssm_b_im[layer],
                            ssm_c_re[layer], ssm_c_im[layer], ssm_d[layer], w_glu[layer],
                            w_fourier[layer], w_out[layer])
        h = rmsnorm(x, norm2_g[layer])
        x = x + peer_ffn(h, w_query[layer], sub_keys[layer], expert_u[layer], expert_v[layer])
    return rmsnorm(x, final_g)
```

```cpp
#include <hip/hip_runtime.h>
#include <stdint.h>
#include <string.h>

#define NTOK 65536
#define DM 1024
#define SEQ 4096
#define NB 16

__device__ __forceinline__ void dsincos(double x, double* s, double* c) {
  double q = rint(x * 0.63661977236758134308);
  double r = fma(-q, 1.57079632679489655800, x);
  r = fma(-q, 6.12323399573676603587e-17, r);
  double r2 = r * r;
  double sp = r * (1.0 + r2 * (-1.0 / 6 + r2 * (1.0 / 120 + r2 * (-1.0 / 5040 + r2 * (1.0 / 362880 + r2 * (-1.0 / 39916800 + r2 * (1.0 / 6227020800.0 + r2 * (-1.0 / 1307674368000.0))))))));
  double cp = 1.0 + r2 * (-0.5 + r2 * (1.0 / 24 + r2 * (-1.0 / 720 + r2 * (1.0 / 40320 + r2 * (-1.0 / 3628800 + r2 * (1.0 / 479001600.0 + r2 * (-1.0 / 87178291200.0)))))));
  long long qi = (long long)q;
  int m = (int)(qi & 3);
  double ss = (m == 0) ? sp : (m == 1) ? cp : (m == 2) ? -sp : -cp;
  double cc = (m == 0) ? cp : (m == 1) ? -sp : (m == 2) ? -cp : sp;
  *s = ss; *c = cc;
}

__device__ __forceinline__ float gelu_exact(float x) { return 0.5f * x * (1.0f + erff(x * 0.70710678118654752440f)); }

__global__ void __launch_bounds__(256) k_rinv(const float* __restrict__ x, float* __restrict__ rinv, int nrows) {
  int row = blockIdx.x * 4 + (threadIdx.x >> 6);
  int lane = threadIdx.x & 63;
  if (row >= nrows) return;
  const float4* p = (const float4*)(x + (size_t)row * DM);
  float s = 0.f;
  for (int i = lane; i < DM / 4; i += 64) { float4 v = p[i]; s += v.x * v.x + v.y * v.y + v.z * v.z + v.w * v.w; }
  for (int m = 32; m >= 1; m >>= 1) s += __shfl_xor(s, m, 64);
  if (lane == 0) rinv[row] = rsqrtf(s * (1.0f / DM) + 1e-6f);
}

struct GemmP {
  const float* A; const float* B; float* C;
  const float* rs; const float* ks;
  long long sA, sB, sC;
  int lda, ldb, ldc, M, N, K, transB;
  float alpha, beta;
};

__global__ void __launch_bounds__(256) k_gemm(GemmP p) {
  __shared__ float As[16][132];
  __shared__ float Bs[16][132];
  const int tid = threadIdx.x;
  const int bz = blockIdx.z;
  const float* A = p.A + (size_t)bz * p.sA;
  const float* B = p.B + (size_t)bz * p.sB;
  float* C = p.C + (size_t)bz * p.sC;
  const int m0 = blockIdx.y * 128, n0 = blockIdx.x * 128;
  const int ty = tid >> 4, tx = tid & 15;
  float acc[8][8];
#pragma unroll
  for (int i = 0; i < 8; ++i)
#pragma unroll
    for (int j = 0; j < 8; ++j) acc[i][j] = 0.f;
  for (int k0 = 0; k0 < p.K; k0 += 16) {
#pragma unroll
    for (int it = 0; it < 2; ++it) {
      int idx = tid + it * 256;
      int r = idx >> 2, kq = (idx & 3) * 4;
      float4 v = *(const float4*)(A + (size_t)(m0 + r) * p.lda + k0 + kq);
      float rsv = p.rs ? p.rs[m0 + r] : 1.0f;
      float k0s = 1.f, k1s = 1.f, k2s = 1.f, k3s = 1.f;
      if (p.ks) { k0s = p.ks[k0 + kq]; k1s = p.ks[k0 + kq + 1]; k2s = p.ks[k0 + kq + 2]; k3s = p.ks[k0 + kq + 3]; }
      As[kq + 0][r] = v.x * rsv * k0s; As[kq + 1][r] = v.y * rsv * k1s; As[kq + 2][r] = v.z * rsv * k2s; As[kq + 3][r] = v.w * rsv * k3s;
    }
    if (!p.transB) {
#pragma unroll
      for (int it = 0; it < 2; ++it) {
        int idx = tid + it * 256;
        int kk = idx >> 5, nq = (idx & 31) * 4;
        float4 v = *(const float4*)(B + (size_t)(k0 + kk) * p.ldb + n0 + nq);
        Bs[kk][nq + 0] = v.x; Bs[kk][nq + 1] = v.y; Bs[kk][nq + 2] = v.z; Bs[kk][nq + 3] = v.w;
      }
    } else {
#pragma unroll
      for (int it = 0; it < 2; ++it) {
        int idx = tid + it * 256;
        int n = idx >> 2, kq = (idx & 3) * 4;
        float4 v = *(const float4*)(B + (size_t)(n0 + n) * p.ldb + k0 + kq);
        Bs[kq + 0][n] = v.x; Bs[kq + 1][n] = v.y; Bs[kq + 2][n] = v.z; Bs[kq + 3][n] = v.w;
      }
    }
    __syncthreads();
#pragma unroll
    for (int kk = 0; kk < 16; ++kk) {
      float a[8], b[8];
#pragma unroll
      for (int i = 0; i < 8; ++i) a[i] = As[kk][ty * 8 + i];
#pragma unroll
      for (int j = 0; j < 8; ++j) b[j] = Bs[kk][tx * 8 + j];
#pragma unroll
      for (int i = 0; i < 8; ++i)
#pragma unroll
        for (int j = 0; j < 8; ++j) acc[i][j] = fmaf(a[i], b[j], acc[i][j]);
    }
    __syncthreads();
  }
#pragma unroll
  for (int i = 0; i < 8; ++i) {
    float* cp = C + (size_t)(m0 + ty * 8 + i) * p.ldc + n0 + tx * 8;
#pragma unroll
    for (int j = 0; j < 8; ++j) {
      float v = p.alpha * acc[i][j];
      if (p.beta != 0.f) v += p.beta * cp[j];
      cp[j] = v;
    }
  }
}

static void gemm(hipStream_t st, const float* A, int lda, long long sA, const float* B, int ldb, long long sB, int transB,
                 float* C, int ldc, long long sC, int M, int N, int K, int batch, float alpha, float beta,
                 const float* rs, const float* ks) {
  GemmP p;
  memset(&p, 0, sizeof(p));
  p.A = A; p.B = B; p.C = C; p.rs = rs; p.ks = ks; p.sA = sA; p.sB = sB; p.sC = sC;
  p.lda = lda; p.ldb = ldb; p.ldc = ldc; p.M = M; p.N = N; p.K = K; p.transB = transB; p.alpha = alpha; p.beta = beta;
  dim3 grid(N / 128, M / 128, batch);
  hipLaunchKernelGGL(k_gemm, grid, dim3(256), 0, st, p);
}

__global__ void k_dft_table(float* cs, float* sn, int n) {
  size_t i = (size_t)blockIdx.x * blockDim.x + threadIdx.x;
  if (i >= (size_t)n * n) return;
  int k = (int)(i / n), s = (int)(i % n);
  int m = (int)(((long long)k * s) % n);
  double sv, cv;
  dsincos(6.283185307179586476925 * (double)m / (double)n, &sv, &cv);
  cs[i] = (float)cv; sn[i] = (float)sv;
}

__global__ void __launch_bounds__(64) k_s5(const float* __restrict__ z, const float* __restrict__ a_re, const float* __restrict__ a_im,
                                          const float* __restrict__ log_step, const float* __restrict__ b_re, const float* __restrict__ b_im,
                                          const float* __restrict__ c_re, const float* __restrict__ c_im, float* __restrict__ yout) {
  const int p = threadIdx.x;
  const int bid = blockIdx.x;
  const int dir = bid & 1, g = (bid >> 1) & 31, b = bid >> 6;
  const int gi = dir * 32 + g;
  double are = a_re[gi * 64 + p], aim = a_im[gi * 64 + p];
  double step = exp((double)log_step[gi]);
  double sn_, cs_;
  dsincos(aim * step, &sn_, &cs_);
  double mag = exp(are * step);
  double lr = mag * cs_, li = mag * sn_;
  double nr = lr - 1.0, ni = li;
  double den = are * are + aim * aim;
  double fr = (nr * are + ni * aim) / den, fi = (ni * are - nr * aim) / den;
  float bbr[16], bbi[16], cr[16], ci[16];
#pragma unroll
  for (int c = 0; c < 16; ++c) {
    double br = b_re[((size_t)gi * 64 + p) * 16 + c], bi = b_im[((size_t)gi * 64 + p) * 16 + c];
    bbr[c] = (float)(fr * br - fi * bi);
    bbi[c] = (float)(fr * bi + fi * br);
    cr[c] = c_re[((size_t)gi * 16 + c) * 64 + p];
    ci[c] = c_im[((size_t)gi * 16 + c) * 64 + p];
  }
  const float lrf = (float)lr, lif = (float)li;
  float xr = 0.f, xi = 0.f;
  float* yo = yout + (size_t)dir * NTOK * 512;
  for (int q = 0; q < SEQ; ++q) {
    int t = dir ? (SEQ - 1 - q) : q;
    size_t tok = (size_t)b * SEQ + t;
    const float4* up = (const float4*)(z + tok * DM + g * 16);
    float u[16];
#pragma unroll
    for (int i = 0; i < 4; ++i) { float4 v = up[i]; u[4 * i] = v.x; u[4 * i + 1] = v.y; u[4 * i + 2] = v.z; u[4 * i + 3] = v.w; }
    float br = 0.f, bi = 0.f;
#pragma unroll
    for (int c = 0; c < 16; ++c) { br = fmaf(bbr[c], u[c], br); bi = fmaf(bbi[c], u[c], bi); }
    float nxr = lrf * xr - lif * xi + br;
    float nxi = lrf * xi + lif * xr + bi;
    xr = nxr; xi = nxi;
    float myv = 0.f;
#pragma unroll
    for (int c = 0; c < 16; ++c) {
      float v = cr[c] * xr - ci[c] * xi;
      for (int m = 32; m >= 1; m >>= 1) v += __shfl_xor(v, m, 64);
      if (p == c) myv = v;
    }
    if (p < 16) yo[tok * 512 + g * 16 + p] = myv;
  }
}

__global__ void k_ssm_post(float* __restrict__ yf, const float* __restrict__ yb, const float* __restrict__ z, const float* __restrict__ dvec) {
  size_t i = (size_t)blockIdx.x * blockDim.x + threadIdx.x;
  if (i >= (size_t)NTOK * 512) return;
  size_t tok = i >> 9; int c = (int)(i & 511);
  float v = yf[i] + yb[i] + dvec[c] * z[tok * DM + c];
  yf[i] = gelu_exact(v);
}
__global__ void k_glu(const float* __restrict__ Y, const float* __restrict__ G, float* __restrict__ cat) {
  size_t i = (size_t)blockIdx.x * blockDim.x + threadIdx.x;
  if (i >= (size_t)NTOK * 512) return;
  size_t tok = i >> 9; int c = (int)(i & 511);
  float g = G[i];
  cat[tok * DM + c] = Y[i] * (1.0f / (1.0f + expf(-g)));
}

__global__ void k_topk(const float* __restrict__ scores, float* __restrict__ sval, int* __restrict__ sidx, int nprob, int n) {
  int i = blockIdx.x * blockDim.x + threadIdx.x;
  if (i >= nprob) return;
  const float* s = scores + (size_t)i * n;
  unsigned long long t0 = 0ull, t1 = 0ull, t2 = 0ull, t3 = 0ull;
  for (int r = 0; r < 16; ++r) {
    float best = -3.0e38f; int bi = -1;
    for (int k = 0; k < n; ++k) {
      int w = k >> 6;
      unsigned long long tw = (w == 0) ? t0 : (w == 1) ? t1 : (w == 2) ? t2 : t3;
      bool tk = (tw >> (k & 63)) & 1ull;
      float v = s[k];
      if (!tk && (bi < 0 || v > best)) { best = v; bi = k; }
    }
    unsigned long long bit = 1ull << (bi & 63);
    int w = bi >> 6;
    if (w == 0) t0 |= bit; else if (w == 1) t1 |= bit; else if (w == 2) t2 |= bit; else t3 |= bit;
    sval[(size_t)i * 16 + r] = best; sidx[(size_t)i * 16 + r] = bi;
  }
}
__global__ void k_cand(const float* __restrict__ sval, float* __restrict__ cand, int nprob) {
  size_t t = (size_t)blockIdx.x * blockDim.x + threadIdx.x;
  if (t >= (size_t)nprob * 256) return;
  size_t i = t >> 8; int c = (int)(t & 255);
  cand[t] = sval[(i * 2 + 0) * 16 + (c >> 4)] + sval[(i * 2 + 1) * 16 + (c & 15)];
}
__global__ void k_finish(const float* __restrict__ tval, const int* __restrict__ tpos, const int* __restrict__ sidx,
                         int* __restrict__ eidx, float* __restrict__ gate, int nprob) {
  int i = blockIdx.x * blockDim.x + threadIdx.x;
  if (i >= nprob) return;
  float mx = tval[(size_t)i * 16];
  float sum = 0.f;
  for (int r = 0; r < 16; ++r) sum += expf(tval[(size_t)i * 16 + r] - mx);
  float inv = 1.0f / sum;
  for (int r = 0; r < 16; ++r) {
    int pos = tpos[(size_t)i * 16 + r];
    int e = sidx[((size_t)i * 2 + 0) * 16 + (pos >> 4)] * 128 + sidx[((size_t)i * 2 + 1) * 16 + (pos & 15)];
    eidx[(size_t)i * 16 + r] = e;
    gate[(size_t)i * 16 + r] = expf(tval[(size_t)i * 16 + r] - mx) * inv;
  }
}

__global__ void __launch_bounds__(256) k_expert(const float* __restrict__ x2, const float* __restrict__ rinv2, const float* __restrict__ g2,
                                               const int* __restrict__ eidx, const float* __restrict__ gate,
                                               const float* __restrict__ eu, const float* __restrict__ ev, const float* __restrict__ fg,
                                               float* __restrict__ out, int tok0) {
  __shared__ float red[4];
  __shared__ float bc;
  const int tl = blockIdx.x;
  const size_t tok = (size_t)tok0 + tl;
  const int tid = threadIdx.x, lane = tid & 63, w = tid >> 6;
  float4 xv = *(const float4*)(x2 + tok * DM + tid * 4);
  float4 gv = *(const float4*)(g2 + tid * 4);
  float ri = rinv2[tok];
  float4 h = make_float4(xv.x * ri * gv.x, xv.y * ri * gv.y, xv.z * ri * gv.z, xv.w * ri * gv.w);
  float4 acc = make_float4(0.f, 0.f, 0.f, 0.f);
  for (int j = 0; j < 128; ++j) {
    int e = eidx[(size_t)tl * 128 + j];
    float gt = gate[(size_t)tl * 128 + j];
    float4 uv = *(const float4*)(eu + (size_t)e * DM + tid * 4);
    float s = uv.x * h.x + uv.y * h.y + uv.z * h.z + uv.w * h.w;
    for (int m = 32; m >= 1; m >>= 1) s += __shfl_xor(s, m, 64);
    if (lane == 0) red[w] = s;
    __syncthreads();
    if (tid == 0) bc = red[0] + red[1] + red[2] + red[3];
    __syncthreads();
    float pre = bc;
    float a = gelu_exact(pre) * gt;
    float4 vv = *(const float4*)(ev + (size_t)e * DM + tid * 4);
    acc.x = fmaf(a, vv.x, acc.x); acc.y = fmaf(a, vv.y, acc.y); acc.z = fmaf(a, vv.z, acc.z); acc.w = fmaf(a, vv.w, acc.w);
  }
  float4 x3 = make_float4(xv.x + acc.x, xv.y + acc.y, xv.z + acc.z, xv.w + acc.w);
  float s = x3.x * x3.x + x3.y * x3.y + x3.z * x3.z + x3.w * x3.w;
  for (int m = 32; m >= 1; m >>= 1) s += __shfl_xor(s, m, 64);
  __syncthreads();
  if (lane == 0) red[w] = s;
  __syncthreads();
  float tot = red[0] + red[1] + red[2] + red[3];
  float r3 = rsqrtf(tot * (1.0f / DM) + 1e-6f);
  float4 fv = *(const float4*)(fg + tid * 4);
  *(float4*)(out + tok * DM + tid * 4) = make_float4(x3.x * r3 * fv.x, x3.y * r3 * fv.y, x3.z * r3 * fv.z, x3.w * r3 * fv.w);
}

__global__ void k_add(float* __restrict__ mix, const float* __restrict__ x) {
  size_t i = (size_t)blockIdx.x * blockDim.x + threadIdx.x;
  if (i >= (size_t)NTOK * DM / 4) return;
  float4 a = ((float4*)mix)[i], b = ((const float4*)x)[i];
  ((float4*)mix)[i] = make_float4(a.x + b.x, a.y + b.y, a.z + b.z, a.w + b.w);
}

extern "C" void kernel_launch(void* const* d_in, const int* in_sizes, int n_in, void* d_out, int out_size, void* d_ws, size_t ws_size,
                              hipStream_t stream) {
  const float* x = (const float*)d_in[0];
  const float* norm1_g = (const float*)d_in[1];
  const float* w_in = (const float*)d_in[2];
  const float* a_re = (const float*)d_in[3];
  const float* a_im = (const float*)d_in[4];
  const float* log_step = (const float*)d_in[5];
  const float* b_re = (const float*)d_in[6];
  const float* b_im = (const float*)d_in[7];
  const float* c_re = (const float*)d_in[8];
  const float* c_im = (const float*)d_in[9];
  const float* ssm_d = (const float*)d_in[10];
  const float* w_glu = (const float*)d_in[11];
  const float* w_fourier = (const float*)d_in[12];
  const float* w_out = (const float*)d_in[13];
  const float* norm2_g = (const float*)d_in[14];
  const float* w_query = (const float*)d_in[15];
  const float* sub_keys = (const float*)d_in[16];
  const float* expert_u = (const float*)d_in[17];
  const float* expert_v = (const float*)d_in[18];
  const float* final_g = (const float*)d_in[19];
  float* out = (float*)d_out;

  const size_t Q = (size_t)NTOK * DM;
  float* bufA = (float*)d_ws;
  float* bufB = bufA + Q;
  float* bufC = bufB + Q;
  float* bufD = bufC + Q;
  float* tab = out;
  float* cs4096 = tab;
  float* sn4096 = tab + (size_t)4096 * 4096;
  float* cs128 = tab + (size_t)2 * 4096 * 4096;
  float* sn128 = cs128 + 128 * 128;
  float* rinv = cs128 + 2 * 128 * 128;

  hipLaunchKernelGGL(k_rinv, dim3(NTOK / 4), dim3(256), 0, stream, x, rinv, NTOK);
  gemm(stream, x, DM, 0, w_in, DM, 0, 0, bufA, DM, 0, NTOK, DM, DM, 1, 1.f, 0.f, rinv, norm1_g);
  hipLaunchKernelGGL(k_s5, dim3(NB * 32 * 2), dim3(64), 0, stream, bufA, a_re, a_im, log_step, b_re, b_im, c_re, c_im, bufB);
  float* yf = bufB; float* yb = bufB + (size_t)NTOK * 512;
  hipLaunchKernelGGL(k_ssm_post, dim3((NTOK * 512) / 256), dim3(256), 0, stream, yf, yb, bufA, ssm_d);
  gemm(stream, yf, 512, 0, w_glu, 512, 0, 0, yb, 512, 0, NTOK, 512, 512, 1, 1.f, 0.f, nullptr, nullptr);
  hipLaunchKernelGGL(k_glu, dim3((NTOK * 512) / 256), dim3(256), 0, stream, yf, yb, bufC);
  hipLaunchKernelGGL(k_dft_table, dim3((4096 * 4096) / 256), dim3(256), 0, stream, cs4096, sn4096, 4096);
  hipLaunchKernelGGL(k_dft_table, dim3((128 * 128) / 256), dim3(256), 0, stream, cs128, sn128, 128);
  float* Pm = bufD; float* Qm = bufD + (size_t)NTOK * 512;
  gemm(stream, bufA + 512, DM, 128, cs128, 128, 0, 0, Pm, 512, 128, NTOK, 128, 128, 4, 1.f, 0.f, nullptr, nullptr);
  gemm(stream, bufA + 512, DM, 128, sn128, 128, 0, 0, Qm, 512, 128, NTOK, 128, 128, 4, 1.f, 0.f, nullptr, nullptr);
  const float nrm = 1.0f / sqrtf(4096.f * 128.f);
  float* R = bufB;
  gemm(stream, cs4096, 4096, 0, Pm, 512, (long long)4096 * 512, 0, R, 512, (long long)4096 * 512, 4096, 512, 4096, NB, nrm, 0.f, nullptr, nullptr);
  gemm(stream, sn4096, 4096, 0, Qm, 512, (long long)4096 * 512, 0, R, 512, (long long)4096 * 512, 4096, 512, 4096, NB, -nrm, 1.f, nullptr, nullptr);
  gemm(stream, R, 512, 128, w_fourier, 128, 128 * 128, 0, bufC + 512, DM, 128, NTOK, 128, 128, 4, 1.f, 0.f, nullptr, nullptr);
  gemm(stream, bufC, DM, 0, w_out, DM, 0, 0, bufA, DM, 0, NTOK, DM, DM, 1, 1.f, 0.f, nullptr, nullptr);
  hipLaunchKernelGGL(k_add, dim3((unsigned)(Q / 4 / 256)), dim3(256), 0, stream, bufA, x);
  float* x2 = bufA;
  float* rinv2 = bufD;
  hipLaunchKernelGGL(k_rinv, dim3(NTOK / 4), dim3(256), 0, stream, x2, rinv2, NTOK);
  const int CH = 16384;
  float* qbuf = bufB;
  float* sc = bufB + (size_t)CH * 2048;
  float* sval = bufD + NTOK;
  int* sidx = (int*)(sval + (size_t)CH * 16 * 16);
  int* eidx = sidx + (size_t)CH * 16 * 16;
  float* gate = (float*)(eidx + (size_t)CH * 128);
  float* tval = gate + (size_t)CH * 128;
  int* tpos = (int*)(tval + (size_t)CH * 128);
  float* outtmp = bufC;
  for (int c0 = 0; c0 < NTOK; c0 += CH) {
    gemm(stream, x2 + (size_t)c0 * DM, DM, 0, w_query, 2048, 0, 0, qbuf, 2048, 0, CH, 2048, DM, 1, 1.f, 0.f, rinv2 + c0, norm2_g);
    gemm(stream, qbuf, 2048, 128, sub_keys, 128, 128 * 128, 1, sc, 2048, 128, CH, 128, 128, 16, 1.f, 0.f, nullptr, nullptr);
    hipLaunchKernelGGL(k_topk, dim3((CH * 16) / 64), dim3(64), 0, stream, sc, sval, sidx, CH * 16, 128);
    hipLaunchKernelGGL(k_cand, dim3((CH * 8 * 256) / 256), dim3(256), 0, stream, sval, sc, CH * 8);
    hipLaunchKernelGGL(k_topk, dim3((CH * 8) / 64), dim3(64), 0, stream, sc, tval, tpos, CH * 8, 256);
    hipLaunchKernelGGL(k_finish, dim3((CH * 8) / 64), dim3(64), 0, stream, tval, tpos, sidx, eidx, gate, CH * 8);
    hipLaunchKernelGGL(k_expert, dim3(CH), dim3(256), 0, stream, x2, rinv2, norm2_g, eidx, gate, expert_u, expert_v, final_g, outtmp, c0);
  }
  (void)hipMemcpyAsync(out, outtmp, Q * sizeof(float), hipMemcpyDeviceToDevice, stream);
}
```

```cpp
#include <hip/hip_runtime.h>
#ifndef LEVEL
#define LEVEL 3
#endif
#ifndef P3_STOP
#define P3_STOP 0
#endif
#include <stdint.h>
#include <string.h>

#define NTOK 65536
#define DM 1024
#define SEQ 4096
#define NB 16

__device__ __forceinline__ void dsincos(double x, double* s, double* c) {
  double q = rint(x * 0.63661977236758134308);
  double r = fma(-q, 1.57079632679489655800, x);
  r = fma(-q, 6.12323399573676603587e-17, r);
  double r2 = r * r;
  double sp = r * (1.0 + r2 * (-1.0 / 6 + r2 * (1.0 / 120 + r2 * (-1.0 / 5040 + r2 * (1.0 / 362880 + r2 * (-1.0 / 39916800 + r2 * (1.0 / 6227020800.0 + r2 * (-1.0 / 1307674368000.0))))))));
  double cp = 1.0 + r2 * (-0.5 + r2 * (1.0 / 24 + r2 * (-1.0 / 720 + r2 * (1.0 / 40320 + r2 * (-1.0 / 3628800 + r2 * (1.0 / 479001600.0 + r2 * (-1.0 / 87178291200.0)))))));
  long long qi = (long long)q;
  int m = (int)(qi & 3);
  double ss = (m == 0) ? sp : (m == 1) ? cp : (m == 2) ? -sp : -cp;
  double cc = (m == 0) ? cp : (m == 1) ? -sp : (m == 2) ? -cp : sp;
  *s = ss; *c = cc;
}

__device__ __forceinline__ float gelu_exact(float x) { return 0.5f * x * (1.0f + erff(x * 0.70710678118654752440f)); }

__global__ void __launch_bounds__(256) k_rinv(const float* __restrict__ x, float* __restrict__ rinv, int nrows) {
  int row = blockIdx.x * 4 + (threadIdx.x >> 6);
  int lane = threadIdx.x & 63;
  if (row >= nrows) return;
  const float4* p = (const float4*)(x + (size_t)row * DM);
  float s = 0.f;
  for (int i = lane; i < DM / 4; i += 64) { float4 v = p[i]; s += v.x * v.x + v.y * v.y + v.z * v.z + v.w * v.w; }
  for (int m = 32; m >= 1; m >>= 1) s += __shfl_xor(s, m, 64);
  if (lane == 0) rinv[row] = rsqrtf(s * (1.0f / DM) + 1e-6f);
}

struct GemmP {
  const float* A; const float* B; float* C;
  const float* rs; const float* ks;
  long long sA, sB, sC;
  int lda, ldb, ldc, M, N, K, transB;
  float alpha, beta;
};

__global__ void __launch_bounds__(256) k_gemm(GemmP p) {
  __shared__ float As[16][132];
  __shared__ float Bs[16][132];
  const int tid = threadIdx.x;
  const int bz = blockIdx.z;
  const float* A = p.A + (size_t)bz * p.sA;
  const float* B = p.B + (size_t)bz * p.sB;
  float* C = p.C + (size_t)bz * p.sC;
  const int m0 = blockIdx.y * 128, n0 = blockIdx.x * 128;
  const int ty = tid >> 4, tx = tid & 15;
  float acc[8][8];
#pragma unroll
  for (int i = 0; i < 8; ++i)
#pragma unroll
    for (int j = 0; j < 8; ++j) acc[i][j] = 0.f;
  for (int k0 = 0; k0 < p.K; k0 += 16) {
#pragma unroll
    for (int it = 0; it < 2; ++it) {
      int idx = tid + it * 256;
      int r = idx >> 2, kq = (idx & 3) * 4;
      float4 v = *(const float4*)(A + (size_t)(m0 + r) * p.lda + k0 + kq);
      float rsv = p.rs ? p.rs[m0 + r] : 1.0f;
      float k0s = 1.f, k1s = 1.f, k2s = 1.f, k3s = 1.f;
      if (p.ks) { k0s = p.ks[k0 + kq]; k1s = p.ks[k0 + kq + 1]; k2s = p.ks[k0 + kq + 2]; k3s = p.ks[k0 + kq + 3]; }
      As[kq + 0][r] = v.x * rsv * k0s; As[kq + 1][r] = v.y * rsv * k1s; As[kq + 2][r] = v.z * rsv * k2s; As[kq + 3][r] = v.w * rsv * k3s;
    }
    if (!p.transB) {
#pragma unroll
      for (int it = 0; it < 2; ++it) {
        int idx = tid + it * 256;
        int kk = idx >> 5, nq = (idx & 31) * 4;
        float4 v = *(const float4*)(B + (size_t)(k0 + kk) * p.ldb + n0 + nq);
        Bs[kk][nq + 0] = v.x; Bs[kk][nq + 1] = v.y; Bs[kk][nq + 2] = v.z; Bs[kk][nq + 3] = v.w;
      }
    } else {
#pragma unroll
      for (int it = 0; it < 2; ++it) {
        int idx = tid + it * 256;
        int n = idx >> 2, kq = (idx & 3) * 4;
        float4 v = *(const float4*)(B + (size_t)(n0 + n) * p.ldb + k0 + kq);
        Bs[kq + 0][n] = v.x; Bs[kq + 1][n] = v.y; Bs[kq + 2][n] = v.z; Bs[kq + 3][n] = v.w;
      }
    }
    __syncthreads();
#pragma unroll
    for (int kk = 0; kk < 16; ++kk) {
      float a[8], b[8];
#pragma unroll
      for (int i = 0; i < 8; ++i) a[i] = As[kk][ty * 8 + i];
#pragma unroll
      for (int j = 0; j < 8; ++j) b[j] = Bs[kk][tx * 8 + j];
#pragma unroll
      for (int i = 0; i < 8; ++i)
#pragma unroll
        for (int j = 0; j < 8; ++j) acc[i][j] = fmaf(a[i], b[j], acc[i][j]);
    }
    __syncthreads();
  }
#pragma unroll
  for (int i = 0; i < 8; ++i) {
    float* cp = C + (size_t)(m0 + ty * 8 + i) * p.ldc + n0 + tx * 8;
#pragma unroll
    for (int j = 0; j < 8; ++j) {
      float v = p.alpha * acc[i][j];
      if (p.beta != 0.f) v += p.beta * cp[j];
      cp[j] = v;
    }
  }
}

static void gemm(hipStream_t st, const float* A, int lda, long long sA, const float* B, int ldb, long long sB, int transB,
                 float* C, int ldc, long long sC, int M, int N, int K, int batch, float alpha, float beta,
                 const float* rs, const float* ks) {
  GemmP p;
  memset(&p, 0, sizeof(p));
  p.A = A; p.B = B; p.C = C; p.rs = rs; p.ks = ks; p.sA = sA; p.sB = sB; p.sC = sC;
  p.lda = lda; p.ldb = ldb; p.ldc = ldc; p.M = M; p.N = N; p.K = K; p.transB = transB; p.alpha = alpha; p.beta = beta;
  dim3 grid(N / 128, M / 128, batch);
  hipLaunchKernelGGL(k_gemm, grid, dim3(256), 0, st, p);
}

__global__ void k_dft_table(float* cs, float* sn, int n) {
  size_t i = (size_t)blockIdx.x * blockDim.x + threadIdx.x;
  if (i >= (size_t)n * n) return;
  int k = (int)(i / n), s = (int)(i % n);
  int m = (int)(((long long)k * s) % n);
  double sv, cv;
  dsincos(6.283185307179586476925 * (double)m / (double)n, &sv, &cv);
  cs[i] = (float)cv; sn[i] = (float)sv;
}

__global__ void __launch_bounds__(64) k_s5(const float* __restrict__ z, const float* __restrict__ a_re, const float* __restrict__ a_im,
                                          const float* __restrict__ log_step, const float* __restrict__ b_re, const float* __restrict__ b_im,
                                          const float* __restrict__ c_re, const float* __restrict__ c_im, float* __restrict__ yout) {
  const int p = threadIdx.x;
  const int bid = blockIdx.x;
  const int dir = bid & 1, g = (bid >> 1) & 31, b = bid >> 6;
  const int gi = dir * 32 + g;
  double are = a_re[gi * 64 + p], aim = a_im[gi * 64 + p];
  double step = exp((double)log_step[gi]);
  double sn_, cs_;
  dsincos(aim * step, &sn_, &cs_);
  double mag = exp(are * step);
  double lr = mag * cs_, li = mag * sn_;
  double nr = lr - 1.0, ni = li;
  double den = are * are + aim * aim;
  double fr = (nr * are + ni * aim) / den, fi = (ni * are - nr * aim) / den;
  float bbr[16], bbi[16], cr[16], ci[16];
#pragma unroll
  for (int c = 0; c < 16; ++c) {
    double br = b_re[((size_t)gi * 64 + p) * 16 + c], bi = b_im[((size_t)gi * 64 + p) * 16 + c];
    bbr[c] = (float)(fr * br - fi * bi);
    bbi[c] = (float)(fr * bi + fi * br);
    cr[c] = c_re[((size_t)gi * 16 + c) * 64 + p];
    ci[c] = c_im[((size_t)gi * 16 + c) * 64 + p];
  }
  const float lrf = (float)lr, lif = (float)li;
  float xr = 0.f, xi = 0.f;
  float* yo = yout + (size_t)dir * NTOK * 512;
  for (int q = 0; q < SEQ; ++q) {
    int t = dir ? (SEQ - 1 - q) : q;
    size_t tok = (size_t)b * SEQ + t;
    const float4* up = (const float4*)(z + tok * DM + g * 16);
    float u[16];
#pragma unroll
    for (int i = 0; i < 4; ++i) { float4 v = up[i]; u[4 * i] = v.x; u[4 * i + 1] = v.y; u[4 * i + 2] = v.z; u[4 * i + 3] = v.w; }
    float br = 0.f, bi = 0.f;
#pragma unroll
    for (int c = 0; c < 16; ++c) { br = fmaf(bbr[c], u[c], br); bi = fmaf(bbi[c], u[c], bi); }
    float nxr = lrf * xr - lif * xi + br;
    float nxi = lrf * xi + lif * xr + bi;
    xr = nxr; xi = nxi;
    float myv = 0.f;
#pragma unroll
    for (int c = 0; c < 16; ++c) {
      float v = cr[c] * xr - ci[c] * xi;
      for (int m = 32; m >= 1; m >>= 1) v += __shfl_xor(v, m, 64);
      if (p == c) myv = v;
    }
    if (p < 16) yo[tok * 512 + g * 16 + p] = myv;
  }
}

__global__ void k_ssm_post(float* __restrict__ yf, const float* __restrict__ yb, const float* __restrict__ z, const float* __restrict__ dvec) {
  size_t i = (size_t)blockIdx.x * blockDim.x + threadIdx.x;
  if (i >= (size_t)NTOK * 512) return;
  size_t tok = i >> 9; int c = (int)(i & 511);
  float v = yf[i] + yb[i] + dvec[c] * z[tok * DM + c];
  yf[i] = gelu_exact(v);
}
__global__ void k_glu(const float* __restrict__ Y, const float* __restrict__ G, float* __restrict__ cat) {
  size_t i = (size_t)blockIdx.x * blockDim.x + threadIdx.x;
  if (i >= (size_t)NTOK * 512) return;
  size_t tok = i >> 9; int c = (int)(i & 511);
  float g = G[i];
  cat[tok * DM + c] = Y[i] * (1.0f / (1.0f + expf(-g)));
}

__global__ void k_topk(const float* __restrict__ scores, float* __restrict__ sval, int* __restrict__ sidx, int nprob, int n) {
  int i = blockIdx.x * blockDim.x + threadIdx.x;
  if (i >= nprob) return;
  const float* s = scores + (size_t)i * n;
  unsigned long long t0 = 0ull, t1 = 0ull, t2 = 0ull, t3 = 0ull;
  for (int r = 0; r < 16; ++r) {
    float best = -3.0e38f; int bi = -1;
    for (int k = 0; k < n; ++k) {
      int w = k >> 6;
      unsigned long long tw = (w == 0) ? t0 : (w == 1) ? t1 : (w == 2) ? t2 : t3;
      bool tk = (tw >> (k & 63)) & 1ull;
      float v = s[k];
      if (!tk && (bi < 0 || v > best)) { best = v; bi = k; }
    }
    unsigned long long bit = 1ull << (bi & 63);
    int w = bi >> 6;
    if (w == 0) t0 |= bit; else if (w == 1) t1 |= bit; else if (w == 2) t2 |= bit; else t3 |= bit;
    sval[(size_t)i * 16 + r] = best; sidx[(size_t)i * 16 + r] = bi;
  }
}
__global__ void k_cand(const float* __restrict__ sval, float* __restrict__ cand, int nprob) {
  size_t t = (size_t)blockIdx.x * blockDim.x + threadIdx.x;
  if (t >= (size_t)nprob * 256) return;
  size_t i = t >> 8; int c = (int)(t & 255);
  cand[t] = sval[(i * 2 + 0) * 16 + (c >> 4)] + sval[(i * 2 + 1) * 16 + (c & 15)];
}
__global__ void k_finish(const float* __restrict__ tval, const int* __restrict__ tpos, const int* __restrict__ sidx,
                         int* __restrict__ eidx, float* __restrict__ gate, int nprob) {
  int i = blockIdx.x * blockDim.x + threadIdx.x;
  if (i >= nprob) return;
  float mx = tval[(size_t)i * 16];
  float sum = 0.f;
  for (int r = 0; r < 16; ++r) sum += expf(tval[(size_t)i * 16 + r] - mx);
  float inv = 1.0f / sum;
  for (int r = 0; r < 16; ++r) {
    int pos = tpos[(size_t)i * 16 + r];
    int e = sidx[((size_t)i * 2 + 0) * 16 + (pos >> 4)] * 128 + sidx[((size_t)i * 2 + 1) * 16 + (pos & 15)];
    eidx[(size_t)i * 16 + r] = e;
    gate[(size_t)i * 16 + r] = expf(tval[(size_t)i * 16 + r] - mx) * inv;
  }
}

__global__ void __launch_bounds__(256) k_expert(const float* __restrict__ x2, const float* __restrict__ rinv2, const float* __restrict__ g2,
                                               const int* __restrict__ eidx, const float* __restrict__ gate,
                                               const float* __restrict__ eu, const float* __restrict__ ev, const float* __restrict__ fg,
                                               float* __restrict__ out, int tok0) {
  __shared__ float red[4];
  __shared__ float bc;
  const int tl = blockIdx.x;
  const size_t tok = (size_t)tok0 + tl;
  const int tid = threadIdx.x, lane = tid & 63, w = tid >> 6;
  float4 xv = *(const float4*)(x2 + tok * DM + tid * 4);
  float4 gv = *(const float4*)(g2 + tid * 4);
  float ri = rinv2[tok];
  float4 h = make_float4(xv.x * ri * gv.x, xv.y * ri * gv.y, xv.z * ri * gv.z, xv.w * ri * gv.w);
  float4 acc = make_float4(0.f, 0.f, 0.f, 0.f);
  for (int j = 0; j < 128; ++j) {
    int e = eidx[(size_t)tl * 128 + j];
    float gt = gate[(size_t)tl * 128 + j];
    float4 uv = *(const float4*)(eu + (size_t)e * DM + tid * 4);
    float s = uv.x * h.x + uv.y * h.y + uv.z * h.z + uv.w * h.w;
    for (int m = 32; m >= 1; m >>= 1) s += __shfl_xor(s, m, 64);
    if (lane == 0) red[w] = s;
    __syncthreads();
    if (tid == 0) bc = red[0] + red[1] + red[2] + red[3];
    __syncthreads();
    float pre = bc;
    float a = gelu_exact(pre) * gt;
    float4 vv = *(const float4*)(ev + (size_t)e * DM + tid * 4);
    acc.x = fmaf(a, vv.x, acc.x); acc.y = fmaf(a, vv.y, acc.y); acc.z = fmaf(a, vv.z, acc.z); acc.w = fmaf(a, vv.w, acc.w);
  }
  float4 x3 = make_float4(xv.x + acc.x, xv.y + acc.y, xv.z + acc.z, xv.w + acc.w);
  float s = x3.x * x3.x + x3.y * x3.y + x3.z * x3.z + x3.w * x3.w;
  for (int m = 32; m >= 1; m >>= 1) s += __shfl_xor(s, m, 64);
  __syncthreads();
  if (lane == 0) red[w] = s;
  __syncthreads();
  float tot = red[0] + red[1] + red[2] + red[3];
  float r3 = rsqrtf(tot * (1.0f / DM) + 1e-6f);
  float4 fv = *(const float4*)(fg + tid * 4);
  *(float4*)(out + tok * DM + tid * 4) = make_float4(x3.x * r3 * fv.x, x3.y * r3 * fv.y, x3.z * r3 * fv.z, x3.w * r3 * fv.w);
}

__global__ void k_add(float* __restrict__ mix, const float* __restrict__ x) {
  size_t i = (size_t)blockIdx.x * blockDim.x + threadIdx.x;
  if (i >= (size_t)NTOK * DM / 4) return;
  float4 a = ((float4*)mix)[i], b = ((const float4*)x)[i];
  ((float4*)mix)[i] = make_float4(a.x + b.x, a.y + b.y, a.z + b.z, a.w + b.w);
}

typedef short bf16x8 __attribute__((ext_vector_type(8)));
typedef float f32x16 __attribute__((ext_vector_type(16)));
typedef float f32x4 __attribute__((ext_vector_type(4)));
typedef unsigned u32x4 __attribute__((ext_vector_type(4)));
typedef unsigned u32x2 __attribute__((ext_vector_type(2)));
typedef float f32x2_t __attribute__((ext_vector_type(2)));
typedef __bf16 bf16x2_t __attribute__((ext_vector_type(2)));
typedef _Float16 f16x2_t __attribute__((ext_vector_type(2)));
typedef _Float16 f16x8_t __attribute__((ext_vector_type(8)));
__device__ __forceinline__ f16x2_t as_h2(unsigned v) { return __builtin_bit_cast(f16x2_t, v); }
#define DI __device__ __forceinline__
#define MFMA32(a, b, c) __builtin_amdgcn_mfma_f32_32x32x16_bf16((a), (b), (c), 0, 0, 0)
#define MFMA16(a, b, c) __builtin_amdgcn_mfma_f32_16x16x32_bf16((a), (b), (c), 0, 0, 0)
#define NTHR 512
#define ASTRIDE 2064
#define ATILE_BYTES (64 * ASTRIDE)

DI unsigned cvtpk(float lo, float hi) { f32x2_t v = {lo, hi}; bf16x2_t b = __builtin_convertvector(v, bf16x2_t); return __builtin_bit_cast(unsigned, b); }
DI unsigned short f2bf(float x) { return (unsigned short)(cvtpk(x, 0.f) & 0xffffu); }
DI float bf2f(unsigned h) { return __uint_as_float(h << 16); }
DI float bflo(unsigned w) { return __uint_as_float(w << 16); }
DI float bfhi(unsigned w) { return __uint_as_float(w & 0xffff0000u); }
DI int crow(int reg, int h) { return (reg & 3) + 8 * (reg >> 2) + 4 * h; }
DI f32x16 zero16() { f32x16 z; for (int i = 0; i < 16; ++i) z[i] = 0.f; return z; }

struct MP {
  const float *x, *g1, *w_in, *a_re, *a_im, *log_step, *b_re, *b_im, *c_re, *c_im, *ssm_d, *w_glu, *w_f, *w_out, *g2, *w_q, *keys, *eu, *ev, *fg;
  float* out;
  bf16x8 *WinF, *WgluF, *WoutF, *WqkF, *M1F, *s5B, *s5C;
  unsigned short *M3T, *U, *T, *YF, *YB;
  _Float16 *EU, *EV;
  float* s5lam;
  unsigned* PAIRS;
};

DI void s5_params(const MP& p, int dg, int pp, float& lr, float& li, double& fr, double& fi) {
  double are = p.a_re[dg * 64 + pp], aim = p.a_im[dg * 64 + pp];
  double step = exp((double)p.log_step[dg]);
  double sn_, cs_;
  dsincos(aim * step, &sn_, &cs_);
  double mag = exp(are * step);
  double lrd = mag * cs_, lid = mag * sn_;
  double nr = lrd - 1.0, ni = lid;
  double den = are * are + aim * aim;
  fr = (nr * are + ni * aim) / den; fi = (ni * are - nr * aim) / den;
  lr = (float)lrd; li = (float)lid;
}

DI int opq(int v) { asm volatile("" : "+v"(v)); return v; }
DI unsigned opqu(unsigned v) { asm volatile("" : "+v"(v)); return v; }
DI float fold_dot(const float* __restrict__ wrow, const float* lds, int stride, int n4) {
  const float4* wr = (const float4*)wrow;
  float s = 0.f;
#pragma unroll 2
  for (int m4 = 0; m4 < n4; ++m4) {
    float4 wv = wr[m4];
    s = fmaf(wv.x, lds[(4 * m4) * stride], s); s = fmaf(wv.y, lds[(4 * m4 + 1) * stride], s);
    s = fmaf(wv.z, lds[(4 * m4 + 2) * stride], s); s = fmaf(wv.w, lds[(4 * m4 + 3) * stride], s);
  }
  return s;
}
DI void conv_frag(bf16x8* dst, const float* __restrict__ src, int ld, const float* __restrict__ kscale, int ntiles, int KS, long gtid, long gsz) {
  const long total = (long)ntiles * KS * 64;
#pragma unroll 1
  for (long u = gtid; u < total; u += gsz) {
    int lane = (int)(u & 63);
    long q = u >> 6;
    int ks = (int)(q % KS), nt = (int)(q / KS);
    int n = 32 * nt + (lane & 31), k0 = 16 * ks + 8 * (lane >> 5);
    u32x4 w;
#pragma unroll
    for (int jj = 0; jj < 4; ++jj) {
      int k = k0 + 2 * jj;
      float a = src[(size_t)k * ld + n], b = src[(size_t)(k + 1) * ld + n];
      if (kscale) { a *= kscale[k]; b *= kscale[k + 1]; }
      w[jj] = cvtpk(a, b);
    }
    dst[u] = __builtin_bit_cast(bf16x8, w);
  }
}

DI void phase0(const MP& p, char* smem) {
  const int tid = threadIdx.x;
  const long gtid = (long)blockIdx.x * NTHR + tid;
  const long gsz = (long)gridDim.x * NTHR;
  conv_frag(p.WinF, p.w_in, 1024, p.g1, 16, 64, gtid, gsz);
  conv_frag(p.WgluF, p.w_glu, 512, nullptr, 16, 32, gtid, gsz);
  conv_frag(p.WoutF, p.w_out, 1024, nullptr, 32, 64, gtid, gsz);
#pragma unroll 1
  for (long u = gtid; u < 4 * 8 * 64; u += gsz) {
    int lane = (int)(u & 63), ks = (int)((u >> 6) & 7), mt = (int)(u >> 9);
    int row = 32 * mt + (lane & 31), h = lane >> 5;
    int ri = row >> 6, k1 = row & 63;
    u32x4 w;
#pragma unroll
    for (int jj = 0; jj < 4; ++jj) {
      float v2[2];
#pragma unroll
      for (int e = 0; e < 2; ++e) {
        int j = 2 * jj + e;
        int col = 16 * ks + 8 * (j >> 2) + 4 * h + (j & 3);
        int ab = col >> 6, s1 = col & 63;
        double sv, cv;
        dsincos(6.283185307179586476925 * (double)((k1 * s1) & 63) / 64.0, &sv, &cv);
        double val = (ri == 0) ? (ab == 0 ? cv : -sv) : (ab == 0 ? -sv : -cv);
        v2[e] = (float)val;
      }
      w[jj] = cvtpk(v2[0], v2[1]);
    }
    p.M1F[u] = __builtin_bit_cast(bf16x8, w);
  }
#pragma unroll 1
  for (long u = gtid; u < 4096 * 128; u += gsz) {
    int s2ri = (int)(u & 127), k = (int)(u >> 7);
    int ri = s2ri >> 6, s2 = s2ri & 63;
    double sv, cv;
    dsincos(6.283185307179586476925 * (double)((k * s2) & 4095) / 4096.0, &sv, &cv);
    p.M3T[u] = f2bf((float)(ri ? sv : cv));
  }
#pragma unroll 1
  for (long u = gtid; u < (long)16384 * 1024 / 8; u += gsz) {
    int d0 = (int)((u * 8) & 1023);
    const float4* s = (const float4*)(p.eu + u * 8);
    float4 a = s[0], b = s[1];
    float4 ga = *(const float4*)(p.g2 + d0), gb = *(const float4*)(p.g2 + d0 + 4);
    f16x8_t o = {(_Float16)(a.x * ga.x), (_Float16)(a.y * ga.y), (_Float16)(a.z * ga.z), (_Float16)(a.w * ga.w),
                 (_Float16)(b.x * gb.x), (_Float16)(b.y * gb.y), (_Float16)(b.z * gb.z), (_Float16)(b.w * gb.w)};
    *(f16x8_t*)(p.EU + u * 8) = o;
    const float4* s2 = (const float4*)(p.ev + u * 8);
    a = s2[0]; b = s2[1];
    f16x8_t o2 = {(_Float16)a.x, (_Float16)a.y, (_Float16)a.z, (_Float16)a.w, (_Float16)b.x, (_Float16)b.y, (_Float16)b.z, (_Float16)b.w};
    *(f16x8_t*)(p.EV + u * 8) = o2;
  }
#pragma unroll 1
  for (long u = gtid; u < 64 * 64; u += gsz) {
    int pp = (int)(u & 63), dg = (int)(u >> 6);
    float lr, li; double fr, fi;
    s5_params(p, dg, pp, lr, li, fr, fi);
    p.s5lam[u * 2] = lr; p.s5lam[u * 2 + 1] = li;
  }
#pragma unroll 1
  for (long u = gtid; u < 64 * 4 * 64; u += gsz) {
    int lane = (int)(u & 63), nt = (int)((u >> 6) & 3), dg = (int)(u >> 8);
    int col = 32 * nt + (lane & 31), ri = col >> 6, pp = col & 63, h = lane >> 5;
    float lr, li; double fr, fi;
    s5_params(p, dg, pp, lr, li, fr, fi);
    const float* brp = p.b_re + ((size_t)dg * 64 + pp) * 16 + 8 * h;
    const float* bip = p.b_im + ((size_t)dg * 64 + pp) * 16 + 8 * h;
    u32x4 w;
#pragma unroll
    for (int jj = 0; jj < 4; ++jj) {
      double br0 = brp[2 * jj], bi0 = bip[2 * jj], br1 = brp[2 * jj + 1], bi1 = bip[2 * jj + 1];
      float v0 = (float)(ri ? (fr * bi0 + fi * br0) : (fr * br0 - fi * bi0));
      float v1 = (float)(ri ? (fr * bi1 + fi * br1) : (fr * br1 - fi * bi1));
      w[jj] = cvtpk(v0, v1);
    }
    p.s5B[u] = __builtin_bit_cast(bf16x8, w);
  }
#pragma unroll 1
  for (long u = gtid; u < 64 * 4 * 64; u += gsz) {
    int lane = (int)(u & 63), ks = (int)((u >> 6) & 3), dg = (int)(u >> 8);
    int c = lane & 15;
    u32x4 w;
#pragma unroll
    for (int jj = 0; jj < 4; ++jj) {
      int kk = 32 * ks + 8 * (lane >> 4) + 2 * jj;
      int pt = kk >> 6, pq = (kk & 63) >> 1;
      int pp = 32 * pt + pq;
      float vre = p.c_re[((size_t)dg * 16 + c) * 64 + pp];
      float vim = -p.c_im[((size_t)dg * 16 + c) * 64 + pp];
      w[jj] = cvtpk(vre, vim);
    }
    p.s5C[u] = __builtin_bit_cast(bf16x8, w);
  }
  {
    float* AB = (float*)smem;
    float* tab = AB + 128 * 32;
    const float nrm = 1.0f / sqrtf(4096.f * 128.f);
#pragma unroll 1
    for (int task = blockIdx.x; task < 128; task += gridDim.x) {
      int ntp = task >> 2, kq = task & 3;
      int ab = ntp >> 4, chbase = (ntp & 15) * 32, g = chbase >> 7, d0 = chbase & 127;
      __syncthreads();
      if (tid < 128) {
        double sv, cv;
        dsincos(6.283185307179586476925 * (double)tid / 128.0, &sv, &cv);
        tab[tid] = (float)(ab ? sv : cv);
      }
      __syncthreads();
#pragma unroll 1
      for (int o = tid; o < 128 * 32; o += NTHR) {
        int m = o >> 5, dd = o & 31;
        float s = 0.f;
#pragma unroll 4
        for (int c = 0; c < 128; ++c) s = fmaf(tab[(m * c) & 127], p.w_f[((size_t)g * 128 + c) * 128 + d0 + dd], s);
        AB[o] = s * nrm;
      }
      __syncthreads();
#pragma unroll 1
      for (int uu = tid; uu < 16 * 64; uu += NTHR) {
        int lane = uu & 63, ks = kq * 16 + (uu >> 6);
        int dd = lane & 31, h = lane >> 5;
        u32x4 w;
#pragma unroll
        for (int jj = 0; jj < 4; ++jj) {
          int k = 16 * ks + 8 * h + 2 * jj;
          float s0 = fold_dot(p.w_in + (size_t)k * 1024 + 512 + 128 * g, AB + dd, 32, 32) * p.g1[k];
          float s1 = fold_dot(p.w_in + (size_t)(k + 1) * 1024 + 512 + 128 * g, AB + dd, 32, 32) * p.g1[k + 1];
          w[jj] = cvtpk(s0, s1);
        }
        p.WinF[((size_t)(16 + ntp) * 64 + ks) * 64 + lane] = __builtin_bit_cast(bf16x8, w);
      }
    }
  }
  {
    float* Ks = (float*)smem;
#pragma unroll 1
    for (int task = blockIdx.x; task < 128; task += gridDim.x) {
      int hp = task >> 3, kt = (task >> 1) & 3, chalf = task & 1;
      __syncthreads();
#pragma unroll 1
      for (int o = tid; o < 32 * 128; o += NTHR) {
        int kk = o >> 7, d = o & 127;
        Ks[kk * 129 + d] = p.keys[((size_t)hp * 128 + kt * 32 + kk) * 128 + d];
      }
      __syncthreads();
#pragma unroll 1
      for (int uu = tid; uu < 32 * 64; uu += NTHR) {
        int lane = uu & 63, ks = chalf * 32 + (uu >> 6);
        int kk = lane & 31, h = lane >> 5;
        u32x4 w;
#pragma unroll
        for (int jj = 0; jj < 4; ++jj) {
          int c = 16 * ks + 8 * h + 2 * jj;
          float s0 = fold_dot(p.w_q + (size_t)c * 2048 + hp * 128, Ks + kk * 129, 1, 32) * p.g2[c];
          float s1 = fold_dot(p.w_q + (size_t)(c + 1) * 2048 + hp * 128, Ks + kk * 129, 1, 32) * p.g2[c + 1];
          w[jj] = cvtpk(s0, s1);
        }
        p.WqkF[((size_t)(hp * 4 + kt) * 64 + ks) * 64 + lane] = __builtin_bit_cast(bf16x8, w);
      }
    }
  }
}

template <int NT>
DI void gemm_tile(f32x16 (&acc)[2][NT], const char* atile, int acol0, const bf16x8* __restrict__ wf, int KS, int nks, int lane) {
  const char* abase = atile + (lane & 31) * ASTRIDE + (acol0 + 8 * (lane >> 5)) * 2;
  const bf16x8* wb = wf + lane;
#pragma unroll 2
  for (int ks = 0; ks < nks; ++ks) {
    bf16x8 a0 = *(const bf16x8*)(abase + ks * 32);
    bf16x8 a1 = *(const bf16x8*)(abase + 32 * ASTRIDE + ks * 32);
    bf16x8 b[NT];
#pragma unroll
    for (int nt = 0; nt < NT; ++nt) b[nt] = wb[((size_t)nt * KS + ks) * 64];
#pragma unroll
    for (int nt = 0; nt < NT; ++nt) {
      acc[0][nt] = MFMA32(a0, b[nt], acc[0][nt]);
      acc[1][nt] = MFMA32(a1, b[nt], acc[1][nt]);
    }
  }
}

DI bf16x8 pack_step(const f32x16& x, int s) {
  u32x4 w;
  w[0] = cvtpk(x[8 * s + 0], x[8 * s + 1]); w[1] = cvtpk(x[8 * s + 2], x[8 * s + 3]);
  w[2] = cvtpk(x[8 * s + 4], x[8 * s + 5]); w[3] = cvtpk(x[8 * s + 6], x[8 * s + 7]);
  return __builtin_bit_cast(bf16x8, w);
}

DI void phase1(const MP& p, char* smem) {
  const int tid = threadIdx.x, lane = tid & 63, w = __builtin_amdgcn_readfirstlane(tid >> 6), h = lane >> 5;
  char* atile = smem;
  float* rinv = (float*)(smem + ATILE_BYTES);
  for (int tt = blockIdx.x; tt < 1024; tt += gridDim.x) {
    const int b = tt >> 6, s2 = tt & 63;
    __syncthreads();
    for (int rr = 0; rr < 8; ++rr) {
      int r = w * 8 + rr;
      const float4* xp = (const float4*)(p.x + ((size_t)b * 4096 + 64 * r + s2) * 1024);
      float4 v[4];
#pragma unroll
      for (int i = 0; i < 4; ++i) v[i] = xp[lane + 64 * i];
      float s = 0.f;
#pragma unroll
      for (int i = 0; i < 4; ++i) s += v[i].x * v[i].x + v[i].y * v[i].y + v[i].z * v[i].z + v[i].w * v[i].w;
      for (int m = 32; m >= 1; m >>= 1) s += __shfl_xor(s, m, 64);
      if (lane == 0) rinv[r] = rsqrtf(s * (1.0f / 1024.f) + 1e-6f);
#pragma unroll
      for (int i = 0; i < 4; ++i) {
        u32x2 pk; pk[0] = cvtpk(v[i].x, v[i].y); pk[1] = cvtpk(v[i].z, v[i].w);
        *(u32x2*)(atile + r * ASTRIDE + (lane + 64 * i) * 8) = pk;
      }
    }
    __syncthreads();
    {
      f32x16 acc[2][2];
#pragma unroll
      for (int i = 0; i < 2; ++i)
#pragma unroll
        for (int j = 0; j < 2; ++j) acc[i][j] = zero16();
      gemm_tile<2>(acc, atile, 0, p.WinF + (size_t)(2 * w) * 64 * 64, 64, 64, lane);
      {
        const unsigned ubase = (unsigned)((((size_t)b * 4096 + s2 + 256 * h) * 512 + 64 * w + (lane & 31)) * 2);
#pragma unroll
        for (int mt = 0; mt < 2; ++mt)
#pragma unroll
          for (int nt = 0; nt < 2; ++nt) {
            const unsigned tb = opqu(ubase + (unsigned)((32 * mt * 64 * 512 + 32 * nt) * 2));
            const float* rvp = rinv + opq(32 * mt + 4 * h);
#pragma unroll
            for (int r = 0; r < 16; ++r) {
              const int rc = (r & 3) + 8 * (r >> 2);
              *(unsigned short*)((char*)p.U + tb + (unsigned)(rc * 64 * 512 * 2)) = f2bf(acc[mt][nt][r] * rvp[rc]);
            }
          }
      }
    }
    {
      bf16x8 xs[8][2];
      {
        f32x16 acc[2][4];
#pragma unroll
        for (int i = 0; i < 2; ++i)
#pragma unroll
          for (int j = 0; j < 4; ++j) acc[i][j] = zero16();
        {
          const char* abase = atile + (lane & 31) * ASTRIDE + (8 * h) * 2;
          const bf16x8* wfa = p.WinF + (size_t)(16 + 2 * w) * 64 * 64 + lane;
          const bf16x8* wfb = p.WinF + (size_t)(32 + 2 * w) * 64 * 64 + lane;
#pragma unroll 2
          for (int ks = 0; ks < 64; ++ks) {
            bf16x8 a0 = *(const bf16x8*)(abase + ks * 32);
            bf16x8 a1 = *(const bf16x8*)(abase + 32 * ASTRIDE + ks * 32);
            bf16x8 b0 = wfa[(size_t)ks * 64], b1 = wfa[((size_t)64 + ks) * 64];
            bf16x8 b2 = wfb[(size_t)ks * 64], b3 = wfb[((size_t)64 + ks) * 64];
            acc[0][0] = MFMA32(a0, b0, acc[0][0]); acc[1][0] = MFMA32(a1, b0, acc[1][0]);
            acc[0][1] = MFMA32(a0, b1, acc[0][1]); acc[1][1] = MFMA32(a1, b1, acc[1][1]);
            acc[0][2] = MFMA32(a0, b2, acc[0][2]); acc[1][2] = MFMA32(a1, b2, acc[1][2]);
            acc[0][3] = MFMA32(a0, b3, acc[0][3]); acc[1][3] = MFMA32(a1, b3, acc[1][3]);
          }
        }
#pragma unroll
        for (int mt = 0; mt < 2; ++mt) {
#pragma unroll
          for (int c = 0; c < 4; ++c) {
            const float* rvp = rinv + opq(32 * mt + 4 * h);
#pragma unroll
            for (int r = 0; r < 16; ++r) acc[mt][c][r] *= rvp[(r & 3) + 8 * (r >> 2)];
            const int ab = c >> 1, nt = c & 1;
            xs[ab * 4 + mt * 2 + 0][nt] = pack_step(acc[mt][c], 0);
            xs[ab * 4 + mt * 2 + 1][nt] = pack_step(acc[mt][c], 1);
          }
        }
      }
#pragma unroll
      for (int mt = 0; mt < 4; ++mt) {
        f32x16 t0 = zero16(), t1 = zero16();
        const bf16x8* mf = p.M1F + (size_t)(opq(mt * 8)) * 64 + lane;
#pragma unroll
        for (int ks = 0; ks < 8; ++ks) {
          bf16x8 a = mf[ks * 64];
          t0 = MFMA32(a, xs[ks][0], t0);
          t1 = MFMA32(a, xs[ks][1], t1);
        }
        const int ri = mt >> 1;
        const unsigned tbase = opqu((unsigned)(((((size_t)b * 64 + 32 * (mt & 1) + 4 * h) * 128 + ri * 64 + s2) * 512 + 64 * w + (lane & 31)) * 2));
#pragma unroll
        for (int r = 0; r < 16; ++r) {
          const int rc = (r & 3) + 8 * (r >> 2);
          *(unsigned short*)((char*)p.T + tbase + (unsigned)(rc * 128 * 512 * 2)) = f2bf(t0[r]);
          *(unsigned short*)((char*)p.T + tbase + (unsigned)(rc * 128 * 512 * 2 + 64)) = f2bf(t1[r]);
        }
      }
    }
  }
}

#define XS_STRIDE 272
#define XS_BYTES (32 * XS_STRIDE)
DI void phase2(const MP& p, char* smem) {
  const int tid = threadIdx.x, lane = tid & 63, w = __builtin_amdgcn_readfirstlane(tid >> 6), h = lane >> 5;
  const int slot = w >> 1, pt = w & 1;
  const bool active = (w < 4);
  for (int t0 = blockIdx.x * 2; t0 < 512; t0 += gridDim.x * 2) {
    const int task = t0 + slot;
    const bool act = active && (task < 512);
    const int dir = task & 1, g = (task >> 1) & 31, bp = task >> 6;
    const int dg = dir * 32 + g;
    char* xt = smem + slot * 2 * XS_BYTES;
    bf16x8 bf0, bf1, cf[4];
    float lr = 0.f, li = 0.f;
    if (act) {
      bf0 = p.s5B[(size_t)(dg * 4 + 0 + pt) * 64 + lane];
      bf1 = p.s5B[(size_t)(dg * 4 + 2 + pt) * 64 + lane];
#pragma unroll
      for (int ks = 0; ks < 4; ++ks) cf[ks] = p.s5C[(size_t)(dg * 4 + ks) * 64 + lane];
      int pp = 32 * pt + (lane & 31);
      lr = p.s5lam[((size_t)dg * 64 + pp) * 2]; li = p.s5lam[((size_t)dg * 64 + pp) * 2 + 1];
    }
    const int rho = lane & 31;
    const int hr = (rho >> 2) & 1, rr = (rho & 3) + 4 * (rho >> 3);
    const size_t ubase = ((size_t)(2 * bp + hr) * 4096) * 512 + g * 16 + 8 * h;
    float xr = 0.f, xi = 0.f;
    bf16x8 anext;
    if (act) { int tpos = dir ? (4095 - rr) : rr; anext = *(const bf16x8*)(p.U + ubase + (size_t)tpos * 512); }
    __syncthreads();
    for (int step = 0; step < 256; ++step) {
      char* xb = xt + (step & 1) * XS_BYTES;
      if (act) {
        bf16x8 a = anext;
        if (step < 255) { int q = 16 * (step + 1) + rr; int tpos = dir ? (4095 - q) : q; anext = *(const bf16x8*)(p.U + ubase + (size_t)tpos * 512); }
        f32x16 bre = MFMA32(a, bf0, zero16());
        f32x16 bim = MFMA32(a, bf1, zero16());
#pragma unroll
        for (int r = 0; r < 16; ++r) {
          float nr = fmaf(lr, xr, fmaf(-li, xi, bre[r]));
          float ni = fmaf(lr, xi, fmaf(li, xr, bim[r]));
          xr = nr; xi = ni;
          *(unsigned*)(xb + (h * 16 + r) * XS_STRIDE + (pt * 64 + 2 * (lane & 31)) * 2) = cvtpk(xr, xi);
        }
      }
      __syncthreads();
      if (act) {
        f32x4 y = {0.f, 0.f, 0.f, 0.f};
#pragma unroll
        for (int ks = 0; ks < 4; ++ks) {
          bf16x8 a = *(const bf16x8*)(xb + (pt * 16 + (lane & 15)) * XS_STRIDE + (32 * ks + 8 * (lane >> 4)) * 2);
          y = MFMA16(a, cf[ks], y);
        }
        unsigned short* yo = dir ? p.YB : p.YF;
#pragma unroll
        for (int r = 0; r < 4; ++r) {
          int q = 16 * step + 4 * (lane >> 4) + r;
          int tpos = dir ? (4095 - q) : q;
          yo[((size_t)(2 * bp + pt) * 4096 + tpos) * 512 + g * 16 + (lane & 15)] = f2bf(y[r]);
        }
      }
    }
  }
}

DI int f2key(float f) { int b = __float_as_int(f); return b ^ ((b >> 31) & 0x7fffffff); }
DI float key2f(int k) { return __int_as_float(k ^ ((k >> 31) & 0x7fffffff)); }
#define CE_DESC(a, b) { int mx_ = max(a, b), mn_ = min(a, b); a = mx_; b = mn_; }
#define CE_ASC(a, b) { int mx_ = max(a, b), mn_ = min(a, b); a = mn_; b = mx_; }

DI void sort16_desc(int (&v)[16]) {
#pragma unroll
  for (int k = 2; k <= 16; k <<= 1) {
#pragma unroll
    for (int j = k >> 1; j > 0; j >>= 1) {
#pragma unroll
      for (int i = 0; i < 16; ++i) {
        const int l = i ^ j;
        if (l > i) {
          if ((i & k) == 0) { CE_DESC(v[i], v[l]); } else { CE_ASC(v[i], v[l]); }
        }
      }
    }
  }
}
DI void merge16_desc(int (&a)[16], const int (&b)[16]) {
#pragma unroll
  for (int i = 0; i < 16; ++i) a[i] = max(a[i], b[15 - i]);
#pragma unroll
  for (int j = 8; j > 0; j >>= 1) {
#pragma unroll
    for (int i = 0; i < 16; ++i) {
      const int l = i ^ j;
      if (l > i) { CE_DESC(a[i], a[l]); }
    }
  }
}
DI void top16_of_64(const int (&k)[64], int (&out)[16]) {
  int g1[16], g2[16], g3[16];
#pragma unroll
  for (int i = 0; i < 16; ++i) { out[i] = k[i]; g1[i] = k[16 + i]; g2[i] = k[32 + i]; g3[i] = k[48 + i]; }
  sort16_desc(out); sort16_desc(g1); sort16_desc(g2); sort16_desc(g3);
  merge16_desc(out, g1); merge16_desc(g2, g3); merge16_desc(out, g2);
}

DI float reduce_scatter32(float (&v)[32], int lane) {
  float a[16];
  {
    const bool up = (lane & 16) != 0;
#pragma unroll
    for (int i = 0; i < 16; ++i) { float keep = up ? v[16 + i] : v[i]; float send = up ? v[i] : v[16 + i]; a[i] = keep + __shfl_xor(send, 16, 64); }
  }
  float b[8];
  {
    const bool up = (lane & 8) != 0;
#pragma unroll
    for (int i = 0; i < 8; ++i) { float keep = up ? a[8 + i] : a[i]; float send = up ? a[i] : a[8 + i]; b[i] = keep + __shfl_xor(send, 8, 64); }
  }
  float c[4];
  {
    const bool up = (lane & 4) != 0;
#pragma unroll
    for (int i = 0; i < 4; ++i) { float keep = up ? b[4 + i] : b[i]; float send = up ? b[i] : b[4 + i]; c[i] = keep + __shfl_xor(send, 4, 64); }
  }
  float d[2];
  {
    const bool up = (lane & 2) != 0;
#pragma unroll
    for (int i = 0; i < 2; ++i) { float keep = up ? c[2 + i] : c[i]; float send = up ? c[i] : c[2 + i]; d[i] = keep + __shfl_xor(send, 2, 64); }
  }
  {
    const bool up = (lane & 1) != 0;
    float keep = up ? d[1] : d[0]; float send = up ? d[0] : d[1];
    return keep + __shfl_xor(send, 1, 64);
  }
}
DI float reduce_scatter64(float (&v)[64], int lane) {
  float a[32];
  const bool up = (lane & 32) != 0;
#pragma unroll
  for (int i = 0; i < 32; ++i) { float keep = up ? v[32 + i] : v[i]; float send = up ? v[i] : v[32 + i]; a[i] = keep + __shfl_xor(send, 32, 64); }
  return reduce_scatter32(a, lane);
}

__host__ __device__ constexpr int cand_index(int i, int j) {
  int n = 0;
  for (int a = 0; a < 16; ++a)
    for (int b = 0; b < 16; ++b)
      if ((a + 1) * (b + 1) <= 16) { if (a == i && b == j) return n; ++n; }
  return n;
}
static_assert(cand_index(15, 0) == 49, "50 candidates");
DI float gelu_f(float x) { return 0.5f * x * (1.0f + erff(x * 0.70710678118654752440f)); }

#if LEVEL >= 3
DI void gather_rows(const MP& p, const size_t tok0, const int w, const int lane, const float* rinv2) {
    for (int rr = 0; rr < 8; ++rr) {
      const int row = 8 * w + rr;
      const size_t tok = tok0 + 64 * (size_t)row;
      const float ri2 = rinv2[row];
      float xv[16];
      {
        const float4* xp = (const float4*)(p.out + tok * 1024);
        float4 a0 = xp[2 * lane], a1 = xp[2 * lane + 1], a2 = xp[128 + 2 * lane], a3 = xp[128 + 2 * lane + 1];
        xv[0] = a0.x; xv[1] = a0.y; xv[2] = a0.z; xv[3] = a0.w; xv[4] = a1.x; xv[5] = a1.y; xv[6] = a1.z; xv[7] = a1.w;
        xv[8] = a2.x; xv[9] = a2.y; xv[10] = a2.z; xv[11] = a2.w; xv[12] = a3.x; xv[13] = a3.y; xv[14] = a3.z; xv[15] = a3.w;
      }
      f16x2_t hx[8];
#pragma unroll
      for (int q = 0; q < 8; ++q) { hx[q][0] = (_Float16)xv[2 * q]; hx[q][1] = (_Float16)xv[2 * q + 1]; }
      const unsigned pw0 = p.PAIRS[tok * 128 + lane], pw1 = p.PAIRS[tok * 128 + 64 + lane];
      float act0, act1;
#pragma unroll
      for (int half = 0; half < 2; ++half) {
        const unsigned pw = half ? pw1 : pw0;
        float prt[64];
#pragma unroll
        for (int grp = 0; grp < 8; ++grp) {
          u32x4 ua[8], ub[8];
#pragma unroll
          for (int i = 0; i < 8; ++i) {
            unsigned e = __builtin_amdgcn_readlane(pw, grp * 8 + i) >> 16;
            const u32x4* up = (const u32x4*)(p.EU + (size_t)e * 1024);
            ua[i] = up[lane]; ub[i] = up[64 + lane];
          }
#pragma unroll
          for (int i = 0; i < 8; ++i) {
            float s = 0.f;
#pragma unroll
            for (int q = 0; q < 4; ++q) s = __builtin_amdgcn_fdot2(as_h2(ua[i][q]), hx[q], s, false);
#pragma unroll
            for (int q = 0; q < 4; ++q) s = __builtin_amdgcn_fdot2(as_h2(ub[i][q]), hx[4 + q], s, false);
            prt[grp * 8 + i] = s;
          }
          __builtin_amdgcn_sched_barrier(0);
        }
        float pre = reduce_scatter64(prt, lane) * ri2;
        float a = gelu_f(pre) * bflo(pw);
        if (half) act1 = a; else act0 = a;
      }
      float acc[16];
#pragma unroll
      for (int q = 0; q < 16; ++q) acc[q] = 0.f;
#pragma unroll
      for (int half = 0; half < 2; ++half) {
        const unsigned pw = half ? pw1 : pw0;
        const float av = half ? act1 : act0;
#pragma unroll 8
        for (int j = 0; j < 64; ++j) {
          unsigned e = __builtin_amdgcn_readlane(pw, j) >> 16;
          float a = __builtin_bit_cast(float, __builtin_amdgcn_readlane(__builtin_bit_cast(unsigned, av), j));
          const u32x4* vp = (const u32x4*)(p.EV + (size_t)e * 1024);
          u32x4 va = vp[lane], vb = vp[64 + lane];
#pragma unroll
          for (int q = 0; q < 4; ++q) {
            f16x2_t t = as_h2(va[q]);
            acc[2 * q] = fmaf(a, (float)t[0], acc[2 * q]); acc[2 * q + 1] = fmaf(a, (float)t[1], acc[2 * q + 1]);
            f16x2_t t2 = as_h2(vb[q]);
            acc[8 + 2 * q] = fmaf(a, (float)t2[0], acc[8 + 2 * q]); acc[8 + 2 * q + 1] = fmaf(a, (float)t2[1], acc[8 + 2 * q + 1]);
          }
        }
      }
      float s = 0.f;
#pragma unroll
      for (int q = 0; q < 16; ++q) { xv[q] += acc[q]; s = fmaf(xv[q], xv[q], s); }
      for (int m = 32; m >= 1; m >>= 1) s += __shfl_xor(s, m, 64);
      const float r3 = rsqrtf(s * (1.0f / 1024.f) + 1e-6f);
      const int l2 = opq(2 * lane);
      const float4* fp = (const float4*)p.fg;
      float4 f0 = fp[l2], f1 = fp[l2 + 1], f2 = fp[128 + l2], f3 = fp[128 + l2 + 1];
      float4* op = (float4*)(p.out + tok * 1024);
      op[l2] = make_float4(xv[0] * r3 * f0.x, xv[1] * r3 * f0.y, xv[2] * r3 * f0.z, xv[3] * r3 * f0.w);
      op[l2 + 1] = make_float4(xv[4] * r3 * f1.x, xv[5] * r3 * f1.y, xv[6] * r3 * f1.z, xv[7] * r3 * f1.w);
      op[128 + l2] = make_float4(xv[8] * r3 * f2.x, xv[9] * r3 * f2.y, xv[10] * r3 * f2.z, xv[11] * r3 * f2.w);
      op[128 + l2 + 1] = make_float4(xv[12] * r3 * f3.x, xv[13] * r3 * f3.y, xv[14] * r3 * f3.z, xv[15] * r3 * f3.w);
    }
}
DI void phase3(const MP& p, char* smem) {
  const int tid = threadIdx.x, lane = tid & 63, w = __builtin_amdgcn_readfirstlane(tid >> 6), h = lane >> 5;
  char* atile = smem;
  float* rinv2 = (float*)(smem + ATILE_BYTES);
  float* part = rinv2 + 64;
  for (int tt = blockIdx.x; tt < 1024; tt += gridDim.x) {
    const int b = tt >> 6, k1 = tt & 63;
    const size_t tok0 = (size_t)b * 4096 + k1;
    __syncthreads();
#pragma unroll 2
    for (int it = 0; it < 8; ++it) {
      int chunk = opq(tid + NTHR * it);
      int r = chunk >> 6, c8 = chunk & 63;
      size_t off = (tok0 + 64 * (size_t)r) * 512 + c8 * 8;
      u32x4 yf = *(const u32x4*)(p.YF + off), yb = *(const u32x4*)(p.YB + off), uu = *(const u32x4*)(p.U + off);
      float4 d0 = *(const float4*)(p.ssm_d + c8 * 8), d1 = *(const float4*)(p.ssm_d + c8 * 8 + 4);
      float dd[8] = {d0.x, d0.y, d0.z, d0.w, d1.x, d1.y, d1.z, d1.w};
      u32x4 o;
#pragma unroll
      for (int q = 0; q < 4; ++q) {
        float lo = bflo(yf[q]) + bflo(yb[q]) + dd[2 * q] * bflo(uu[q]);
        float hi = bfhi(yf[q]) + bfhi(yb[q]) + dd[2 * q + 1] * bfhi(uu[q]);
        o[q] = cvtpk(gelu_f(lo), gelu_f(hi));
      }
      *(u32x4*)(atile + r * ASTRIDE + c8 * 16) = o;
    }
    __syncthreads();
    f32x16 gacc[2][2];
#pragma unroll
    for (int i = 0; i < 2; ++i)
#pragma unroll
      for (int j = 0; j < 2; ++j) gacc[i][j] = zero16();
    gemm_tile<2>(gacc, atile, 0, p.WgluF + (size_t)(2 * w) * 32 * 64, 32, 32, opq(lane));
    {
      f32x16 facc[2][2];
#pragma unroll
      for (int i = 0; i < 2; ++i)
#pragma unroll
        for (int j = 0; j < 2; ++j) facc[i][j] = zero16();
      const int lnf = opq(lane);
      const unsigned short* m3 = p.M3T + ((size_t)k1 + 64 * (size_t)(lnf & 31)) * 128 + 8 * (lnf >> 5);
      const unsigned short* tb = p.T + (((size_t)b * 64 + k1) * 128 + 8 * (lnf >> 5)) * 512 + 64 * w + (lnf & 31);
#pragma unroll 2
      for (int ks = 0; ks < 8; ++ks) {
        bf16x8 a0 = *(const bf16x8*)(m3 + 16 * ks);
        bf16x8 a1 = *(const bf16x8*)(m3 + (size_t)32 * 64 * 128 + 16 * ks);
        bf16x8 b0, b1;
#pragma unroll
        for (int j = 0; j < 8; ++j) {
          b0[j] = (short)tb[((size_t)16 * ks + j) * 512];
          b1[j] = (short)tb[((size_t)16 * ks + j) * 512 + 32];
        }
        facc[0][0] = MFMA32(a0, b0, facc[0][0]); facc[1][0] = MFMA32(a1, b0, facc[1][0]);
        facc[0][1] = MFMA32(a0, b1, facc[0][1]); facc[1][1] = MFMA32(a1, b1, facc[1][1]);
      }
#pragma unroll
      for (int mt = 0; mt < 2; ++mt)
#pragma unroll
        for (int nt = 0; nt < 2; ++nt)
#pragma unroll
          for (int r = 0; r < 16; ++r) {
            int row = 32 * mt + crow(r, lnf >> 5), col = 512 + 64 * w + 32 * nt + (lnf & 31);
            *(unsigned short*)(atile + row * ASTRIDE + col * 2) = f2bf(facc[mt][nt][r]);
          }
    }
    __syncthreads();
    {
    const int lng = opq(lane);
#pragma unroll
    for (int mt = 0; mt < 2; ++mt)
#pragma unroll
      for (int nt = 0; nt < 2; ++nt)
#pragma unroll
        for (int r = 0; r < 16; ++r) {
          int row = 32 * mt + crow(r, lng >> 5), col = 64 * w + 32 * nt + (lng & 31);
          unsigned short* q = (unsigned short*)(atile + row * ASTRIDE + col * 2);
          float yv = bf2f(*q);
          *q = f2bf(yv / (1.0f + __expf(-gacc[mt][nt][r])));
        }
    }
    __syncthreads();
    {
      f32x16 acc[2][4];
#pragma unroll
      for (int i = 0; i < 2; ++i)
#pragma unroll
        for (int j = 0; j < 4; ++j) acc[i][j] = zero16();
      gemm_tile<4>(acc, atile, 0, p.WoutF + (size_t)(4 * w) * 64 * 64, 64, 64, opq(lane));
      __syncthreads();
      float ss[32];
#pragma unroll
      for (int i = 0; i < 32; ++i) ss[i] = 0.f;
      {
        const int lnd = opq(lane);
        const unsigned gbase = (unsigned)(((tok0 + 256 * (lnd >> 5)) * 1024 + 128 * w + (lnd & 31)) * 4);
#pragma unroll
        for (int mt = 0; mt < 2; ++mt)
#pragma unroll
          for (int nt = 0; nt < 4; ++nt) {
            const unsigned gb = opqu(gbase + (unsigned)((32 * mt * 64 * 1024 + 32 * nt) * 4));
            char* lb = atile + opq((32 * mt + 4 * (lnd >> 5)) * ASTRIDE + (128 * w + 32 * nt + (lnd & 31)) * 2);
#pragma unroll
            for (int r = 0; r < 16; ++r) {
              const int rc = (r & 3) + 8 * (r >> 2);
              const unsigned go = gb + (unsigned)(rc * 64 * 1024 * 4);
              float v = *(const float*)((const char*)p.x + go) + acc[mt][nt][r];
              *(float*)((char*)p.out + go) = v;
              *(unsigned short*)(lb + rc * ASTRIDE) = f2bf(v);
              ss[mt * 16 + r] = fmaf(v, v, ss[mt * 16 + r]);
            }
          }
      }
      float tot = reduce_scatter32(ss, lane);
      {
        int L = lane & 31;
        part[w * 64 + 32 * (L >> 4) + crow(L & 15, h)] = tot;
      }
    }
    __syncthreads();
    if (tid < 64) {
      float s = 0.f;
#pragma unroll
      for (int i = 0; i < 8; ++i) s += part[i * 64 + tid];
      rinv2[tid] = rsqrtf(s * (1.0f / 1024.f) + 1e-6f);
    }
    __syncthreads();
#if P3_STOP == 1
    continue;
#endif
    int sk[2][2][16];
#pragma unroll
    for (int pq = 0; pq < 2; ++pq) {
      int run[2][16];
#pragma unroll
      for (int half = 0; half < 2; ++half) {
        f32x16 acc[2][2];
#pragma unroll
        for (int i = 0; i < 2; ++i)
#pragma unroll
          for (int j = 0; j < 2; ++j) acc[i][j] = zero16();
        {
          const int ln = opq(lane);
          const char* bbase = atile + (ln & 31) * ASTRIDE + (8 * (ln >> 5)) * 2;
          const bf16x8* wq = p.WqkF + (size_t)(8 * w + 4 * pq + 2 * half) * 64 * 64 + ln;
#pragma unroll 2
          for (int ks = 0; ks < 64; ++ks) {
            bf16x8 x0 = *(const bf16x8*)(bbase + ks * 32);
            bf16x8 x1 = *(const bf16x8*)(bbase + 32 * ASTRIDE + ks * 32);
            bf16x8 a0 = wq[(size_t)ks * 64], a1 = wq[((size_t)64 + ks) * 64];
            acc[0][0] = MFMA32(a0, x0, acc[0][0]); acc[0][1] = MFMA32(a0, x1, acc[0][1]);
            acc[1][0] = MFMA32(a1, x0, acc[1][0]); acc[1][1] = MFMA32(a1, x1, acc[1][1]);
          }
        }
#pragma unroll
        for (int nt = 0; nt < 2; ++nt) {
          const float sc = rinv2[32 * nt + (lane & 31)];
#pragma unroll
          for (int mt = 0; mt < 2; ++mt) {
            int g[16];
            const int hb = opq(4 * h);
#pragma unroll
            for (int r = 0; r < 16; ++r) g[r] = (f2key(acc[mt][nt][r] * sc) & ~0x7f) | (32 * (2 * half + mt) + (r & 3) + 8 * (r >> 2)) | hb;
            sort16_desc(g);
            if (half == 0 && mt == 0) {
#pragma unroll
              for (int i = 0; i < 16; ++i) run[nt][i] = g[i];
            } else {
              merge16_desc(run[nt], g);
            }
          }
        }
      }
#pragma unroll
      for (int nt = 0; nt < 2; ++nt) {
        int other[16];
#pragma unroll
        for (int i = 0; i < 16; ++i) other[i] = __shfl_xor(run[nt][i], 32, 64);
        merge16_desc(run[nt], other);
#pragma unroll
        for (int i = 0; i < 16; ++i) sk[pq][nt][i] = run[nt][i];
      }
    }
    {
      int s0[16], s1[16];
#pragma unroll
      for (int i = 0; i < 16; ++i) { s0[i] = h ? sk[0][1][i] : sk[0][0][i]; s1[i] = h ? sk[1][1][i] : sk[1][0][i]; }
      float v0[16], v1[16];
#pragma unroll
      for (int i = 0; i < 16; ++i) { v0[i] = key2f(s0[i]); v1[i] = key2f(s1[i]); }
      int ck[64];
#pragma unroll
      for (int i = 0; i < 16; ++i)
#pragma unroll
        for (int j = 0; j < 16; ++j)
          if ((i + 1) * (j + 1) <= 16) ck[cand_index(i, j)] = (f2key(v0[i] + v1[j]) & ~0xff) | (i * 16 + j);
#pragma unroll
      for (int q = 50; q < 64; ++q) ck[q] = (int)0x80000000;
      int top[16];
      top16_of_64(ck, top);
      unsigned i0p[4], i1p[4];
#pragma unroll
      for (int q = 0; q < 4; ++q) {
        i0p[q] = (unsigned)(s0[4 * q] & 0x7f) | ((unsigned)(s0[4 * q + 1] & 0x7f) << 8) | ((unsigned)(s0[4 * q + 2] & 0x7f) << 16) | ((unsigned)(s0[4 * q + 3] & 0x7f) << 24);
        i1p[q] = (unsigned)(s1[4 * q] & 0x7f) | ((unsigned)(s1[4 * q + 1] & 0x7f) << 8) | ((unsigned)(s1[4 * q + 2] & 0x7f) << 16) | ((unsigned)(s1[4 * q + 3] & 0x7f) << 24);
      }
      float sum = 0.f;
      float mx = key2f(top[0] & ~0xff);
      float ev[16];
#pragma unroll
      for (int r = 0; r < 16; ++r) { ev[r] = __expf(key2f(top[r] & ~0xff) - mx); sum += ev[r]; }
      const float inv = 1.0f / sum;
      u32x4 o[4];
#pragma unroll
      for (int r = 0; r < 16; ++r) {
        int code = top[r] & 0xff, ci = code >> 4, cj = code & 15;
        unsigned w0 = (ci >> 2) == 0 ? i0p[0] : (ci >> 2) == 1 ? i0p[1] : (ci >> 2) == 2 ? i0p[2] : i0p[3];
        unsigned w1 = (cj >> 2) == 0 ? i1p[0] : (cj >> 2) == 1 ? i1p[1] : (cj >> 2) == 2 ? i1p[2] : i1p[3];
        unsigned e0 = (w0 >> ((ci & 3) * 8)) & 0x7f, e1 = (w1 >> ((cj & 3) * 8)) & 0x7f;
        unsigned e = e0 * 128 + e1;
        o[r >> 2][r & 3] = (e << 16) | (cvtpk(ev[r] * inv, 0.f) & 0xffffu);
      }
      const int lnp = opq(lane);
      unsigned* pr = p.PAIRS + (tok0 + 64 * (size_t)(32 * (lnp >> 5) + (lnp & 31))) * 128 + w * 16;
#pragma unroll
      for (int q = 0; q < 4; ++q) *(u32x4*)(pr + 4 * q) = o[q];
    }
    __syncthreads();
#if P3_STOP == 2
    continue;
#endif
    gather_rows(p, tok0, w, lane, rinv2);
  }
}

#endif
#define SMEM_BYTES (ATILE_BYTES + 64 * 4 + 8 * 64 * 4)
__global__ void __launch_bounds__(NTHR) k_p0(MP p) { __shared__ __attribute__((aligned(16))) char smem[SMEM_BYTES]; phase0(p, smem); }
__global__ void __launch_bounds__(NTHR) k_p1(MP p) { __shared__ __attribute__((aligned(16))) char smem[SMEM_BYTES]; phase1(p, smem); }
__global__ void __launch_bounds__(NTHR) k_p2(MP p) { __shared__ __attribute__((aligned(16))) char smem[SMEM_BYTES]; phase2(p, smem); }
#if LEVEL >= 3
__global__ void __launch_bounds__(NTHR) k_p3(MP p) { __shared__ __attribute__((aligned(16))) char smem[SMEM_BYTES]; phase3(p, smem); }
#endif

#if LEVEL >= 3
__global__ void __launch_bounds__(NTHR) k_p3g(MP p) {
  __shared__ float rinv2[64];
  const int tid = threadIdx.x, lane = tid & 63, w = __builtin_amdgcn_readfirstlane(tid >> 6);
  for (int tt = blockIdx.x; tt < 1024; tt += gridDim.x) {
    const int b = tt >> 6, k1 = tt & 63;
    const size_t tok0 = (size_t)b * 4096 + k1;
    __syncthreads();
    for (int rr = 0; rr < 8; ++rr) {
      int row = 8 * w + rr;
      const float4* xp = (const float4*)(p.out + (tok0 + 64 * (size_t)row) * 1024);
      float s = 0.f;
      for (int i = lane; i < 256; i += 64) { float4 v = xp[i]; s += v.x * v.x + v.y * v.y + v.z * v.z + v.w * v.w; }
      for (int m = 32; m >= 1; m >>= 1) s += __shfl_xor(s, m, 64);
      if (lane == 0) rinv2[row] = rsqrtf(s * (1.0f / 1024.f) + 1e-6f);
    }
    __syncthreads();
    gather_rows(p, tok0, w, lane, rinv2);
  }
}
#endif

__global__ void k_u2z(const unsigned short* __restrict__ U, float* __restrict__ z) {
  size_t i = (size_t)blockIdx.x * blockDim.x + threadIdx.x;
  if (i >= (size_t)NTOK * 512) return;
  size_t tok = i >> 9; int c = (int)(i & 511);
  z[tok * DM + c] = bf2f(U[i]);
}
__global__ void k_stage3_naive(const unsigned short* __restrict__ M3T, const unsigned short* __restrict__ T, float* __restrict__ cat) {
  size_t i = (size_t)blockIdx.x * blockDim.x + threadIdx.x;
  if (i >= (size_t)NTOK * 512) return;
  size_t tok = i >> 9; int ch = (int)(i & 511);
  int b = (int)(tok >> 12), k = (int)(tok & 4095), k1 = k & 63;
  float s = 0.f;
  for (int q = 0; q < 128; ++q) s = fmaf(bf2f(M3T[(size_t)k * 128 + q]), bf2f(T[(((size_t)b * 64 + k1) * 128 + q) * 512 + ch]), s);
  cat[tok * DM + 512 + ch] = s;
}
__global__ void k_bf2f(const unsigned short* __restrict__ a, float* __restrict__ o, size_t n) {
  size_t i = (size_t)blockIdx.x * blockDim.x + threadIdx.x;
  if (i < n) o[i] = bf2f(a[i]);
}


__global__ void __launch_bounds__(256) k_expert_pairs(const float* __restrict__ x2, const float* __restrict__ rinv2, const float* __restrict__ g2,
                                               const unsigned* __restrict__ pairs,
                                               const float* __restrict__ eu, const float* __restrict__ ev, const float* __restrict__ fg,
                                               float* __restrict__ out) {
  __shared__ float red[4];
  __shared__ float bc;
  const size_t tok = blockIdx.x;
  const int tid = threadIdx.x, lane = tid & 63, w = tid >> 6;
  float4 xv = *(const float4*)(x2 + tok * DM + tid * 4);
  float4 gv = *(const float4*)(g2 + tid * 4);
  float ri = rinv2[tok];
  float4 h = make_float4(xv.x * ri * gv.x, xv.y * ri * gv.y, xv.z * ri * gv.z, xv.w * ri * gv.w);
  float4 acc = make_float4(0.f, 0.f, 0.f, 0.f);
  for (int j = 0; j < 128; ++j) {
    unsigned pw = pairs[tok * 128 + j];
    int e = (int)(pw >> 16);
    float gt = __uint_as_float(pw << 16);
    float4 uv = *(const float4*)(eu + (size_t)e * DM + tid * 4);
    float s = uv.x * h.x + uv.y * h.y + uv.z * h.z + uv.w * h.w;
    for (int m = 32; m >= 1; m >>= 1) s += __shfl_xor(s, m, 64);
    if (lane == 0) red[w] = s;
    __syncthreads();
    if (tid == 0) bc = red[0] + red[1] + red[2] + red[3];
    __syncthreads();
    float pre = bc;
    float a = gelu_exact(pre) * gt;
    float4 vv = *(const float4*)(ev + (size_t)e * DM + tid * 4);
    acc.x = fmaf(a, vv.x, acc.x); acc.y = fmaf(a, vv.y, acc.y); acc.z = fmaf(a, vv.z, acc.z); acc.w = fmaf(a, vv.w, acc.w);
  }
  float4 x3 = make_float4(xv.x + acc.x, xv.y + acc.y, xv.z + acc.z, xv.w + acc.w);
  float s = x3.x * x3.x + x3.y * x3.y + x3.z * x3.z + x3.w * x3.w;
  for (int m = 32; m >= 1; m >>= 1) s += __shfl_xor(s, m, 64);
  __syncthreads();
  if (lane == 0) red[w] = s;
  __syncthreads();
  float tot = red[0] + red[1] + red[2] + red[3];
  float r3 = rsqrtf(tot * (1.0f / DM) + 1e-6f);
  float4 fv = *(const float4*)(fg + tid * 4);
  *(float4*)(out + tok * DM + tid * 4) = make_float4(x3.x * r3 * fv.x, x3.y * r3 * fv.y, x3.z * r3 * fv.z, x3.w * r3 * fv.w);
}

__global__ void __launch_bounds__(256) k_expert_pairs_h(const float* __restrict__ x2, const float* __restrict__ rinv2,
                                               const unsigned* __restrict__ pairs,
                                               const _Float16* __restrict__ eu, const _Float16* __restrict__ ev, const float* __restrict__ fg,
                                               float* __restrict__ out) {
  __shared__ float red[4];
  __shared__ float bc;
  const size_t tok = blockIdx.x;
  const int tid = threadIdx.x, lane = tid & 63, w = tid >> 6;
  float4 xv = *(const float4*)(x2 + tok * DM + tid * 4);
  float ri = rinv2[tok];
  float4 acc = make_float4(0.f, 0.f, 0.f, 0.f);
  for (int j = 0; j < 128; ++j) {
    unsigned pw = pairs[tok * 128 + j];
    int e = (int)(pw >> 16);
    float gt = __uint_as_float(pw << 16);
    const _Float16* up = eu + (size_t)e * DM + tid * 4;
    float s = (float)up[0] * xv.x + (float)up[1] * xv.y + (float)up[2] * xv.z + (float)up[3] * xv.w;
    for (int m = 32; m >= 1; m >>= 1) s += __shfl_xor(s, m, 64);
    if (lane == 0) red[w] = s;
    __syncthreads();
    if (tid == 0) bc = red[0] + red[1] + red[2] + red[3];
    __syncthreads();
    float pre = bc * ri;
    float a = gelu_exact(pre) * gt;
    const _Float16* vp = ev + (size_t)e * DM + tid * 4;
    acc.x = fmaf(a, (float)vp[0], acc.x); acc.y = fmaf(a, (float)vp[1], acc.y); acc.z = fmaf(a, (float)vp[2], acc.z); acc.w = fmaf(a, (float)vp[3], acc.w);
  }
  float4 x3 = make_float4(xv.x + acc.x, xv.y + acc.y, xv.z + acc.z, xv.w + acc.w);
  float s = x3.x * x3.x + x3.y * x3.y + x3.z * x3.z + x3.w * x3.w;
  for (int m = 32; m >= 1; m >>= 1) s += __shfl_xor(s, m, 64);
  __syncthreads();
  if (lane == 0) red[w] = s;
  __syncthreads();
  float tot = red[0] + red[1] + red[2] + red[3];
  float r3 = rsqrtf(tot * (1.0f / DM) + 1e-6f);
  float4 fv = *(const float4*)(fg + tid * 4);
  *(float4*)(out + tok * DM + tid * 4) = make_float4(x3.x * r3 * fv.x, x3.y * r3 * fv.y, x3.z * r3 * fv.z, x3.w * r3 * fv.w);
}

#if LEVEL >= 3
extern "C" void kernel_launch(void* const* d_in, const int* in_sizes, int n_in, void* d_out, int out_size, void* d_ws, size_t ws_size,
                              hipStream_t stream) {
  float* out = (float*)d_out;
  char* arena1 = (char*)d_ws;
  size_t o1 = 0;
  auto A1 = [&](size_t bytes) { void* r = arena1 + o1; o1 += (bytes + 255) & ~(size_t)255; return r; };
  MP p;
  memset(&p, 0, sizeof(p));
  p.x = (const float*)d_in[0]; p.g1 = (const float*)d_in[1]; p.w_in = (const float*)d_in[2]; p.a_re = (const float*)d_in[3];
  p.a_im = (const float*)d_in[4]; p.log_step = (const float*)d_in[5]; p.b_re = (const float*)d_in[6]; p.b_im = (const float*)d_in[7];
  p.c_re = (const float*)d_in[8]; p.c_im = (const float*)d_in[9]; p.ssm_d = (const float*)d_in[10]; p.w_glu = (const float*)d_in[11];
  p.w_f = (const float*)d_in[12]; p.w_out = (const float*)d_in[13]; p.g2 = (const float*)d_in[14]; p.w_q = (const float*)d_in[15];
  p.keys = (const float*)d_in[16]; p.eu = (const float*)d_in[17]; p.ev = (const float*)d_in[18]; p.fg = (const float*)d_in[19];
  p.out = out;
  p.U = (unsigned short*)A1((size_t)NTOK * 512 * 2);
  p.T = (unsigned short*)A1((size_t)NTOK * 1024 * 2);
  p.YF = (unsigned short*)A1((size_t)NTOK * 512 * 2);
  p.YB = (unsigned short*)A1((size_t)NTOK * 512 * 2);
  p.PAIRS = (unsigned*)A1((size_t)NTOK * 128 * 4);
  p.EU = (_Float16*)A1((size_t)16384 * 1024 * 2);
  p.EV = (_Float16*)A1((size_t)16384 * 1024 * 2);
  p.WinF = (bf16x8*)A1((size_t)1024 * 1536 * 2);
  p.WgluF = (bf16x8*)A1((size_t)512 * 512 * 2);
  p.WoutF = (bf16x8*)A1((size_t)1024 * 1024 * 2);
  p.WqkF = (bf16x8*)A1((size_t)1024 * 2048 * 2);
  p.M1F = (bf16x8*)A1((size_t)128 * 128 * 2);
  p.M3T = (unsigned short*)A1((size_t)4096 * 128 * 2);
  p.s5lam = (float*)A1((size_t)64 * 64 * 2 * 4);
  p.s5B = (bf16x8*)A1((size_t)64 * 4 * 64 * 16);
  p.s5C = (bf16x8*)A1((size_t)64 * 4 * 64 * 16);
  hipLaunchKernelGGL(k_p0, dim3(256), dim3(NTHR), 0, stream, p);
  hipLaunchKernelGGL(k_p1, dim3(256), dim3(NTHR), 0, stream, p);
  hipLaunchKernelGGL(k_p2, dim3(256), dim3(NTHR), 0, stream, p);
  hipLaunchKernelGGL(k_p3, dim3(256), dim3(NTHR), 0, stream, p);
#if P3_STOP == 2
  {
    float* rinv2b = (float*)A1((size_t)NTOK * 4);
    hipLaunchKernelGGL(k_p3g, dim3(256), dim3(NTHR), 0, stream, p);
  }
#endif
#if P3_STOP == 1
  const float* norm2_g = p.g2;
  float* x2 = out;
  const int CH = 8192;
  float* qbuf = (float*)A1((size_t)CH * 2048 * 4);
  float* sc = (float*)A1((size_t)CH * 2048 * 4);
  float* rinv2 = (float*)A1((size_t)NTOK * 4);
  float* sval = (float*)A1((size_t)CH * 256 * 4);
  int* sidx = (int*)A1((size_t)CH * 256 * 4);
  int* eidx = (int*)A1((size_t)CH * 128 * 4);
  float* gate = (float*)A1((size_t)CH * 128 * 4);
  float* tval = (float*)A1((size_t)CH * 128 * 4);
  int* tpos = (int*)A1((size_t)CH * 128 * 4);
  hipLaunchKernelGGL(k_rinv, dim3(NTOK / 4), dim3(256), 0, stream, x2, rinv2, NTOK);
  for (int c0 = 0; c0 < NTOK; c0 += CH) {
    gemm(stream, x2 + (size_t)c0 * DM, DM, 0, p.w_q, 2048, 0, 0, qbuf, 2048, 0, CH, 2048, DM, 1, 1.f, 0.f, rinv2 + c0, norm2_g);
    gemm(stream, qbuf, 2048, 128, p.keys, 128, 128 * 128, 1, sc, 2048, 128, CH, 128, 128, 16, 1.f, 0.f, nullptr, nullptr);
    hipLaunchKernelGGL(k_topk, dim3((CH * 16) / 64), dim3(64), 0, stream, sc, sval, sidx, CH * 16, 128);
    hipLaunchKernelGGL(k_cand, dim3((CH * 8 * 256) / 256), dim3(256), 0, stream, sval, sc, CH * 8);
    hipLaunchKernelGGL(k_topk, dim3((CH * 8) / 64), dim3(64), 0, stream, sc, tval, tpos, CH * 8, 256);
    hipLaunchKernelGGL(k_finish, dim3((CH * 8) / 64), dim3(64), 0, stream, tval, tpos, sidx, eidx, gate, CH * 8);
    hipLaunchKernelGGL(k_expert, dim3(CH), dim3(256), 0, stream, x2, rinv2, norm2_g, eidx, gate, p.eu, p.ev, p.fg, out, c0);
  }
#endif
}
#else
extern "C" void kernel_launch(void* const* d_in, const int* in_sizes, int n_in, void* d_out, int out_size, void* d_ws, size_t ws_size,
                              hipStream_t stream) {
  const float* x = (const float*)d_in[0];
  const float* norm1_g = (const float*)d_in[1];
  const float* w_in = (const float*)d_in[2];
  const float* a_re = (const float*)d_in[3];
  const float* a_im = (const float*)d_in[4];
  const float* log_step = (const float*)d_in[5];
  const float* b_re = (const float*)d_in[6];
  const float* b_im = (const float*)d_in[7];
  const float* c_re = (const float*)d_in[8];
  const float* c_im = (const float*)d_in[9];
  const float* ssm_d = (const float*)d_in[10];
  const float* w_glu = (const float*)d_in[11];
  const float* w_fourier = (const float*)d_in[12];
  const float* w_out = (const float*)d_in[13];
  const float* norm2_g = (const float*)d_in[14];
  const float* w_query = (const float*)d_in[15];
  const float* sub_keys = (const float*)d_in[16];
  const float* expert_u = (const float*)d_in[17];
  const float* expert_v = (const float*)d_in[18];
  const float* final_g = (const float*)d_in[19];
  float* out = (float*)d_out;
  const size_t Q = (size_t)NTOK * DM;
  float* bufA = (float*)d_ws;
  float* bufB = bufA + Q;
  float* bufC = bufB + Q;
  char* arena1 = (char*)(bufC + Q);
  char* arena2 = (char*)d_out;
  size_t o1 = 0, o2 = 0;
  auto A1 = [&](size_t bytes) { void* r = arena1 + o1; o1 += (bytes + 255) & ~(size_t)255; return r; };
  auto A2 = [&](size_t bytes) { void* r = arena2 + o2; o2 += (bytes + 255) & ~(size_t)255; return r; };
  MP p;
  memset(&p, 0, sizeof(p));
  p.x = x; p.g1 = norm1_g; p.w_in = w_in; p.a_re = a_re; p.a_im = a_im; p.log_step = log_step; p.b_re = b_re; p.b_im = b_im;
  p.c_re = c_re; p.c_im = c_im; p.ssm_d = ssm_d; p.w_glu = w_glu; p.w_f = w_fourier; p.w_out = w_out; p.g2 = norm2_g; p.w_q = w_query;
  p.keys = sub_keys; p.eu = expert_u; p.ev = expert_v; p.fg = final_g; p.out = out;
  p.U = (unsigned short*)A1((size_t)NTOK * 512 * 2);
  p.T = (unsigned short*)A1((size_t)NTOK * 1024 * 2);
  p.WinF = (bf16x8*)A1((size_t)1024 * 1536 * 2);
  p.WgluF = (bf16x8*)A1((size_t)512 * 512 * 2);
  p.WoutF = (bf16x8*)A1((size_t)1024 * 1024 * 2);
  p.WqkF = (bf16x8*)A1((size_t)1024 * 2048 * 2);
  p.M1F = (bf16x8*)A1((size_t)128 * 128 * 2);
  p.M3T = (unsigned short*)A1((size_t)4096 * 128 * 2);
  p.s5lam = (float*)A1((size_t)64 * 64 * 2 * 4);
  p.s5B = (bf16x8*)A1((size_t)64 * 4 * 64 * 16);
  p.s5C = (bf16x8*)A1((size_t)64 * 4 * 64 * 16);
  p.EU = (_Float16*)A2((size_t)16384 * 1024 * 2);
  p.EV = (_Float16*)A2((size_t)16384 * 1024 * 2);
  p.YF = (unsigned short*)A2((size_t)NTOK * 512 * 2);
  p.YB = (unsigned short*)A2((size_t)NTOK * 512 * 2);
  p.PAIRS = (unsigned*)A2((size_t)NTOK * 128 * 4);

  hipLaunchKernelGGL(k_p0, dim3(256), dim3(NTHR), 0, stream, p);
  hipLaunchKernelGGL(k_p1, dim3(256), dim3(NTHR), 0, stream, p);
  hipLaunchKernelGGL(k_u2z, dim3((NTOK * 512) / 256), dim3(256), 0, stream, p.U, bufA);
  hipLaunchKernelGGL(k_stage3_naive, dim3((NTOK * 512) / 256), dim3(256), 0, stream, p.M3T, p.T, bufC);
  float* yf = bufB; float* yb = bufB + (size_t)NTOK * 512;
#if LEVEL >= 2
  hipLaunchKernelGGL(k_p2, dim3(256), dim3(NTHR), 0, stream, p);
  hipLaunchKernelGGL(k_bf2f, dim3((NTOK * 512) / 256), dim3(256), 0, stream, p.YF, yf, (size_t)NTOK * 512);
  hipLaunchKernelGGL(k_bf2f, dim3((NTOK * 512) / 256), dim3(256), 0, stream, p.YB, yb, (size_t)NTOK * 512);
#else
  hipLaunchKernelGGL(k_s5, dim3(NB * 32 * 2), dim3(64), 0, stream, bufA, a_re, a_im, log_step, b_re, b_im, c_re, c_im, bufB);
#endif
  hipLaunchKernelGGL(k_ssm_post, dim3((NTOK * 512) / 256), dim3(256), 0, stream, yf, yb, bufA, ssm_d);
  gemm(stream, yf, 512, 0, w_glu, 512, 0, 0, yb, 512, 0, NTOK, 512, 512, 1, 1.f, 0.f, nullptr, nullptr);
  hipLaunchKernelGGL(k_glu, dim3((NTOK * 512) / 256), dim3(256), 0, stream, yf, yb, bufC);
  gemm(stream, bufC, DM, 0, w_out, DM, 0, 0, bufA, DM, 0, NTOK, DM, DM, 1, 1.f, 0.f, nullptr, nullptr);
  hipLaunchKernelGGL(k_add, dim3((unsigned)(Q / 4 / 256)), dim3(256), 0, stream, bufA, x);
  float* x2 = bufA;
  const int CH = 8192;
  float* qbuf = bufB;
  float* sc = bufB + (size_t)CH * 2048;
  float* small = bufB + (size_t)2 * CH * 2048;
  float* rinv2 = small;
  float* sval = rinv2 + NTOK;
  int* sidx = (int*)(sval + (size_t)CH * 16 * 16);
  int* eidx = sidx + (size_t)CH * 16 * 16;
  float* gate = (float*)(eidx + (size_t)CH * 128);
  float* tval = gate + (size_t)CH * 128;
  int* tpos = (int*)(tval + (size_t)CH * 128);
  hipLaunchKernelGGL(k_rinv, dim3(NTOK / 4), dim3(256), 0, stream, x2, rinv2, NTOK);
  float* outtmp = bufC;
  for (int c0 = 0; c0 < NTOK; c0 += CH) {
    gemm(stream, x2 + (size_t)c0 * DM, DM, 0, w_query, 2048, 0, 0, qbuf, 2048, 0, CH, 2048, DM, 1, 1.f, 0.f, rinv2 + c0, norm2_g);
    gemm(stream, qbuf, 2048, 128, sub_keys, 128, 128 * 128, 1, sc, 2048, 128, CH, 128, 128, 16, 1.f, 0.f, nullptr, nullptr);
    hipLaunchKernelGGL(k_topk, dim3((CH * 16) / 64), dim3(64), 0, stream, sc, sval, sidx, CH * 16, 128);
    hipLaunchKernelGGL(k_cand, dim3((CH * 8 * 256) / 256), dim3(256), 0, stream, sval, sc, CH * 8);
    hipLaunchKernelGGL(k_topk, dim3((CH * 8) / 64), dim3(64), 0, stream, sc, tval, tpos, CH * 8, 256);
    hipLaunchKernelGGL(k_finish, dim3((CH * 8) / 64), dim3(64), 0, stream, tval, tpos, sidx, eidx, gate, CH * 8);
    hipLaunchKernelGGL(k_expert, dim3(CH), dim3(256), 0, stream, x2, rinv2, norm2_g, eidx, gate, expert_u, expert_v, final_g, outtmp, c0);
  }
  (void)hipMemcpyAsync(out, outtmp, Q * sizeof(float), hipMemcpyDeviceToDevice, stream);
}

#endif
```

```cpp
#include <hip/hip_runtime.h>
#include <stdint.h>
#include <string.h>
#include <stdio.h>

#define NTOK 65536

__device__ __forceinline__ void dsincos(double x, double* s, double* c) {
  double q = rint(x * 0.63661977236758134308);
  double r = fma(-q, 1.57079632679489655800, x);
  r = fma(-q, 6.12323399573676603587e-17, r);
  double r2 = r * r;
  double sp = r * (1.0 + r2 * (-1.0 / 6 + r2 * (1.0 / 120 + r2 * (-1.0 / 5040 + r2 * (1.0 / 362880 + r2 * (-1.0 / 39916800 + r2 * (1.0 / 6227020800.0 + r2 * (-1.0 / 1307674368000.0))))))));
  double cp = 1.0 + r2 * (-0.5 + r2 * (1.0 / 24 + r2 * (-1.0 / 720 + r2 * (1.0 / 40320 + r2 * (-1.0 / 3628800 + r2 * (1.0 / 479001600.0 + r2 * (-1.0 / 87178291200.0)))))));
  long long qi = (long long)q;
  int m = (int)(qi & 3);
  double ss = (m == 0) ? sp : (m == 1) ? cp : (m == 2) ? -sp : -cp;
  double cc = (m == 0) ? cp : (m == 1) ? -sp : (m == 2) ? -cp : sp;
  *s = ss; *c = cc;
}

typedef short bf16x8 __attribute__((ext_vector_type(8)));
typedef float f32x16 __attribute__((ext_vector_type(16)));
typedef float f32x4 __attribute__((ext_vector_type(4)));
typedef unsigned u32x4 __attribute__((ext_vector_type(4)));
typedef unsigned u32x2 __attribute__((ext_vector_type(2)));
typedef float f32x2_t __attribute__((ext_vector_type(2)));
typedef __bf16 bf16x2_t __attribute__((ext_vector_type(2)));
typedef _Float16 f16x2_t __attribute__((ext_vector_type(2)));
typedef _Float16 f16x8_t __attribute__((ext_vector_type(8)));
__device__ __forceinline__ f16x2_t as_h2(unsigned v) { return __builtin_bit_cast(f16x2_t, v); }
#define DI __device__ __forceinline__
#define MFMA32(a, b, c) __builtin_amdgcn_mfma_f32_32x32x16_bf16((a), (b), (c), 0, 0, 0)
#define MFMA16(a, b, c) __builtin_amdgcn_mfma_f32_16x16x32_bf16((a), (b), (c), 0, 0, 0)
#define NTHR 512
#define ASTRIDE 2064
#define ATILE_BYTES (64 * ASTRIDE)

DI unsigned cvtpk(float lo, float hi) { f32x2_t v = {lo, hi}; bf16x2_t b = __builtin_convertvector(v, bf16x2_t); return __builtin_bit_cast(unsigned, b); }
DI unsigned short f2bf(float x) { return (unsigned short)(cvtpk(x, 0.f) & 0xffffu); }
DI float bf2f(unsigned h) { return __uint_as_float(h << 16); }
DI float bflo(unsigned w) { return __uint_as_float(w << 16); }
DI float bfhi(unsigned w) { return __uint_as_float(w & 0xffff0000u); }
DI int crow(int reg, int h) { return (reg & 3) + 8 * (reg >> 2) + 4 * h; }
DI f32x16 zero16() { f32x16 z; for (int i = 0; i < 16; ++i) z[i] = 0.f; return z; }

struct MP {
  const float *x, *g1, *w_in, *a_re, *a_im, *log_step, *b_re, *b_im, *c_re, *c_im, *ssm_d, *w_glu, *w_f, *w_out, *g2, *w_q, *keys, *eu, *ev, *fg;
  float* out;
  bf16x8 *WinF, *WgluF, *WoutF, *WqkF, *M1F, *s5B, *s5C;
  unsigned short *M3T, *U, *T, *YF, *YB;
  unsigned char *EU, *EV;
  float* s5lam;
  unsigned* PAIRS;
  unsigned short* E16;
  unsigned* bar;
  unsigned* CTR;
  float *RINV2, *PRE;
  unsigned short* OUTB;
  unsigned short* X2B;
  unsigned char *ACTH, *ACTL;
  unsigned char *X8H, *X8L;
};

DI void s5_params(const MP& p, int dg, int pp, float& lr, float& li, double& fr, double& fi) {
  double are = p.a_re[dg * 64 + pp], aim = p.a_im[dg * 64 + pp];
  double step = exp((double)p.log_step[dg]);
  double sn_, cs_;
  dsincos(aim * step, &sn_, &cs_);
  double mag = exp(are * step);
  double lrd = mag * cs_, lid = mag * sn_;
  double nr = lrd - 1.0, ni = lid;
  double den = are * are + aim * aim;
  fr = (nr * are + ni * aim) / den; fi = (ni * are - nr * aim) / den;
  lr = (float)lrd; li = (float)lid;
}

DI int opq(int v) { asm volatile("" : "+v"(v)); return v; }
DI unsigned opqu(unsigned v) { asm volatile("" : "+v"(v)); return v; }
DI unsigned opqs(unsigned v) { asm volatile("" : "+s"(v)); return v; }
DI void fold_dot8(float (&out)[8], const float* __restrict__ w0, size_t wstride, const float* lds, int stride, int n4) {
#pragma unroll
  for (int j = 0; j < 8; ++j) out[j] = 0.f;
#pragma unroll 2
  for (int m4 = 0; m4 < n4; ++m4) {
    const float l0 = lds[(4 * m4) * stride], l1 = lds[(4 * m4 + 1) * stride], l2 = lds[(4 * m4 + 2) * stride], l3 = lds[(4 * m4 + 3) * stride];
#pragma unroll
    for (int j = 0; j < 8; ++j) {
      const float4 wv = ((const float4*)(w0 + j * wstride))[m4];
      out[j] = fmaf(wv.x, l0, out[j]); out[j] = fmaf(wv.y, l1, out[j]); out[j] = fmaf(wv.z, l2, out[j]); out[j] = fmaf(wv.w, l3, out[j]);
    }
  }
}
DI void conv_frag(bf16x8* dst, const float* __restrict__ src, int ld, const float* __restrict__ kscale, int ntiles, int KS, long gtid, long gsz) {
  const long total = (long)ntiles * KS * 64;
#pragma unroll 1
  for (long u = gtid; u < total; u += gsz) {
    int lane = (int)(u & 63);
    long q = u >> 6;
    int ks = (int)(q % KS), nt = (int)(q / KS);
    int n = 32 * nt + (lane & 31), k0 = 16 * ks + 8 * (lane >> 5);
    u32x4 w;
#pragma unroll
    for (int jj = 0; jj < 4; ++jj) {
      int k = k0 + 2 * jj;
      float a = src[(size_t)k * ld + n], b = src[(size_t)(k + 1) * ld + n];
      if (kscale) { a *= kscale[k]; b *= kscale[k + 1]; }
      w[jj] = cvtpk(a, b);
    }
    dst[u] = __builtin_bit_cast(bf16x8, w);
  }
}

DI void late_prep(const MP& p, long gtid, long gsz) {
#pragma unroll 1
  for (long u = gtid; u < 4096 * 128; u += gsz) {
    int s2ri = (int)(u & 127), k = (int)(u >> 7);
    int ri = s2ri >> 6, s2 = s2ri & 63;
    double sv, cv;
    dsincos(6.283185307179586476925 * (double)((k * s2) & 4095) / 4096.0, &sv, &cv);
    p.M3T[u] = f2bf((float)(ri ? sv : cv));
  }
#pragma unroll 1
  for (long u = gtid; u < (long)16384 * 1024 / 16; u += gsz) {
    int d0 = (int)((u * 16) & 1023);
    const float4* s = (const float4*)(p.eu + u * 16);
    const float4* gq = (const float4*)(p.g2 + d0);
    const float4* s2 = (const float4*)(p.ev + u * 16);
    u32x4 ou, ov;
#pragma unroll
    for (int q = 0; q < 4; ++q) {
      float4 a = s[q], g = gq[q], b = s2[q];
      {
        const int q0 = (int)rintf(__builtin_amdgcn_fmed3f(a.x * g.x * 1024.f, -127.f, 127.f)), q1 = (int)rintf(__builtin_amdgcn_fmed3f(a.y * g.y * 1024.f, -127.f, 127.f));
        const int q2 = (int)rintf(__builtin_amdgcn_fmed3f(a.z * g.z * 1024.f, -127.f, 127.f)), q3 = (int)rintf(__builtin_amdgcn_fmed3f(a.w * g.w * 1024.f, -127.f, 127.f));
        ou[q] = (unsigned)(q0 & 0xff) | ((unsigned)(q1 & 0xff) << 8) | ((unsigned)(q2 & 0xff) << 16) | ((unsigned)(q3 & 0xff) << 24);
      }
      int w2 = __builtin_amdgcn_cvt_pk_fp8_f32(b.x * 4.f, b.y * 4.f, 0, false);
      w2 = __builtin_amdgcn_cvt_pk_fp8_f32(b.z * 4.f, b.w * 4.f, w2, true);
      ov[q] = (unsigned)w2;
    }
    {
      const long e = u >> 6; const int c16 = (int)(u & 63);
      const size_t dst = (((size_t)(c16 >> 3) * 16384 + (size_t)e) * 128) + (size_t)(c16 & 7) * 16;
      *(u32x4*)(p.EU + dst) = ou;
      *(u32x4*)(p.EV + dst) = ov;
    }
  }
}

DI void phase0(const MP& p, char* smem) {
  const int tid = threadIdx.x;
  const long gtid = (long)blockIdx.x * NTHR + tid;
  const long gsz = (long)gridDim.x * NTHR;
  conv_frag(p.WinF, p.w_in, 1024, p.g1, 16, 64, gtid, gsz);
  conv_frag(p.WgluF, p.w_glu, 512, nullptr, 16, 32, gtid, gsz);
  conv_frag(p.WoutF, p.w_out, 1024, nullptr, 32, 64, gtid, gsz);
#pragma unroll 1
  for (long u = gtid; u < 4 * 8 * 64; u += gsz) {
    int lane = (int)(u & 63), ks = (int)((u >> 6) & 7), mt = (int)(u >> 9);
    int row = 32 * mt + (lane & 31), h = lane >> 5;
    int ri = row >> 6, k1 = row & 63;
    u32x4 w;
#pragma unroll
    for (int jj = 0; jj < 4; ++jj) {
      float v2[2];
#pragma unroll
      for (int e = 0; e < 2; ++e) {
        int j = 2 * jj + e;
        int col = 16 * ks + 8 * (j >> 2) + 4 * h + (j & 3);
        int ab = col >> 6, s1 = col & 63;
        double sv, cv;
        dsincos(6.283185307179586476925 * (double)((k1 * s1) & 63) / 64.0, &sv, &cv);
        double val = (ri == 0) ? (ab == 0 ? cv : -sv) : (ab == 0 ? -sv : -cv);
        v2[e] = (float)val;
      }
      w[jj] = cvtpk(v2[0], v2[1]);
    }
    p.M1F[u] = __builtin_bit_cast(bf16x8, w);
  }
#pragma unroll 1
  for (long u = gtid; u < 64 * 64; u += gsz) {
    int pp = (int)(u & 63), dg = (int)(u >> 6);
    float lr, li; double fr, fi;
    s5_params(p, dg, pp, lr, li, fr, fi);
    p.s5lam[u * 2] = lr; p.s5lam[u * 2 + 1] = li;
  }
#pragma unroll 1
  for (long u = gtid; u < 64 * 4 * 64; u += gsz) {
    int lane = (int)(u & 63), nt = (int)((u >> 6) & 3), dg = (int)(u >> 8);
    int col = 32 * nt + (lane & 31), ri = col >> 6, pp = col & 63, h = lane >> 5;
    float lr, li; double fr, fi;
    s5_params(p, dg, pp, lr, li, fr, fi);
    const float* brp = p.b_re + ((size_t)dg * 64 + pp) * 16 + 8 * h;
    const float* bip = p.b_im + ((size_t)dg * 64 + pp) * 16 + 8 * h;
    u32x4 w;
#pragma unroll
    for (int jj = 0; jj < 4; ++jj) {
      double br0 = brp[2 * jj], bi0 = bip[2 * jj], br1 = brp[2 * jj + 1], bi1 = bip[2 * jj + 1];
      float v0 = (float)(ri ? (fr * bi0 + fi * br0) : (fr * br0 - fi * bi0));
      float v1 = (float)(ri ? (fr * bi1 + fi * br1) : (fr * br1 - fi * bi1));
      w[jj] = cvtpk(v0, v1);
    }
    p.s5B[u] = __builtin_bit_cast(bf16x8, w);
  }
#pragma unroll 1
  for (long u = gtid; u < 64 * 4 * 64; u += gsz) {
    int lane = (int)(u & 63), ks = (int)((u >> 6) & 3), dg = (int)(u >> 8);
    int c = lane & 15;
    u32x4 w;
#pragma unroll
    for (int jj = 0; jj < 4; ++jj) {
      int kk = 32 * ks + 8 * (lane >> 4) + 2 * jj;
      int pt = kk >> 6, pq = (kk & 63) >> 1;
      int pp = 32 * pt + pq;
      float vre = p.c_re[((size_t)dg * 16 + c) * 64 + pp];
      float vim = -p.c_im[((size_t)dg * 16 + c) * 64 + pp];
      w[jj] = cvtpk(vre, vim);
    }
    p.s5C[u] = __builtin_bit_cast(bf16x8, w);
  }
  {
    float* AB = (float*)smem;
    float* tab = AB + 128 * 32;
    const float nrm = 1.0f / sqrtf(4096.f * 128.f);
#pragma unroll 1
    for (int task = blockIdx.x; task < 128; task += gridDim.x) {
      int ntp = task >> 2, kq = task & 3;
      int ab = ntp >> 4, chbase = (ntp & 15) * 32, g = chbase >> 7, d0 = chbase & 127;
      __syncthreads();
      if (tid < 128) {
        double sv, cv;
        dsincos(6.283185307179586476925 * (double)tid / 128.0, &sv, &cv);
        tab[tid] = (float)(ab ? sv : cv);
      }
      __syncthreads();
#pragma unroll 1
      for (int o = tid; o < 128 * 32; o += NTHR) {
        int m = o >> 5, dd = o & 31;
        float s = 0.f;
#pragma unroll 4
        for (int c = 0; c < 128; ++c) s = fmaf(tab[(m * c) & 127], p.w_f[((size_t)g * 128 + c) * 128 + d0 + dd], s);
        AB[o] = s * nrm;
      }
      __syncthreads();
#pragma unroll 1
      for (int uu = tid; uu < 16 * 64; uu += NTHR) {
        int lane = uu & 63, ks = kq * 16 + (uu >> 6);
        int dd = lane & 31, h = lane >> 5;
        u32x4 w;
        {
          const int k0 = 16 * ks + 8 * h;
          float sv[8];
          fold_dot8(sv, p.w_in + (size_t)k0 * 1024 + 512 + 128 * g, 1024, AB + dd, 32, 32);
#pragma unroll
          for (int jj = 0; jj < 4; ++jj) w[jj] = cvtpk(sv[2 * jj] * p.g1[k0 + 2 * jj], sv[2 * jj + 1] * p.g1[k0 + 2 * jj + 1]);
        }
        p.WinF[((size_t)(16 + ntp) * 64 + ks) * 64 + lane] = __builtin_bit_cast(bf16x8, w);
      }
    }
  }
  {
    float* Ks = (float*)smem;
#pragma unroll 1
    for (int task = (int)((blockIdx.x + gridDim.x / 2) % gridDim.x); task < 128; task += gridDim.x) {
      int hp = task >> 3, kt = (task >> 1) & 3, chalf = task & 1;
      __syncthreads();
#pragma unroll 1
      for (int o = tid; o < 32 * 128; o += NTHR) {
        int kk = o >> 7, d = o & 127;
        Ks[kk * 129 + d] = p.keys[((size_t)hp * 128 + kt * 32 + kk) * 128 + d];
      }
      __syncthreads();
#pragma unroll 1
      for (int uu = tid; uu < 32 * 64; uu += NTHR) {
        int lane = uu & 63, ks = chalf * 32 + (uu >> 6);
        int kk = lane & 31, h = lane >> 5;
        u32x4 w;
        {
          const int c0 = 16 * ks + 8 * h;
          float sv[8];
          fold_dot8(sv, p.w_q + (size_t)c0 * 2048 + hp * 128, 2048, Ks + kk * 129, 1, 32);
#pragma unroll
          for (int jj = 0; jj < 4; ++jj) w[jj] = cvtpk(sv[2 * jj] * p.g2[c0 + 2 * jj], sv[2 * jj + 1] * p.g2[c0 + 2 * jj + 1]);
        }
        p.WqkF[((size_t)(hp * 4 + kt) * 64 + ks) * 64 + lane] = __builtin_bit_cast(bf16x8, w);
      }
    }
  }
}

#define PD 4
template <int NT, int PDT>
DI void gemm_tile(f32x16 (&acc)[2][NT], const char* atile, int acol0, const bf16x8* __restrict__ wf, int KS, int nks, int lane, int stride2 = 2) {
  const char* abase = atile + (lane & 31) * ASTRIDE + (acol0 + 8 * (lane >> 5)) * 2;
  const char* wbase = (const char*)wf;
  const unsigned loff = (unsigned)lane * 16u;
  unsigned noff[NT];
#pragma unroll
  for (int nt = 0; nt < NT; ++nt) noff[nt] = (unsigned)(((nt & 1) + (nt >> 1) * stride2) * KS) * 1024u;
  bf16x8 bq[PDT][NT];
#pragma unroll
  for (int d = 0; d < PDT; ++d)
#pragma unroll
    for (int nt = 0; nt < NT; ++nt) bq[d][nt] = *(const bf16x8*)(wbase + (noff[nt] + (unsigned)d * 1024u) + loff);
#pragma unroll 1
  for (int ks0 = 0; ks0 < nks; ks0 += PDT) {
#pragma unroll
    for (int d = 0; d < PDT; ++d) {
      const int ks = ks0 + d;
      bf16x8 a0 = *(const bf16x8*)(abase + ks * 32);
      bf16x8 a1 = *(const bf16x8*)(abase + 32 * ASTRIDE + ks * 32);
      bf16x8 b[NT];
#pragma unroll
      for (int nt = 0; nt < NT; ++nt) b[nt] = bq[d][nt];
      const unsigned ksn = (unsigned)min(ks + PDT, nks - 1) * 1024u;
#pragma unroll
      for (int nt = 0; nt < NT; ++nt) bq[d][nt] = *(const bf16x8*)(wbase + (noff[nt] + ksn) + loff);
#pragma unroll
      for (int nt = 0; nt < NT; ++nt) {
        acc[0][nt] = MFMA32(a0, b[nt], acc[0][nt]);
        acc[1][nt] = MFMA32(a1, b[nt], acc[1][nt]);
      }
    }
  }
}

DI bf16x8 pack_step(const f32x16& x, int s) {
  u32x4 w;
  w[0] = cvtpk(x[8 * s + 0], x[8 * s + 1]); w[1] = cvtpk(x[8 * s + 2], x[8 * s + 3]);
  w[2] = cvtpk(x[8 * s + 4], x[8 * s + 5]); w[3] = cvtpk(x[8 * s + 6], x[8 * s + 7]);
  return __builtin_bit_cast(bf16x8, w);
}


template <typename PT>
DI void store_tile_pairs(const float (&vals)[16], PT base, unsigned rs, bool odd) {
#pragma unroll
  for (int r = 0; r < 16; r += 2) {
    const float send = odd ? vals[r] : vals[r + 1];
    const float recv = __builtin_bit_cast(float, __builtin_amdgcn_mov_dpp(__builtin_bit_cast(int, send), 0xB1, 0xF, 0xF, true));
    const float lo = odd ? recv : vals[r];
    const float hi = odd ? vals[r + 1] : recv;
    const int rc = (r & 3) + 8 * (r >> 2);
    *(unsigned*)(base + (size_t)rc * rs) = cvtpk(lo, hi);
  }
}
DI void phase1(const MP& p, char* smem) {
  const int tid = threadIdx.x, w = __builtin_amdgcn_readfirstlane(tid >> 6);
  char* atile = smem;
  float* rinv = (float*)(smem + ATILE_BYTES);
  for (int tt = blockIdx.x; tt < 1024; tt += gridDim.x) {
    const int b = tt >> 6, s2 = tt & 63;
    const int lane = opq((int)threadIdx.x & 63), h = lane >> 5;
    __syncthreads();
    {
      float4 v[8][4];
#pragma unroll
      for (int rr = 0; rr < 8; ++rr) {
        const float4* xp = (const float4*)(p.x + ((size_t)b * 4096 + 64 * (w * 8 + rr) + s2) * 1024);
#pragma unroll
        for (int i = 0; i < 4; ++i) v[rr][i] = xp[lane + 64 * i];
      }
#pragma unroll
      for (int rr = 0; rr < 8; ++rr) {
        const int r = w * 8 + rr;
        float s = 0.f;
#pragma unroll
        for (int i = 0; i < 4; ++i) s += v[rr][i].x * v[rr][i].x + v[rr][i].y * v[rr][i].y + v[rr][i].z * v[rr][i].z + v[rr][i].w * v[rr][i].w;
        for (int m = 32; m >= 1; m >>= 1) s += __shfl_xor(s, m, 64);
        if (lane == 0) rinv[r] = rsqrtf(s * (1.0f / 1024.f) + 1e-6f);
#pragma unroll
        for (int i = 0; i < 4; ++i) {
          u32x2 pk; pk[0] = cvtpk(v[rr][i].x, v[rr][i].y); pk[1] = cvtpk(v[rr][i].z, v[rr][i].w);
          *(u32x2*)(atile + r * ASTRIDE + (lane + 64 * i) * 8) = pk;
        }
      }
    }
    __syncthreads();
    {
      f32x16 acc[2][2];
#pragma unroll
      for (int i = 0; i < 2; ++i)
#pragma unroll
        for (int j = 0; j < 2; ++j) acc[i][j] = zero16();
      gemm_tile<2, 4>(acc, atile, 0, p.WinF + (size_t)(2 * w) * 64 * 64, 64, 64, lane);
      {
        const bool odd = (lane & 1) != 0;
        const unsigned ubase = (unsigned)((((size_t)b * 4096 + s2 + 64 * (4 * h + (odd ? 1 : 0))) * 512 + 64 * w + ((lane & 31) & ~1)) * 2);
#pragma unroll
        for (int mt = 0; mt < 2; ++mt)
#pragma unroll
          for (int nt = 0; nt < 2; ++nt) {
            const unsigned tb = opqu(ubase + (unsigned)((32 * mt * 64 * 512 + 32 * nt) * 2));
            const float* rvp = rinv + opq(32 * mt + 4 * h);
            float vals[16];
#pragma unroll
            for (int r = 0; r < 16; ++r) vals[r] = acc[mt][nt][r] * rvp[(r & 3) + 8 * (r >> 2)];
            store_tile_pairs(vals, (char*)p.U + tb, 64u * 512u * 2u, odd);
          }
      }
    }
    {
      bf16x8 xs[8][2];
      {
        f32x16 acc[2][4];
#pragma unroll
        for (int i = 0; i < 2; ++i)
#pragma unroll
          for (int j = 0; j < 4; ++j) acc[i][j] = zero16();
        gemm_tile<4, 2>(acc, atile, 0, p.WinF + (size_t)(16 + 2 * w) * 64 * 64, 64, 64, opq(lane), 16);
#pragma unroll
        for (int mt = 0; mt < 2; ++mt) {
#pragma unroll
          for (int c = 0; c < 4; ++c) {
            const float* rvp = rinv + opq(32 * mt + 4 * h);
#pragma unroll
            for (int r = 0; r < 16; ++r) acc[mt][c][r] *= rvp[(r & 3) + 8 * (r >> 2)];
            const int ab = c >> 1, nt = c & 1;
            xs[ab * 4 + mt * 2 + 0][nt] = pack_step(acc[mt][c], 0);
            xs[ab * 4 + mt * 2 + 1][nt] = pack_step(acc[mt][c], 1);
          }
        }
      }
#pragma unroll
      for (int mt = 0; mt < 4; ++mt) {
        f32x16 t0 = zero16(), t1 = zero16();
        const bf16x8* mf = p.M1F + (size_t)(opq(mt * 8)) * 64 + lane;
#pragma unroll
        for (int ks = 0; ks < 8; ++ks) {
          bf16x8 a = mf[ks * 64];
          t0 = MFMA32(a, xs[ks][0], t0);
          t1 = MFMA32(a, xs[ks][1], t1);
        }
        const int ri = mt >> 1;
        const bool odd = (lane & 1) != 0;
        const unsigned tbase = opqu((unsigned)(((((size_t)b * 64 + 32 * (mt & 1) + 4 * h + (odd ? 1 : 0)) * 128 + ri * 64 + s2) * 512 + 64 * w + ((lane & 31) & ~1)) * 2));
        float v0[16], v1[16];
#pragma unroll
        for (int r = 0; r < 16; ++r) { v0[r] = t0[r]; v1[r] = t1[r]; }
        store_tile_pairs(v0, (char*)p.T + tbase, 128u * 512u * 2u, odd);
        store_tile_pairs(v1, (char*)p.T + tbase + 64, 128u * 512u * 2u, odd);
      }
    }
  }
}

#define XS_STRIDE 272
#define XS_BYTES (32 * XS_STRIDE)
DI void phase2(const MP& p, char* smem) {
  const int tid = threadIdx.x, lane = tid & 63, w = __builtin_amdgcn_readfirstlane(tid >> 6), h = lane >> 5;
  {
    const int nactive = min(8, (512 + (int)gridDim.x - 1) / (int)gridDim.x);
    if (nactive >= 8) {
      late_prep(p, (long)blockIdx.x * NTHR + tid, (long)gridDim.x * NTHR);
    } else if (w >= nactive) {
      const long nidle = 8 - nactive;
      late_prep(p, ((long)blockIdx.x * nidle + (w - nactive)) * 64 + lane, (long)gridDim.x * nidle * 64);
    }
  }
#pragma unroll 1
  for (int task = w * gridDim.x + blockIdx.x; task < 512; task += 8 * gridDim.x) {
    const int dir = task & 1, g = (task >> 1) & 31, bp = task >> 6;
    const int dg = dir * 32 + g;
    char* xt = smem + w * XS_BYTES;
    bf16x8 bfr[4], cf[4];
#pragma unroll
    for (int nt = 0; nt < 4; ++nt) bfr[nt] = p.s5B[(size_t)(dg * 4 + nt) * 64 + lane];
#pragma unroll
    for (int ks = 0; ks < 4; ++ks) cf[ks] = p.s5C[(size_t)(dg * 4 + ks) * 64 + lane];
    const int pp = lane & 31;
    const float lr0 = p.s5lam[((size_t)dg * 64 + pp) * 2], li0 = p.s5lam[((size_t)dg * 64 + pp) * 2 + 1];
    const float lr1 = p.s5lam[((size_t)dg * 64 + 32 + pp) * 2], li1 = p.s5lam[((size_t)dg * 64 + 32 + pp) * 2 + 1];
    const int rho = lane & 31;
    const int hr = (rho >> 2) & 1, rr = (rho & 3) + 4 * (rho >> 3);
    const size_t ubase = ((size_t)(2 * bp + hr) * 4096) * 512 + g * 16 + 8 * h;
    float xr0 = 0.f, xi0 = 0.f, xr1 = 0.f, xi1 = 0.f;
    bf16x8 aq[4];
#pragma unroll
    for (int d = 0; d < 4; ++d) { int q = 16 * d + rr; int tpos = dir ? (4095 - q) : q; aq[d] = *(const bf16x8*)(p.U + ubase + (size_t)tpos * 512); }
    unsigned short* yo = dir ? p.YB : p.YF;
#pragma unroll 1
    for (int step0 = 0; step0 < 256; step0 += 4) {
#pragma unroll
      for (int d = 0; d < 4; ++d) {
        const int step = step0 + d;
        bf16x8 a = aq[d];
        { int q = 16 * min(step + 4, 255) + rr; int tpos = dir ? (4095 - q) : q; aq[d] = *(const bf16x8*)(p.U + ubase + (size_t)tpos * 512); }
        f32x16 br0 = MFMA32(a, bfr[0], zero16());
        f32x16 br1 = MFMA32(a, bfr[1], zero16());
        f32x16 bi0 = MFMA32(a, bfr[2], zero16());
        f32x16 bi1 = MFMA32(a, bfr[3], zero16());
        char* xrow = xt + (h * 16) * XS_STRIDE + (2 * (lane & 31)) * 2;
#pragma unroll
        for (int r = 0; r < 16; ++r) {
          float n0r = fmaf(lr0, xr0, fmaf(-li0, xi0, br0[r]));
          float n0i = fmaf(lr0, xi0, fmaf(li0, xr0, bi0[r]));
          float n1r = fmaf(lr1, xr1, fmaf(-li1, xi1, br1[r]));
          float n1i = fmaf(lr1, xi1, fmaf(li1, xr1, bi1[r]));
          xr0 = n0r; xi0 = n0i; xr1 = n1r; xi1 = n1i;
          *(unsigned*)(xrow + r * XS_STRIDE) = cvtpk(xr0, xi0);
          *(unsigned*)(xrow + r * XS_STRIDE + 128) = cvtpk(xr1, xi1);
        }
        __builtin_amdgcn_wave_barrier();
#pragma unroll
        for (int mt = 0; mt < 2; ++mt) {
          f32x4 y = {0.f, 0.f, 0.f, 0.f};
#pragma unroll
          for (int ks = 0; ks < 4; ++ks) {
            bf16x8 xa = *(const bf16x8*)(xt + (mt * 16 + (lane & 15)) * XS_STRIDE + (32 * ks + 8 * (lane >> 4)) * 2);
            y = MFMA16(xa, cf[ks], y);
          }
          {
            const bool odd = (lane & 1) != 0;
#pragma unroll
            for (int r = 0; r < 4; r += 2) {
              const float send = odd ? y[r] : y[r + 1];
              const float recv = __builtin_bit_cast(float, __builtin_amdgcn_mov_dpp(__builtin_bit_cast(int, send), 0xB1, 0xF, 0xF, true));
              const float lo = odd ? recv : y[r], hi = odd ? y[r + 1] : recv;
              const int q = 16 * step + 4 * (lane >> 4) + r + (odd ? 1 : 0);
              const int tpos = dir ? (4095 - q) : q;
              *(unsigned*)(yo + ((size_t)(2 * bp + mt) * 4096 + tpos) * 512 + g * 16 + ((lane & 15) & ~1)) = cvtpk(lo, hi);
            }
          }
        }
        __builtin_amdgcn_wave_barrier();
      }
    }
  }
}
DI int f2key(float f) { return __float_as_int(__builtin_amdgcn_fmed3f(f, -60.f, 60.f) + 64.f); }
DI float key2f(int k) { return __int_as_float(k) - 64.f; }
#define CE_DESC(a, b) { int mx_ = max(a, b), mn_ = min(a, b); a = mx_; b = mn_; }
#define CE_ASC(a, b) { int mx_ = max(a, b), mn_ = min(a, b); a = mn_; b = mx_; }

#define S16(i, j) CE_DESC(v[i], v[j])
DI void sort16_desc(int (&v)[16]) {
  S16(0,13) S16(1,12) S16(2,15) S16(3,14) S16(4,8) S16(5,6) S16(7,11) S16(9,10)
  S16(0,5) S16(1,7) S16(2,9) S16(3,4) S16(6,13) S16(8,14) S16(10,15) S16(11,12)
  S16(0,1) S16(2,3) S16(4,5) S16(6,8) S16(7,9) S16(10,11) S16(12,13) S16(14,15)
  S16(0,2) S16(1,3) S16(4,10) S16(5,11) S16(6,7) S16(8,9) S16(12,14) S16(13,15)
  S16(1,2) S16(3,12) S16(4,6) S16(5,7) S16(8,10) S16(9,11) S16(13,14)
  S16(1,4) S16(2,6) S16(5,8) S16(7,10) S16(9,13) S16(11,14)
  S16(2,4) S16(3,6) S16(9,12) S16(11,13)
  S16(3,5) S16(6,8) S16(7,9) S16(10,12)
  S16(3,4) S16(5,6) S16(7,8) S16(9,10) S16(11,12)
  S16(6,7) S16(8,9)
}
DI void merge16_desc(int (&a)[16], const int (&b)[16]) {
#pragma unroll
  for (int i = 0; i < 16; ++i) a[i] = max(a[i], b[15 - i]);
#pragma unroll
  for (int j = 8; j > 0; j >>= 1) {
#pragma unroll
    for (int i = 0; i < 16; ++i) {
      const int l = i ^ j;
      if (l > i) { CE_DESC(a[i], a[l]); }
    }
  }
}
DI void top16_of_64(const int (&k)[64], int (&out)[16]) {
  int g1[16], g2[16], g3[16];
#pragma unroll
  for (int i = 0; i < 16; ++i) { out[i] = k[i]; g1[i] = k[16 + i]; g2[i] = k[32 + i]; g3[i] = k[48 + i]; }
  sort16_desc(out); sort16_desc(g1); sort16_desc(g2); sort16_desc(g3);
  merge16_desc(out, g1); merge16_desc(g2, g3); merge16_desc(out, g2);
}

DI float reduce_scatter32(float (&v)[32], int lane) {
  float a[16];
  {
    const bool up = (lane & 16) != 0;
#pragma unroll
    for (int i = 0; i < 16; ++i) { float keep = up ? v[16 + i] : v[i]; float send = up ? v[i] : v[16 + i]; a[i] = keep + __shfl_xor(send, 16, 64); }
  }
  float b[8];
  {
    const bool up = (lane & 8) != 0;
#pragma unroll
    for (int i = 0; i < 8; ++i) { float keep = up ? a[8 + i] : a[i]; float send = up ? a[i] : a[8 + i]; b[i] = keep + __shfl_xor(send, 8, 64); }
  }
  float c[4];
  {
    const bool up = (lane & 4) != 0;
#pragma unroll
    for (int i = 0; i < 4; ++i) { float keep = up ? b[4 + i] : b[i]; float send = up ? b[i] : b[4 + i]; c[i] = keep + __shfl_xor(send, 4, 64); }
  }
  float d[2];
  {
    const bool up = (lane & 2) != 0;
#pragma unroll
    for (int i = 0; i < 2; ++i) { float keep = up ? c[2 + i] : c[i]; float send = up ? c[i] : c[2 + i]; d[i] = keep + __shfl_xor(send, 2, 64); }
  }
  {
    const bool up = (lane & 1) != 0;
    float keep = up ? d[1] : d[0]; float send = up ? d[0] : d[1];
    return keep + __shfl_xor(send, 1, 64);
  }
}
DI float reduce_scatter64(float (&v)[64], int lane) {
  float a[32];
  const bool up = (lane & 32) != 0;
#pragma unroll
  for (int i = 0; i < 32; ++i) { float keep = up ? v[32 + i] : v[i]; float send = up ? v[i] : v[32 + i]; a[i] = keep + __shfl_xor(send, 32, 64); }
  return reduce_scatter32(a, lane);
}

__host__ __device__ constexpr int cand_ij(int c) {
  int n = 0;
  for (int a = 0; a < 16; ++a)
    for (int b = 0; b < 16; ++b)
      if ((a + 1) * (b + 1) <= 16) { if (n == c) return a * 16 + b; ++n; }
  return 0;
}
__host__ __device__ constexpr int cand_index(int i, int j) {
  int n = 0;
  for (int a = 0; a < 16; ++a)
    for (int b = 0; b < 16; ++b)
      if ((a + 1) * (b + 1) <= 16) { if (a == i && b == j) return n; ++n; }
  return n;
}
static_assert(cand_index(15, 0) == 49, "50 candidates");
DI float erf_as(float z) {
  const float az = fabsf(z);
  const float t = __builtin_amdgcn_rcpf(fmaf(0.3275911f, az, 1.0f));
  float pl = fmaf(1.061405429f, t, -1.453152027f);
  pl = fmaf(pl, t, 1.421413741f);
  pl = fmaf(pl, t, -0.284496736f);
  pl = fmaf(pl, t, 0.254829592f);
  pl *= t;
  const float ex = __expf(-az * az);
  const float r = fmaf(-pl, ex, 1.0f);
  return copysignf(r, z);
}
DI float gelu_f(float x) { return 0.5f * x * (1.0f + erf_as(x * 0.70710678118654752440f)); }

DI void phase3(const MP& p, char* smem) {
  const int tid = threadIdx.x, lane = tid & 63, w = __builtin_amdgcn_readfirstlane(tid >> 6), h = lane >> 5;
  char* atile = smem;
  float* rinv2 = (float*)(smem + ATILE_BYTES);
  float* part = rinv2 + 64;
  for (int tt = blockIdx.x; tt < 1024; tt += gridDim.x) {
    const int b = tt >> 6, k1 = tt & 63;
    const size_t tok0 = (size_t)b * 4096 + k1;
    __syncthreads();
#pragma unroll
    for (int it = 0; it < 8; ++it) {
      int chunk = opq(tid + NTHR * it);
      int r = chunk >> 6, c8 = chunk & 63;
      size_t off = (tok0 + 64 * (size_t)r) * 512 + c8 * 8;
      u32x4 yf = *(const u32x4*)(p.YF + off), yb = *(const u32x4*)(p.YB + off), uu = *(const u32x4*)(p.U + off);
      float4 d0 = *(const float4*)(p.ssm_d + c8 * 8), d1 = *(const float4*)(p.ssm_d + c8 * 8 + 4);
      float dd[8] = {d0.x, d0.y, d0.z, d0.w, d1.x, d1.y, d1.z, d1.w};
      u32x4 o;
#pragma unroll
      for (int q = 0; q < 4; ++q) {
        float lo = bflo(yf[q]) + bflo(yb[q]) + dd[2 * q] * bflo(uu[q]);
        float hi = bfhi(yf[q]) + bfhi(yb[q]) + dd[2 * q + 1] * bfhi(uu[q]);
        o[q] = cvtpk(gelu_f(lo), gelu_f(hi));
      }
      *(u32x4*)(atile + r * ASTRIDE + c8 * 16) = o;
    }
    __syncthreads();
    f32x16 gacc[2][2];
#pragma unroll
    for (int i = 0; i < 2; ++i)
#pragma unroll
      for (int j = 0; j < 2; ++j) gacc[i][j] = zero16();
    gemm_tile<2, 4>(gacc, atile, 0, p.WgluF + (size_t)(2 * w) * 32 * 64, 32, 32, opq(lane));
    {
      f32x16 facc[2][2];
#pragma unroll
      for (int i = 0; i < 2; ++i)
#pragma unroll
        for (int j = 0; j < 2; ++j) facc[i][j] = zero16();
      const int lnf = opq(lane);
      const unsigned short* m3 = p.M3T + ((size_t)k1 + 64 * (size_t)(lnf & 31)) * 128 + 8 * (lnf >> 5);
      const unsigned short* tb = p.T + (((size_t)b * 64 + k1) * 128 + 8 * (lnf >> 5)) * 512 + 64 * w + (lnf & 31);
#pragma unroll 4
      for (int ks = 0; ks < 8; ++ks) {
        bf16x8 a0 = *(const bf16x8*)(m3 + 16 * ks);
        bf16x8 a1 = *(const bf16x8*)(m3 + (size_t)32 * 64 * 128 + 16 * ks);
        bf16x8 b0, b1;
#pragma unroll
        for (int j = 0; j < 8; ++j) {
          b0[j] = (short)tb[((size_t)16 * ks + j) * 512];
          b1[j] = (short)tb[((size_t)16 * ks + j) * 512 + 32];
        }
        facc[0][0] = MFMA32(a0, b0, facc[0][0]); facc[1][0] = MFMA32(a1, b0, facc[1][0]);
        facc[0][1] = MFMA32(a0, b1, facc[0][1]); facc[1][1] = MFMA32(a1, b1, facc[1][1]);
      }
#pragma unroll
      for (int mt = 0; mt < 2; ++mt)
#pragma unroll
        for (int nt = 0; nt < 2; ++nt)
#pragma unroll
          for (int r = 0; r < 16; ++r) {
            int row = 32 * mt + crow(r, lnf >> 5), col = 512 + 64 * w + 32 * nt + (lnf & 31);
            *(unsigned short*)(atile + row * ASTRIDE + col * 2) = f2bf(facc[mt][nt][r]);
          }
    }
    __syncthreads();
    {
    const int lng = opq(lane);
#pragma unroll
    for (int mt = 0; mt < 2; ++mt)
#pragma unroll
      for (int nt = 0; nt < 2; ++nt)
#pragma unroll
        for (int r = 0; r < 16; ++r) {
          int row = 32 * mt + crow(r, lng >> 5), col = 64 * w + 32 * nt + (lng & 31);
          unsigned short* q = (unsigned short*)(atile + row * ASTRIDE + col * 2);
          float yv = bf2f(*q);
          *q = f2bf(yv / (1.0f + __expf(-gacc[mt][nt][r])));
        }
    }
    __syncthreads();
    {
      f32x16 acc[2][4];
#pragma unroll
      for (int i = 0; i < 2; ++i)
#pragma unroll
        for (int j = 0; j < 4; ++j) acc[i][j] = zero16();
      gemm_tile<4, 2>(acc, atile, 0, p.WoutF + (size_t)(4 * w) * 64 * 64, 64, 64, opq(lane));
      __syncthreads();
      float ss[32];
#pragma unroll
      for (int i = 0; i < 32; ++i) ss[i] = 0.f;
      {
        const int lnd = opq(lane);
        const unsigned gbase = (unsigned)(((tok0 + 256 * (lnd >> 5)) * 1024 + 128 * w + (lnd & 31)) * 4);
#pragma unroll
        for (int mt = 0; mt < 2; ++mt)
#pragma unroll
          for (int nt = 0; nt < 4; ++nt) {
            const unsigned gb = opqu(gbase + (unsigned)((32 * mt * 64 * 1024 + 32 * nt) * 4));
            char* lb = atile + opq((32 * mt + 4 * (lnd >> 5)) * ASTRIDE + (128 * w + 32 * nt + (lnd & 31)) * 2);
#pragma unroll
            for (int r = 0; r < 16; ++r) {
              const int rc = (r & 3) + 8 * (r >> 2);
              const unsigned go = gb + (unsigned)(rc * 64 * 1024 * 4);
              float v = *(const float*)((const char*)p.x + go) + acc[mt][nt][r];
              *(unsigned short*)(lb + rc * ASTRIDE) = f2bf(v);
              ss[mt * 16 + r] = fmaf(v, v, ss[mt * 16 + r]);
            }
          }
      }
      float tot = reduce_scatter32(ss, lane);
      {
        int L = lane & 31;
        part[w * 64 + 32 * (L >> 4) + crow(L & 15, h)] = tot;
      }
    }
    __syncthreads();
#pragma unroll 4
    for (int it = 0; it < 16; ++it) {
      const int chunk = opq(tid + NTHR * it);
      const int r = chunk >> 7, c8 = chunk & 127;
      const u32x4 xb = *(const u32x4*)(atile + r * ASTRIDE + c8 * 16);
      const size_t go = (tok0 + 64 * (size_t)r) * 1024 + c8 * 8;
      *(u32x4*)(p.X2B + go) = xb;
      unsigned hw[2], lw[2];
#pragma unroll
      for (int q = 0; q < 2; ++q) {
        hw[q] = 0u; lw[q] = 0u;
#pragma unroll
        for (int e = 0; e < 4; ++e) {
          const unsigned wv = xb[2 * q + (e >> 1)];
          const float x8 = ((e & 1) ? bfhi(wv) : bflo(wv)) * 8.f;
          const float hf = rintf(__builtin_amdgcn_fmed3f(x8, -127.f, 127.f));
          const float lf = rintf(__builtin_amdgcn_fmed3f((x8 - hf) * 128.f, -127.f, 127.f));
          hw[q] |= ((unsigned)((int)hf & 0xff)) << (8 * e);
          lw[q] |= ((unsigned)((int)lf & 0xff)) << (8 * e);
        }
      }
      u32x2 hv = {hw[0], hw[1]}, lv = {lw[0], lw[1]};
      *(u32x2*)(p.X8H + go) = hv;
      *(u32x2*)(p.X8L + go) = lv;
    }
    if (tid < 64) {
      float s = 0.f;
#pragma unroll
      for (int i = 0; i < 8; ++i) s += part[i * 64 + tid];
      rinv2[tid] = rsqrtf(s * (1.0f / 1024.f) + 1e-6f);
    }
    __syncthreads();
    int sk[2][16];
#pragma unroll
    for (int pq = 0; pq < 2; ++pq) {
      int run[2][16];
#pragma unroll
      for (int half = 0; half < 2; ++half) {
        f32x16 acc[2][2];
#pragma unroll
        for (int i = 0; i < 2; ++i)
#pragma unroll
          for (int j = 0; j < 2; ++j) acc[i][j] = zero16();
        {
          const int ln = opq(lane);
          const char* bbase = atile + (ln & 31) * ASTRIDE + (8 * (ln >> 5)) * 2;
          const char* wq = (const char*)(p.WqkF + (size_t)(8 * w + 4 * pq + 2 * half) * 64 * 64);
          const unsigned loff = (unsigned)ln * 16u;
          bf16x8 aq[PD][2];
#pragma unroll
          for (int d = 0; d < PD; ++d) { aq[d][0] = *(const bf16x8*)(wq + (unsigned)d * 1024u + loff); aq[d][1] = *(const bf16x8*)(wq + (unsigned)(64 + d) * 1024u + loff); }
#pragma unroll 1
          for (int ks0 = 0; ks0 < 64; ks0 += PD) {
#pragma unroll
            for (int d = 0; d < PD; ++d) {
              const int ks = ks0 + d;
              bf16x8 x0 = *(const bf16x8*)(bbase + ks * 32);
              bf16x8 x1 = *(const bf16x8*)(bbase + 32 * ASTRIDE + ks * 32);
              bf16x8 a0 = aq[d][0], a1 = aq[d][1];
              const unsigned ksn = opqs((unsigned)min(ks + PD, 63) * 1024u);
              aq[d][0] = *(const bf16x8*)(wq + ksn + loff); aq[d][1] = *(const bf16x8*)(wq + (ksn + 65536u) + loff);
              acc[0][0] = MFMA32(a0, x0, acc[0][0]); acc[0][1] = MFMA32(a0, x1, acc[0][1]);
              acc[1][0] = MFMA32(a1, x0, acc[1][0]); acc[1][1] = MFMA32(a1, x1, acc[1][1]);
            }
          }
        }
#pragma unroll
        for (int nt = 0; nt < 2; ++nt) {
#pragma unroll
          for (int mt = 0; mt < 2; ++mt) {
            int g[16];
            const int hb = opq(4 * h);
#pragma unroll
            for (int r = 0; r < 16; ++r) g[r] = (f2key(acc[mt][nt][r]) & ~0x7f) | (32 * (2 * half + mt) + (r & 3) + 8 * (r >> 2)) | hb;
            sort16_desc(g);
            if (half == 0 && mt == 0) {
#pragma unroll
              for (int i = 0; i < 16; ++i) run[nt][i] = g[i];
            } else {
              merge16_desc(run[nt], g);
            }
          }
        }
      }
      {
        int mine[16], other[16];
#pragma unroll
        for (int i = 0; i < 16; ++i) {
          const int give = h ? run[0][i] : run[1][i];
          mine[i] = h ? run[1][i] : run[0][i];
          other[i] = __shfl_xor(give, 32, 64);
        }
        merge16_desc(mine, other);
#pragma unroll
        for (int i = 0; i < 16; ++i) sk[pq][i] = mine[i];
      }
    }
    {
      float v0[16], v1[16];
      unsigned i0p[4], i1p[4];
      {
        int s0[16], s1[16];
#pragma unroll
        for (int i = 0; i < 16; ++i) { s0[i] = sk[0][i]; s1[i] = sk[1][i]; }
        const float sc = rinv2[32 * h + (lane & 31)];
#pragma unroll
        for (int i = 0; i < 16; ++i) { v0[i] = key2f(s0[i] & ~0x7f) * sc; v1[i] = key2f(s1[i] & ~0x7f) * sc; }
#pragma unroll
        for (int q = 0; q < 4; ++q) {
          i0p[q] = (unsigned)(s0[4 * q] & 0x7f) | ((unsigned)(s0[4 * q + 1] & 0x7f) << 8) | ((unsigned)(s0[4 * q + 2] & 0x7f) << 16) | ((unsigned)(s0[4 * q + 3] & 0x7f) << 24);
          i1p[q] = (unsigned)(s1[4 * q] & 0x7f) | ((unsigned)(s1[4 * q + 1] & 0x7f) << 8) | ((unsigned)(s1[4 * q + 2] & 0x7f) << 16) | ((unsigned)(s1[4 * q + 3] & 0x7f) << 24);
        }
      }
      int top[16];
#pragma unroll
      for (int grp = 0; grp < 4; ++grp) {
        int g[16];
#pragma unroll
        for (int t = 0; t < 16; ++t) {
          const int c = 16 * grp + t;
          if (c < 50) { const int ij = cand_ij(c); g[t] = (f2key(v0[ij >> 4] + v1[ij & 15]) & ~0xff) | ij; }
          else g[t] = (int)0x80000000;
        }
        sort16_desc(g);
        if (grp == 0) {
#pragma unroll
          for (int t = 0; t < 16; ++t) top[t] = g[t];
        } else {
          merge16_desc(top, g);
        }
      }
      float sum = 0.f;
      float mx = key2f(top[0] & ~0xff);
      float ev[16];
#pragma unroll
      for (int r = 0; r < 16; ++r) { ev[r] = __expf(key2f(top[r] & ~0xff) - mx); sum += ev[r]; }
      const float inv = 1.0f / sum;
      u32x4 o[4];
#pragma unroll
      for (int r = 0; r < 16; ++r) {
        int code = top[r] & 0xff, ci = code >> 4, cj = code & 15;
        unsigned w0 = (ci >> 2) == 0 ? i0p[0] : (ci >> 2) == 1 ? i0p[1] : (ci >> 2) == 2 ? i0p[2] : i0p[3];
        unsigned w1 = (cj >> 2) == 0 ? i1p[0] : (cj >> 2) == 1 ? i1p[1] : (cj >> 2) == 2 ? i1p[2] : i1p[3];
        unsigned e0 = (w0 >> ((ci & 3) * 8)) & 0x7f, e1 = (w1 >> ((cj & 3) * 8)) & 0x7f;
        unsigned e = e0 * 128 + e1;
        o[r >> 2][r & 3] = (e << 16) | (cvtpk(ev[r] * inv, 0.f) & 0xffffu);
      }
      const int lnp = opq(lane);
      unsigned* pr = p.PAIRS + (tok0 + 64 * (size_t)(32 * (lnp >> 5) + (lnp & 31))) * 128 + w * 16;
#pragma unroll
      for (int q = 0; q < 4; ++q) *(u32x4*)(pr + 4 * q) = o[q];
      {
        u32x4 e0, e1;
#pragma unroll
        for (int q = 0; q < 4; ++q) {
          e0[q] = (o[q >> 1][2 * (q & 1)] >> 16) | (o[q >> 1][2 * (q & 1) + 1] & 0xffff0000u);
          e1[q] = (o[2 + (q >> 1)][2 * (q & 1)] >> 16) | (o[2 + (q >> 1)][2 * (q & 1) + 1] & 0xffff0000u);
        }
        unsigned short* er = p.E16 + (tok0 + 64 * (size_t)(32 * (lnp >> 5) + (lnp & 31))) * 128 + w * 16;
        *(u32x4*)er = e0; *(u32x4*)(er + 8) = e1;
      }
    }
    if (tid < 64) p.RINV2[tok0 + 64 * (size_t)tid] = rinv2[tid];
  }
}


#define XB_TMO      128
#define XB_XCNT(j)  (256  + 64 * (j))
#define XB_XSUB(j)  (1280 + 64 * (j))
#define XB_XGEN(j)  (2304 + 64 * (j))
#define XB_TOP      3328
#define XB_TOPGEN   3392
#define XCD_BAR_WORDS 3456
#define XB_SPIN_CAP (1u << 22)
#define LAS __attribute__((address_space(3)))
DI unsigned xb_ld(unsigned* p) { return __hip_atomic_load(p, __ATOMIC_RELAXED, __HIP_MEMORY_SCOPE_AGENT); }
DI unsigned xb_add(unsigned* p, unsigned v) { return __hip_atomic_fetch_add(p, v, __ATOMIC_RELAXED, __HIP_MEMORY_SCOPE_AGENT); }
DI unsigned xb_xcc_id() { return (unsigned)__builtin_amdgcn_s_getreg((3 << 11) | 20) & 0xFu; }
#define XB_SPIN(cond, bar) do { unsigned _sp = 0; while (cond) { __builtin_amdgcn_s_sleep(1); \
    if ((++_sp & 255u) == 0u) { if (xb_ld(&(bar)[XB_TMO])) break; if (_sp > XB_SPIN_CAP) { atomicAdd(&(bar)[XB_TMO], 1u); break; } } } } while (0)
struct XcdBarrier { unsigned* bar; unsigned x; volatile LAS unsigned* st; };
DI XcdBarrier xcd_barrier_post(unsigned* bar, volatile LAS unsigned* st) {
  XcdBarrier b; b.bar = bar; b.x = xb_xcc_id(); b.st = st;
  if (threadIdx.x == 0) (void)xb_add(&bar[XB_XCNT(b.x)], 1u);
  return b;
}
DI void xcd_barrier_complete(unsigned* bar, unsigned x, unsigned& nloc, unsigned& nx) {
  const unsigned G = gridDim.x * gridDim.y * gridDim.z;
  unsigned sum, cnt, mine, sp = 0u;
  for (;;) {
    sum = 0u; cnt = 0u; mine = 0u;
#pragma unroll
    for (unsigned j = 0; j < 16; ++j) { const unsigned c = xb_ld(&bar[XB_XCNT(j)]); sum += c; cnt += (c > 0u) ? 1u : 0u; mine = (j == x) ? c : mine; }
    if (sum == G) break;
    __builtin_amdgcn_s_sleep(1);
    if ((++sp & 255u) == 0u) { if (xb_ld(&bar[XB_TMO])) break; if (sp > XB_SPIN_CAP) { atomicAdd(&bar[XB_TMO], 1u); break; } }
  }
  nloc = mine > 0u ? mine : 1u; nx = cnt > 0u ? cnt : 1u;
}
DI void xcd_barrier(const XcdBarrier& b) {
  asm volatile("s_waitcnt vmcnt(0)" ::: "memory");
  __syncthreads();
  if (threadIdx.x == 0) {
    unsigned* bar = b.bar;
    __builtin_amdgcn_s_waitcnt(0);
    unsigned nloc = b.st[0], nx = b.st[1];
    if (nloc == 0u) { xcd_barrier_complete(bar, b.x, nloc, nx); b.st[0] = nloc; b.st[1] = nx; }
    const unsigned old = xb_add(&bar[XB_XSUB(b.x)], 1u);
    const unsigned gen = old / nloc;
    if (old + 1u == (gen + 1u) * nloc) {
      __builtin_amdgcn_fence(__ATOMIC_RELEASE, "agent");
      asm volatile("s_waitcnt vmcnt(0)" ::: "memory");
      const unsigned og = xb_add(&bar[XB_TOP], 1u);
      const unsigned tg = og / nx;
      if (og + 1u == (tg + 1u) * nx) xb_add(&bar[XB_TOPGEN], 1u);
      else XB_SPIN(xb_ld(&bar[XB_TOPGEN]) == tg, bar);
      __builtin_amdgcn_fence(__ATOMIC_ACQUIRE, "agent");
      xb_add(&bar[XB_XGEN(b.x)], 1u);
      asm volatile("s_waitcnt vmcnt(0)" ::: "memory");
    } else {
      XB_SPIN(xb_ld(&bar[XB_XGEN(b.x)]) == gen, bar);
      __builtin_amdgcn_fence(__ATOMIC_ACQUIRE, "agent");
      asm volatile("s_waitcnt vmcnt(0)" ::: "memory");
    }
  }
  __syncthreads();
}

DI f32x2_t dec_lo(unsigned w) { return __builtin_amdgcn_cvt_pk_f32_fp8((int)w, false); }
DI f32x2_t dec_hi(unsigned w) { return __builtin_amdgcn_cvt_pk_f32_fp8((int)w, true); }
#define PCHUNK 16
#define NPCHUNK (NTOK / PCHUNK)
#define DPP_XOR1 0xB1
#define DPP_XOR2 0x4E
#define DPP_HALF_MIRROR 0x141
#define DPP_ROR8 0x128
template <int CTRL> DI int dpp_i(int v) { return __builtin_amdgcn_mov_dpp(v, CTRL, 0xF, 0xF, true); }
template <int CTRL> DI float dpp_f(float v) { return __builtin_bit_cast(float, __builtin_amdgcn_mov_dpp(__builtin_bit_cast(int, v), CTRL, 0xF, 0xF, true)); }
DI void phase4(const MP& p, char* smem) {
  const int lane = threadIdx.x & 63, w = __builtin_amdgcn_readfirstlane(threadIdx.x >> 6), g = lane >> 3, i = lane & 7;
  const unsigned xcc = xb_xcc_id() & 7u;
  const unsigned loff = 16u * (unsigned)i;
  char* stg = smem + w * 8192;
#pragma unroll 1
  for (int s = 0; s < 8; ++s) {
    const int slice = (int)((xcc + s) & 7u);
    unsigned* ctr = p.CTR + (size_t)slice * 64;
    const unsigned char* tbs = p.EU + (size_t)slice * 16384 * 128;
    _Float16* pre = (_Float16*)p.PRE + (size_t)slice * NTOK * 128 + 16 * g + 2 * i;
#pragma unroll 1
    for (;;) {
      unsigned c = 0;
      if (lane == 0) c = atomicAdd(ctr, 1u);
      c = (unsigned)__builtin_amdgcn_readfirstlane((int)c);
      if (c >= NPCHUNK) break;
      const size_t tokb = (size_t)c * PCHUNK;
      {
        const u32x4* ep = (const u32x4*)(p.E16 + tokb * 128) + lane;
        u32x4 ev[4], hv[2], lv[2];
#pragma unroll
        for (int j = 0; j < 4; ++j) ev[j] = ep[64 * j];
#pragma unroll
        for (int j = 0; j < 2; ++j) {
          const size_t xo = (tokb + 8 * j + (lane >> 3)) * 1024 + 128 * slice + loff;
          hv[j] = *(const u32x4*)(p.X8H + xo); lv[j] = *(const u32x4*)(p.X8L + xo);
        }
        __builtin_amdgcn_wave_barrier();
#pragma unroll
        for (int j = 0; j < 4; ++j) *(u32x4*)(stg + 1024 * j + 16 * lane) = ev[j];
#pragma unroll
        for (int j = 0; j < 2; ++j) { *(u32x4*)(stg + 4096 + 1024 * j + 16 * lane) = hv[j]; *(u32x4*)(stg + 6144 + 1024 * j + 16 * lane) = lv[j]; }
        __builtin_amdgcn_wave_barrier();
      }
#pragma unroll 1
      for (int tt = 0; tt < PCHUNK; ++tt) {
        const size_t tok = tokb + tt;
        const u32x4 pw0 = *(const u32x4*)(stg + 256 * tt + 32 * g), pw1 = *(const u32x4*)(stg + 256 * tt + 32 * g + 16);
        const u32x4 xh = *(const u32x4*)(stg + 4096 + 128 * tt + loff), xl = *(const u32x4*)(stg + 6144 + 128 * tt + loff);
        u32x4 ua[16];
#pragma unroll
        for (int k = 0; k < 16; ++k) {
          const unsigned e = __builtin_amdgcn_ubfe(k < 8 ? pw0[(k >> 1) & 3] : pw1[(k >> 1) & 3], 16 * (k & 1), 16);
          ua[k] = *(const u32x4*)(tbs + ((e << 7) | loff));
        }
        int v[16];
#pragma unroll
        for (int k = 0; k < 16; ++k) {
          int ah = 0, al = 0;
#pragma unroll
          for (int q = 0; q < 4; ++q) {
            ah = __builtin_amdgcn_sdot4((int)ua[k][q], (int)xh[q], ah, false);
            al = __builtin_amdgcn_sdot4((int)ua[k][q], (int)xl[q], al, false);
          }
          v[k] = (ah << 7) + al;
        }
        int a8[8], a4[4], a2[2];
        { const bool up = (lane & 4) != 0;
#pragma unroll
          for (int k = 0; k < 8; ++k) { const int keep = up ? v[8 + k] : v[k]; const int send = up ? v[k] : v[8 + k]; a8[k] = keep + dpp_i<DPP_HALF_MIRROR>(send); } }
        { const bool up = (lane & 2) != 0;
#pragma unroll
          for (int k = 0; k < 4; ++k) { const int keep = up ? a8[4 + k] : a8[k]; const int send = up ? a8[k] : a8[4 + k]; a4[k] = keep + dpp_i<DPP_XOR2>(send); } }
        { const bool up = (lane & 1) != 0;
#pragma unroll
          for (int k = 0; k < 2; ++k) { const int keep = up ? a4[2 + k] : a4[k]; const int send = up ? a4[k] : a4[2 + k]; a2[k] = keep + dpp_i<DPP_XOR1>(send); } }
        const float sc = 1.0f / 1048576.f;
        f16x2_t o2 = {(_Float16)((float)a2[0] * sc), (_Float16)((float)a2[1] * sc)};
        *(f16x2_t*)(pre + tok * 128) = o2;
      }
      __builtin_amdgcn_wave_barrier();
    }
  }
}
DI void phase5(const MP& p) {
  const long gtid = (long)blockIdx.x * NTHR + threadIdx.x;
  const long gsz = (long)gridDim.x * NTHR;
#pragma unroll 1
  for (long u = gtid; u < (long)NTOK * 32; u += gsz) {
    const long tok = u >> 5; const int q4 = (int)(u & 31) * 4;
    float4 s = make_float4(0.f, 0.f, 0.f, 0.f);
#pragma unroll
    for (int sl = 0; sl < 8; ++sl) {
      const u32x2 v = *(const u32x2*)((const _Float16*)p.PRE + ((size_t)sl * NTOK + tok) * 128 + q4);
      const f16x2_t v01 = as_h2(v[0]), v23 = as_h2(v[1]);
      s.x += (float)v01[0]; s.y += (float)v01[1]; s.z += (float)v23[0]; s.w += (float)v23[1];
    }
    const float ri = p.RINV2[tok];
    u32x4 pw = *(const u32x4*)(p.PAIRS + tok * 128 + q4);
    float4 a;
    a.x = gelu_f(s.x * ri) * bflo(pw[0]) * 16.f; a.y = gelu_f(s.y * ri) * bflo(pw[1]) * 16.f;
    a.z = gelu_f(s.z * ri) * bflo(pw[2]) * 16.f; a.w = gelu_f(s.w * ri) * bflo(pw[3]) * 16.f;
    int hw = __builtin_amdgcn_cvt_pk_fp8_f32(a.x, a.y, 0, false);
    hw = __builtin_amdgcn_cvt_pk_fp8_f32(a.z, a.w, hw, true);
    const f32x2_t d01 = __builtin_amdgcn_cvt_pk_f32_fp8(hw, false), d23 = __builtin_amdgcn_cvt_pk_f32_fp8(hw, true);
    int lw = __builtin_amdgcn_cvt_pk_fp8_f32((a.x - d01[0]) * 16.f, (a.y - d01[1]) * 16.f, 0, false);
    lw = __builtin_amdgcn_cvt_pk_fp8_f32((a.z - d23[0]) * 16.f, (a.w - d23[1]) * 16.f, lw, true);
    *(int*)(p.ACTH + tok * 128 + q4) = hw;
    *(int*)(p.ACTL + tok * 128 + q4) = lw;
  }
}
typedef int i32x8 __attribute__((ext_vector_type(8)));
struct V6Ctx {
  int lane, g, i, n, kq, bq, sc, tc, rg; bool valid; unsigned loff; unsigned sel[4]; int aoff;
};
DI void v6_load(const V6Ctx& c, u32x4 (&va)[16], u32x4& aw, unsigned*& xrow, const MP& p, const char* stg, const unsigned char* tbs, size_t tok, int tt, int slice) {
  aw = *(const u32x4*)(stg + c.aoff + 128 * tt);
  const u32x4 pw0 = *(const u32x4*)(stg + 256 * tt + 32 * c.g), pw1 = *(const u32x4*)(stg + 256 * tt + 32 * c.g + 16);
#pragma unroll
  for (int k = 0; k < 16; ++k) { const unsigned e = __builtin_amdgcn_ubfe(k < 8 ? pw0[(k >> 1) & 3] : pw1[(k >> 1) & 3], 16 * (k & 1), 16); va[k] = *(const u32x4*)(tbs + ((e << 7) | c.loff)); }
  xrow = (unsigned*)(p.OUTB + tok * 1024 + 128 * slice) + c.lane;
}
DI void v6_mma(const V6Ctx& c, const u32x4 (&va)[16], const u32x4 aw, float* red) {
  i32x8 B0, B1;
#pragma unroll
  for (int r = 0; r < 8; ++r) {
    B0[r] = (int)__builtin_amdgcn_perm(0u, aw[r >> 2], c.sel[r & 3]);
    B1[r] = (int)__builtin_amdgcn_perm(0u, aw[2 + (r >> 2)], c.sel[r & 3]);
  }
  float* dst = c.valid ? (red + (c.tc * 2 + c.sc) * 128 + 64 * (c.rg & 1) + c.bq) : (red + 512 + c.lane);
  const int st = c.valid ? 1 : 0;
#pragma unroll
  for (int q = 0; q < 4; ++q) {
    i32x8 A0, A1;
#pragma unroll
    for (int r = 0; r < 8; ++r) { A0[r] = (int)va[r][q]; A1[r] = (int)va[8 + r][q]; }
    f32x4 z = {0.f, 0.f, 0.f, 0.f};
    z = __builtin_amdgcn_mfma_scale_f32_16x16x128_f8f6f4(A0, B0, z, 0, 0, 0, 0x7f7f7f7f, 0, 0x7f7f7f7f);
    z = __builtin_amdgcn_mfma_scale_f32_16x16x128_f8f6f4(A1, B1, z, 0, 0, 0, 0x7f7f7f7f, 0, 0x7f7f7f7f);
#pragma unroll
    for (int r = 0; r < 4; ++r) {
      float v = z[r];
      asm volatile("" : "+v"(v));
      dst[st * (16 * r + 4 * q)] = v;
    }
  }
}
DI void v6_fin(const V6Ctx& c, const float* red, unsigned* xrow) {
  const f32x2_t h0 = *(const f32x2_t*)(red + 0 * 128 + 2 * c.lane), h1 = *(const f32x2_t*)(red + 1 * 128 + 2 * c.lane);
  const f32x2_t l0 = *(const f32x2_t*)(red + 2 * 128 + 2 * c.lane), l1 = *(const f32x2_t*)(red + 3 * 128 + 2 * c.lane);
  const float o0 = ((h0[0] + h1[0]) + (l0[0] + l1[0]) * (1.0f / 16.f)) * (1.0f / 64.f);
  const float o1 = ((h0[1] + h1[1]) + (l0[1] + l1[1]) * (1.0f / 16.f)) * (1.0f / 64.f);
  *xrow = cvtpk(o0, o1);
}
DI void phase6(const MP& p, char* smem) {
  V6Ctx c;
  c.lane = threadIdx.x & 63;
  const int w = __builtin_amdgcn_readfirstlane(threadIdx.x >> 6);
  c.g = c.lane >> 3; c.i = c.lane & 7; c.n = c.lane & 15; c.kq = c.lane >> 4; c.bq = c.n & 3; c.sc = (c.n >> 2) & 1; c.tc = c.n >> 3; c.rg = c.kq;
  c.loff = 16u * (unsigned)c.i;
  c.valid = ((c.rg >> 1) == c.sc);
#pragma unroll
  for (int j = 0; j < 4; ++j) c.sel[j] = (0x0c0c0c0cu & ~(0xffu << (8 * c.bq))) | ((unsigned)j << (8 * c.bq));
  c.aoff = 4096 + 2048 * c.tc + 16 * (2 * c.kq + c.sc);
  const unsigned xcc = xb_xcc_id() & 7u;
  float* redA = (float*)(smem + w * 4608);
  float* redB = redA + 576;
  char* stg = smem + 8 * 4608 + w * 8192;
#pragma unroll 1
  for (int s = 0; s < 8; ++s) {
    const int slice = (int)((xcc + s) & 7u);
    unsigned* ctr = p.CTR + (size_t)(8 + slice) * 64;
    const unsigned char* tbs = p.EV + (size_t)slice * 16384 * 128;
#pragma unroll 1
    for (;;) {
      unsigned cc = 0;
      if (c.lane == 0) cc = atomicAdd(ctr, 1u);
      cc = (unsigned)__builtin_amdgcn_readfirstlane((int)cc);
      if (cc >= NPCHUNK) break;
      const size_t tokb = (size_t)cc * PCHUNK;
      {
        const u32x4* ep = (const u32x4*)(p.E16 + tokb * 128) + c.lane;
        u32x4 ev[4], ah[2], al[2];
#pragma unroll
        for (int j = 0; j < 4; ++j) ev[j] = ep[64 * j];
#pragma unroll
        for (int j = 0; j < 2; ++j) { ah[j] = ((const u32x4*)(p.ACTH + tokb * 128))[64 * j + c.lane]; al[j] = ((const u32x4*)(p.ACTL + tokb * 128))[64 * j + c.lane]; }
        __builtin_amdgcn_wave_barrier();
#pragma unroll
        for (int j = 0; j < 4; ++j) *(u32x4*)(stg + 1024 * j + 16 * c.lane) = ev[j];
#pragma unroll
        for (int j = 0; j < 2; ++j) { *(u32x4*)(stg + 4096 + 1024 * j + 16 * c.lane) = ah[j]; *(u32x4*)(stg + 6144 + 1024 * j + 16 * c.lane) = al[j]; }
        __builtin_amdgcn_wave_barrier();
      }
#pragma unroll 1
      for (int tt = 0; tt < PCHUNK; tt += 2) {
        u32x4 vaA[16], vaB[16], awA, awB; unsigned *rowA, *rowB;
        v6_load(c, vaA, awA, rowA, p, stg, tbs, tokb + tt, tt, slice);
        v6_load(c, vaB, awB, rowB, p, stg, tbs, tokb + tt + 1, tt + 1, slice);
        v6_mma(c, vaA, awA, redA);
        v6_mma(c, vaB, awB, redB);
        __builtin_amdgcn_wave_barrier();
        v6_fin(c, redA, rowA);
        v6_fin(c, redB, rowB);
        __builtin_amdgcn_wave_barrier();
      }
    }
  }
}
DI void phase7(const MP& p) {
  const int lane = threadIdx.x & 63;
  const int gw = blockIdx.x * (NTHR / 64) + (threadIdx.x >> 6), nw = gridDim.x * (NTHR / 64);
  const float4* fp = (const float4*)p.fg + 4 * lane;
  float4 f[4];
#pragma unroll
  for (int q = 0; q < 4; ++q) f[q] = fp[q];
#pragma unroll 2
  for (int tok = gw; tok < NTOK; tok += nw) {
    const u32x4* xp = (const u32x4*)(p.X2B + (size_t)tok * 1024) + 2 * lane;
    const u32x4* op_ = (const u32x4*)(p.OUTB + (size_t)tok * 1024) + 2 * lane;
    const u32x4 a = xp[0], b = xp[1], oa = op_[0], ob = op_[1];
    float v[16];
#pragma unroll
    for (int q = 0; q < 4; ++q) {
      v[2 * q] = bflo(a[q]) + bflo(oa[q]); v[2 * q + 1] = bfhi(a[q]) + bfhi(oa[q]);
      v[8 + 2 * q] = bflo(b[q]) + bflo(ob[q]); v[8 + 2 * q + 1] = bfhi(b[q]) + bfhi(ob[q]);
    }
    float s = 0.f;
#pragma unroll
    for (int q = 0; q < 16; ++q) s = fmaf(v[q], v[q], s);
    for (int m = 32; m >= 1; m >>= 1) s += __shfl_xor(s, m, 64);
    const float r3 = rsqrtf(s * (1.0f / 1024.f) + 1e-6f);
    float4* op = (float4*)(p.out + (size_t)tok * 1024) + 4 * lane;
#pragma unroll
    for (int q = 0; q < 4; ++q)
      op[q] = make_float4(v[4 * q] * r3 * f[q].x, v[4 * q + 1] * r3 * f[q].y, v[4 * q + 2] * r3 * f[q].z, v[4 * q + 3] * r3 * f[q].w);
  }
}

#define SMEM_BYTES (ATILE_BYTES + 64 * 4 + 8 * 64 * 4)
__global__ void __launch_bounds__(NTHR) k_mega(MP p) {
  __shared__ __attribute__((aligned(16))) char smem[SMEM_BYTES];
  __shared__ uint4 xb_words;
  if (threadIdx.x == 0) xb_words = make_uint4(0u, 0u, 0u, 0u);
  __syncthreads();
  XcdBarrier gb = xcd_barrier_post(p.bar, (volatile LAS unsigned*)&xb_words);
  phase0(p, smem);
  xcd_barrier(gb);
  phase1(p, smem);
  xcd_barrier(gb);
  phase2(p, smem);
  xcd_barrier(gb);
  phase3(p, smem);
  xcd_barrier(gb);
  phase4(p, smem);
  xcd_barrier(gb);
  phase5(p);
  xcd_barrier(gb);
  phase6(p, smem);
  xcd_barrier(gb);
  phase7(p);
}

extern "C" void kernel_launch(void* const* d_in, const int* in_sizes, int n_in, void* d_out, int out_size, void* d_ws, size_t ws_size,
                              hipStream_t stream) {
  float* out = (float*)d_out;
  char* arena1 = (char*)d_ws;
  size_t o1 = 0;
  auto A1 = [&](size_t bytes) { void* r = arena1 + o1; o1 += (bytes + 255) & ~(size_t)255; return r; };
  MP p;
  memset(&p, 0, sizeof(p));
  p.x = (const float*)d_in[0]; p.g1 = (const float*)d_in[1]; p.w_in = (const float*)d_in[2]; p.a_re = (const float*)d_in[3];
  p.a_im = (const float*)d_in[4]; p.log_step = (const float*)d_in[5]; p.b_re = (const float*)d_in[6]; p.b_im = (const float*)d_in[7];
  p.c_re = (const float*)d_in[8]; p.c_im = (const float*)d_in[9]; p.ssm_d = (const float*)d_in[10]; p.w_glu = (const float*)d_in[11];
  p.w_f = (const float*)d_in[12]; p.w_out = (const float*)d_in[13]; p.g2 = (const float*)d_in[14]; p.w_q = (const float*)d_in[15];
  p.keys = (const float*)d_in[16]; p.eu = (const float*)d_in[17]; p.ev = (const float*)d_in[18]; p.fg = (const float*)d_in[19];
  p.out = out;
  p.U = (unsigned short*)A1((size_t)NTOK * 512 * 2);
  p.T = (unsigned short*)A1((size_t)NTOK * 1024 * 2);
  p.YF = (unsigned short*)A1((size_t)NTOK * 512 * 2);
  p.YB = (unsigned short*)A1((size_t)NTOK * 512 * 2);
  p.PAIRS = (unsigned*)A1((size_t)NTOK * 128 * 4);
  p.E16 = (unsigned short*)A1((size_t)NTOK * 128 * 2);
  p.EU = (unsigned char*)A1((size_t)16384 * 1024);
  p.EV = (unsigned char*)A1((size_t)16384 * 1024);
  p.WinF = (bf16x8*)A1((size_t)1024 * 1536 * 2);
  p.WgluF = (bf16x8*)A1((size_t)512 * 512 * 2);
  p.WoutF = (bf16x8*)A1((size_t)1024 * 1024 * 2);
  p.WqkF = (bf16x8*)A1((size_t)1024 * 2048 * 2);
  p.M1F = (bf16x8*)A1((size_t)128 * 128 * 2);
  p.M3T = (unsigned short*)A1((size_t)4096 * 128 * 2);
  p.s5lam = (float*)A1((size_t)64 * 64 * 2 * 4);
  p.s5B = (bf16x8*)A1((size_t)64 * 4 * 64 * 16);
  p.s5C = (bf16x8*)A1((size_t)64 * 4 * 64 * 16);
  p.bar = (unsigned*)A1((size_t)XCD_BAR_WORDS * 4);
  p.CTR = (unsigned*)A1((size_t)16 * 64 * 4);
  (void)hipMemsetAsync(p.bar, 0, (size_t)((char*)(p.CTR + 16 * 64) - (char*)p.bar), stream);
  p.RINV2 = (float*)A1((size_t)NTOK * 4);
  p.OUTB = (unsigned short*)A1((size_t)NTOK * 1024 * 2);
  p.X2B = (unsigned short*)A1((size_t)NTOK * 1024 * 2);
  p.ACTH = (unsigned char*)A1((size_t)NTOK * 128);
  p.ACTL = (unsigned char*)A1((size_t)NTOK * 128);
  p.X8H = (unsigned char*)A1((size_t)NTOK * 1024);
  p.X8L = (unsigned char*)A1((size_t)NTOK * 1024);
  p.PRE = (float*)A1((size_t)8 * NTOK * 128 * 2);
  static int grid_blocks = 0;
  if (!grid_blocks) {
    int dev = 0, cus = 0, per_cu = 0;
    (void)hipGetDevice(&dev);
    (void)hipDeviceGetAttribute(&cus, hipDeviceAttributeMultiprocessorCount, dev);
    (void)hipOccupancyMaxActiveBlocksPerMultiprocessor(&per_cu, k_mega, NTHR, 0);
    if (per_cu < 1) per_cu = 1;
    if (per_cu > 1) per_cu = 1;
    grid_blocks = cus * per_cu;
  }
  void* args[] = {&p};
  hipError_t e = hipLaunchCooperativeKernel((void*)k_mega, dim3(grid_blocks), dim3(NTHR), args, 0, stream);
  if (e != hipSuccess) fprintf(stderr, "cooperative launch failed: %s (grid %d)\n", hipGetErrorString(e), grid_blocks);
}
```

```cpp
#include <hip/hip_runtime.h>
#include <stdint.h>
#include <string.h>
#include <stdio.h>

#define NTOK 65536

__device__ __forceinline__ void dsincos(double x, double* s, double* c) {
  double q = rint(x * 0.63661977236758134308);
  double r = fma(-q, 1.57079632679489655800, x);
  r = fma(-q, 6.12323399573676603587e-17, r);
  double r2 = r * r;
  double sp = r * (1.0 + r2 * (-1.0 / 6 + r2 * (1.0 / 120 + r2 * (-1.0 / 5040 + r2 * (1.0 / 362880 + r2 * (-1.0 / 39916800 + r2 * (1.0 / 6227020800.0 + r2 * (-1.0 / 1307674368000.0))))))));
  double cp = 1.0 + r2 * (-0.5 + r2 * (1.0 / 24 + r2 * (-1.0 / 720 + r2 * (1.0 / 40320 + r2 * (-1.0 / 3628800 + r2 * (1.0 / 479001600.0 + r2 * (-1.0 / 87178291200.0)))))));
  long long qi = (long long)q;
  int m = (int)(qi & 3);
  double ss = (m == 0) ? sp : (m == 1) ? cp : (m == 2) ? -sp : -cp;
  double cc = (m == 0) ? cp : (m == 1) ? -sp : (m == 2) ? -cp : sp;
  *s = ss; *c = cc;
}

typedef short bf16x8 __attribute__((ext_vector_type(8)));
typedef float f32x16 __attribute__((ext_vector_type(16)));
typedef float f32x4 __attribute__((ext_vector_type(4)));
typedef unsigned u32x4 __attribute__((ext_vector_type(4)));
typedef unsigned u32x2 __attribute__((ext_vector_type(2)));
typedef float f32x2_t __attribute__((ext_vector_type(2)));
typedef __bf16 bf16x2_t __attribute__((ext_vector_type(2)));
typedef _Float16 f16x2_t __attribute__((ext_vector_type(2)));
typedef _Float16 f16x8_t __attribute__((ext_vector_type(8)));
__device__ __forceinline__ f16x2_t as_h2(unsigned v) { return __builtin_bit_cast(f16x2_t, v); }
#define DI __device__ __forceinline__
#define MFMA32(a, b, c) __builtin_amdgcn_mfma_f32_32x32x16_bf16((a), (b), (c), 0, 0, 0)
#define MFMA16(a, b, c) __builtin_amdgcn_mfma_f32_16x16x32_bf16((a), (b), (c), 0, 0, 0)
#define NTHR 512
#define ASTRIDE 2064
#define ATILE_BYTES (64 * ASTRIDE)

DI unsigned cvtpk(float lo, float hi) { f32x2_t v = {lo, hi}; bf16x2_t b = __builtin_convertvector(v, bf16x2_t); return __builtin_bit_cast(unsigned, b); }
DI unsigned short f2bf(float x) { return (unsigned short)(cvtpk(x, 0.f) & 0xffffu); }
DI float bf2f(unsigned h) { return __uint_as_float(h << 16); }
DI float bflo(unsigned w) { return __uint_as_float(w << 16); }
DI float bfhi(unsigned w) { return __uint_as_float(w & 0xffff0000u); }
DI int crow(int reg, int h) { return (reg & 3) + 8 * (reg >> 2) + 4 * h; }
DI f32x16 zero16() { f32x16 z; for (int i = 0; i < 16; ++i) z[i] = 0.f; return z; }

struct MP {
  const float *x, *g1, *w_in, *a_re, *a_im, *log_step, *b_re, *b_im, *c_re, *c_im, *ssm_d, *w_glu, *w_f, *w_out, *g2, *w_q, *keys, *eu, *ev, *fg;
  float* out;
  bf16x8 *WinF, *WgluF, *WoutF, *WqkF, *M1F, *s5B, *s5C;
  unsigned short *M3T, *U, *T, *YF, *YB;
  unsigned char *EU, *EV;
  float* s5lam;
  unsigned* PAIRS;
  unsigned short* E16;
  unsigned* bar;
  unsigned* CTR;
  float *RINV2, *PRE;
  unsigned short* OUTB;
  unsigned short* X2B;
  unsigned char *ACTH, *ACTL;
  unsigned char *X8H, *X8L;
};

DI void s5_params(const MP& p, int dg, int pp, float& lr, float& li, double& fr, double& fi) {
  double are = p.a_re[dg * 64 + pp], aim = p.a_im[dg * 64 + pp];
  double step = exp((double)p.log_step[dg]);
  double sn_, cs_;
  dsincos(aim * step, &sn_, &cs_);
  double mag = exp(are * step);
  double lrd = mag * cs_, lid = mag * sn_;
  double nr = lrd - 1.0, ni = lid;
  double den = are * are + aim * aim;
  fr = (nr * are + ni * aim) / den; fi = (ni * are - nr * aim) / den;
  lr = (float)lrd; li = (float)lid;
}

DI int opq(int v) { asm volatile("" : "+v"(v)); return v; }
DI unsigned opqu(unsigned v) { asm volatile("" : "+v"(v)); return v; }
DI unsigned opqs(unsigned v) { asm volatile("" : "+s"(v)); return v; }
DI void fold_dot8(float (&out)[8], const float* __restrict__ w0, size_t wstride, const float* lds, int stride, int n4) {
#pragma unroll
  for (int j = 0; j < 8; ++j) out[j] = 0.f;
#pragma unroll 2
  for (int m4 = 0; m4 < n4; ++m4) {
    const float l0 = lds[(4 * m4) * stride], l1 = lds[(4 * m4 + 1) * stride], l2 = lds[(4 * m4 + 2) * stride], l3 = lds[(4 * m4 + 3) * stride];
#pragma unroll
    for (int j = 0; j < 8; ++j) {
      const float4 wv = ((const float4*)(w0 + j * wstride))[m4];
      out[j] = fmaf(wv.x, l0, out[j]); out[j] = fmaf(wv.y, l1, out[j]); out[j] = fmaf(wv.z, l2, out[j]); out[j] = fmaf(wv.w, l3, out[j]);
    }
  }
}
DI void conv_frag(bf16x8* dst, const float* __restrict__ src, int ld, const float* __restrict__ kscale, int ntiles, int KS, long gtid, long gsz) {
  const long total = (long)ntiles * KS * 64;
#pragma unroll 1
  for (long u = gtid; u < total; u += gsz) {
    int lane = (int)(u & 63);
    long q = u >> 6;
    int ks = (int)(q % KS), nt = (int)(q / KS);
    int n = 32 * nt + (lane & 31), k0 = 16 * ks + 8 * (lane >> 5);
    u32x4 w;
#pragma unroll
    for (int jj = 0; jj < 4; ++jj) {
      int k = k0 + 2 * jj;
      float a = src[(size_t)k * ld + n], b = src[(size_t)(k + 1) * ld + n];
      if (kscale) { a *= kscale[k]; b *= kscale[k + 1]; }
      w[jj] = cvtpk(a, b);
    }
    dst[u] = __builtin_bit_cast(bf16x8, w);
  }
}

DI void late_prep(const MP& p, long gtid, long gsz) {
#pragma unroll 1
  for (long u = gtid; u < 4096 * 128; u += gsz) {
    int s2ri = (int)(u & 127), k = (int)(u >> 7);
    int ri = s2ri >> 6, s2 = s2ri & 63;
    double sv, cv;
    dsincos(6.283185307179586476925 * (double)((k * s2) & 4095) / 4096.0, &sv, &cv);
    p.M3T[u] = f2bf((float)(ri ? sv : cv));
  }
#pragma unroll 1
  for (long u = gtid; u < (long)16384 * 1024 / 16; u += gsz) {
    int d0 = (int)((u * 16) & 1023);
    const float4* s = (const float4*)(p.eu + u * 16);
    const float4* gq = (const float4*)(p.g2 + d0);
    const float4* s2 = (const float4*)(p.ev + u * 16);
    u32x4 ou, ov;
#pragma unroll
    for (int q = 0; q < 4; ++q) {
      float4 a = s[q], g = gq[q], b = s2[q];
      {
        const int q0 = (int)rintf(__builtin_amdgcn_fmed3f(a.x * g.x * 1024.f, -127.f, 127.f)), q1 = (int)rintf(__builtin_amdgcn_fmed3f(a.y * g.y * 1024.f, -127.f, 127.f));
        const int q2 = (int)rintf(__builtin_amdgcn_fmed3f(a.z * g.z * 1024.f, -127.f, 127.f)), q3 = (int)rintf(__builtin_amdgcn_fmed3f(a.w * g.w * 1024.f, -127.f, 127.f));
        ou[q] = (unsigned)(q0 & 0xff) | ((unsigned)(q1 & 0xff) << 8) | ((unsigned)(q2 & 0xff) << 16) | ((unsigned)(q3 & 0xff) << 24);
      }
      int w2 = __builtin_amdgcn_cvt_pk_fp8_f32(b.x * 4.f, b.y * 4.f, 0, false);
      w2 = __builtin_amdgcn_cvt_pk_fp8_f32(b.z * 4.f, b.w * 4.f, w2, true);
      ov[q] = (unsigned)w2;
    }
    {
      const long e = u >> 6; const int c16 = (int)(u & 63);
      const size_t dst = (((size_t)(c16 >> 3) * 16384 + (size_t)e) * 128) + (size_t)(c16 & 7) * 16;
      *(u32x4*)(p.EU + dst) = ou;
      *(u32x4*)(p.EV + dst) = ov;
    }
  }
}

DI void phase0(const MP& p, char* smem) {
  const int tid = threadIdx.x;
  const long gtid = (long)blockIdx.x * NTHR + tid;
  const long gsz = (long)gridDim.x * NTHR;
  conv_frag(p.WinF, p.w_in, 1024, p.g1, 16, 64, gtid, gsz);
  conv_frag(p.WgluF, p.w_glu, 512, nullptr, 16, 32, gtid, gsz);
  conv_frag(p.WoutF, p.w_out, 1024, nullptr, 32, 64, gtid, gsz);
#pragma unroll 1
  for (long u = gtid; u < 4 * 8 * 64; u += gsz) {
    int lane = (int)(u & 63), ks = (int)((u >> 6) & 7), mt = (int)(u >> 9);
    int row = 32 * mt + (lane & 31), h = lane >> 5;
    int ri = row >> 6, k1 = row & 63;
    u32x4 w;
#pragma unroll
    for (int jj = 0; jj < 4; ++jj) {
      float v2[2];
#pragma unroll
      for (int e = 0; e < 2; ++e) {
        int j = 2 * jj + e;
        int col = 16 * ks + 8 * (j >> 2) + 4 * h + (j & 3);
        int ab = col >> 6, s1 = col & 63;
        double sv, cv;
        dsincos(6.283185307179586476925 * (double)((k1 * s1) & 63) / 64.0, &sv, &cv);
        double val = (ri == 0) ? (ab == 0 ? cv : -sv) : (ab == 0 ? -sv : -cv);
        v2[e] = (float)val;
      }
      w[jj] = cvtpk(v2[0], v2[1]);
    }
    p.M1F[u] = __builtin_bit_cast(bf16x8, w);
  }
#pragma unroll 1
  for (long u = gtid; u < 64 * 64; u += gsz) {
    int pp = (int)(u & 63), dg = (int)(u >> 6);
    float lr, li; double fr, fi;
    s5_params(p, dg, pp, lr, li, fr, fi);
    p.s5lam[u * 2] = lr; p.s5lam[u * 2 + 1] = li;
  }
#pragma unroll 1
  for (long u = gtid; u < 64 * 4 * 64; u += gsz) {
    int lane = (int)(u & 63), nt = (int)((u >> 6) & 3), dg = (int)(u >> 8);
    int col = 32 * nt + (lane & 31), ri = col >> 6, pp = col & 63, h = lane >> 5;
    float lr, li; double fr, fi;
    s5_params(p, dg, pp, lr, li, fr, fi);
    const float* brp = p.b_re + ((size_t)dg * 64 + pp) * 16 + 8 * h;
    const float* bip = p.b_im + ((size_t)dg * 64 + pp) * 16 + 8 * h;
    u32x4 w;
#pragma unroll
    for (int jj = 0; jj < 4; ++jj) {
      double br0 = brp[2 * jj], bi0 = bip[2 * jj], br1 = brp[2 * jj + 1], bi1 = bip[2 * jj + 1];
      float v0 = (float)(ri ? (fr * bi0 + fi * br0) : (fr * br0 - fi * bi0));
      float v1 = (float)(ri ? (fr * bi1 + fi * br1) : (fr * br1 - fi * bi1));
      w[jj] = cvtpk(v0, v1);
    }
    p.s5B[u] = __builtin_bit_cast(bf16x8, w);
  }
#pragma unroll 1
  for (long u = gtid; u < 64 * 4 * 64; u += gsz) {
    int lane = (int)(u & 63), ks = (int)((u >> 6) & 3), dg = (int)(u >> 8);
    int c = lane & 15;
    u32x4 w;
#pragma unroll
    for (int jj = 0; jj < 4; ++jj) {
      int kk = 32 * ks + 8 * (lane >> 4) + 2 * jj;
      int pt = kk >> 6, pq = (kk & 63) >> 1;
      int pp = 32 * pt + pq;
      float vre = p.c_re[((size_t)dg * 16 + c) * 64 + pp];
      float vim = -p.c_im[((size_t)dg * 16 + c) * 64 + pp];
      w[jj] = cvtpk(vre, vim);
    }
    p.s5C[u] = __builtin_bit_cast(bf16x8, w);
  }
  {
    float* AB = (float*)smem;
    float* tab = AB + 128 * 32;
    const float nrm = 1.0f / sqrtf(4096.f * 128.f);
#pragma unroll 1
    for (int task = blockIdx.x; task < 128; task += gridDim.x) {
      int ntp = task >> 2, kq = task & 3;
      int ab = ntp >> 4, chbase = (ntp & 15) * 32, g = chbase >> 7, d0 = chbase & 127;
      __syncthreads();
      if (tid < 128) {
        double sv, cv;
        dsincos(6.283185307179586476925 * (double)tid / 128.0, &sv, &cv);
        tab[tid] = (float)(ab ? sv : cv);
      }
      __syncthreads();
#pragma unroll 1
      for (int o = tid; o < 128 * 32; o += NTHR) {
        int m = o >> 5, dd = o & 31;
        float s = 0.f;
#pragma unroll 4
        for (int c = 0; c < 128; ++c) s = fmaf(tab[(m * c) & 127], p.w_f[((size_t)g * 128 + c) * 128 + d0 + dd], s);
        AB[o] = s * nrm;
      }
      __syncthreads();
#pragma unroll 1
      for (int uu = tid; uu < 16 * 64; uu += NTHR) {
        int lane = uu & 63, ks = kq * 16 + (uu >> 6);
        int dd = lane & 31, h = lane >> 5;
        u32x4 w;
        {
          const int k0 = 16 * ks + 8 * h;
          float sv[8];
          fold_dot8(sv, p.w_in + (size_t)k0 * 1024 + 512 + 128 * g, 1024, AB + dd, 32, 32);
#pragma unroll
          for (int jj = 0; jj < 4; ++jj) w[jj] = cvtpk(sv[2 * jj] * p.g1[k0 + 2 * jj], sv[2 * jj + 1] * p.g1[k0 + 2 * jj + 1]);
        }
        p.WinF[((size_t)(16 + ntp) * 64 + ks) * 64 + lane] = __builtin_bit_cast(bf16x8, w);
      }
    }
  }
  {
    float* Ks = (float*)smem;
#pragma unroll 1
    for (int task = (int)((blockIdx.x + gridDim.x / 2) % gridDim.x); task < 128; task += gridDim.x) {
      int hp = task >> 3, kt = (task >> 1) & 3, chalf = task & 1;
      __syncthreads();
#pragma unroll 1
      for (int o = tid; o < 32 * 128; o += NTHR) {
        int kk = o >> 7, d = o & 127;
        Ks[kk * 129 + d] = p.keys[((size_t)hp * 128 + kt * 32 + kk) * 128 + d];
      }
      __syncthreads();
#pragma unroll 1
      for (int uu = tid; uu < 32 * 64; uu += NTHR) {
        int lane = uu & 63, ks = chalf * 32 + (uu >> 6);
        int kk = lane & 31, h = lane >> 5;
        u32x4 w;
        {
          const int c0 = 16 * ks + 8 * h;
          float sv[8];
          fold_dot8(sv, p.w_q + (size_t)c0 * 2048 + hp * 128, 2048, Ks + kk * 129, 1, 32);
#pragma unroll
          for (int jj = 0; jj < 4; ++jj) w[jj] = cvtpk(sv[2 * jj] * p.g2[c0 + 2 * jj], sv[2 * jj + 1] * p.g2[c0 + 2 * jj + 1]);
        }
        p.WqkF[((size_t)(hp * 4 + kt) * 64 + ks) * 64 + lane] = __builtin_bit_cast(bf16x8, w);
      }
    }
  }
}

#define PD 4
template <int NT, int PDT>
DI void gemm_tile(f32x16 (&acc)[2][NT], const char* atile, int acol0, const bf16x8* __restrict__ wf, int KS, int nks, int lane, int stride2 = 2) {
  const char* abase = atile + (lane & 31) * ASTRIDE + (acol0 + 8 * (lane >> 5)) * 2;
  const char* wbase = (const char*)wf;
  const unsigned loff = (unsigned)lane * 16u;
  unsigned noff[NT];
#pragma unroll
  for (int nt = 0; nt < NT; ++nt) noff[nt] = (unsigned)(((nt & 1) + (nt >> 1) * stride2) * KS) * 1024u;
  bf16x8 bq[PDT][NT];
#pragma unroll
  for (int d = 0; d < PDT; ++d)
#pragma unroll
    for (int nt = 0; nt < NT; ++nt) bq[d][nt] = *(const bf16x8*)(wbase + (noff[nt] + (unsigned)d * 1024u) + loff);
#pragma unroll 1
  for (int ks0 = 0; ks0 < nks; ks0 += PDT) {
#pragma unroll
    for (int d = 0; d < PDT; ++d) {
      const int ks = ks0 + d;
      bf16x8 a0 = *(const bf16x8*)(abase + ks * 32);
      bf16x8 a1 = *(const bf16x8*)(abase + 32 * ASTRIDE + ks * 32);
      bf16x8 b[NT];
#pragma unroll
      for (int nt = 0; nt < NT; ++nt) b[nt] = bq[d][nt];
      const unsigned ksn = (unsigned)min(ks + PDT, nks - 1) * 1024u;
#pragma unroll
      for (int nt = 0; nt < NT; ++nt) bq[d][nt] = *(const bf16x8*)(wbase + (noff[nt] + ksn) + loff);
#pragma unroll
      for (int nt = 0; nt < NT; ++nt) {
        acc[0][nt] = MFMA32(a0, b[nt], acc[0][nt]);
        acc[1][nt] = MFMA32(a1, b[nt], acc[1][nt]);
      }
    }
  }
}

DI bf16x8 pack_step(const f32x16& x, int s) {
  u32x4 w;
  w[0] = cvtpk(x[8 * s + 0], x[8 * s + 1]); w[1] = cvtpk(x[8 * s + 2], x[8 * s + 3]);
  w[2] = cvtpk(x[8 * s + 4], x[8 * s + 5]); w[3] = cvtpk(x[8 * s + 6], x[8 * s + 7]);
  return __builtin_bit_cast(bf16x8, w);
}


template <typename PT>
DI void store_tile_pairs(const float (&vals)[16], PT base, unsigned rs, bool odd) {
#pragma unroll
  for (int r = 0; r < 16; r += 2) {
    const float send = odd ? vals[r] : vals[r + 1];
    const float recv = __builtin_bit_cast(float, __builtin_amdgcn_mov_dpp(__builtin_bit_cast(int, send), 0xB1, 0xF, 0xF, true));
    const float lo = odd ? recv : vals[r];
    const float hi = odd ? vals[r + 1] : recv;
    const int rc = (r & 3) + 8 * (r >> 2);
    *(unsigned*)(base + (size_t)rc * rs) = cvtpk(lo, hi);
  }
}
DI void phase1(const MP& p, char* smem) {
  const int tid = threadIdx.x, w = __builtin_amdgcn_readfirstlane(tid >> 6);
  char* atile = smem;
  float* rinv = (float*)(smem + ATILE_BYTES);
  for (int tt = blockIdx.x; tt < 1024; tt += gridDim.x) {
    const int b = tt >> 6, s2 = tt & 63;
    const int lane = opq((int)threadIdx.x & 63), h = lane >> 5;
    __syncthreads();
    {
      float4 v[8][4];
#pragma unroll
      for (int rr = 0; rr < 8; ++rr) {
        const float4* xp = (const float4*)(p.x + ((size_t)b * 4096 + 64 * (w * 8 + rr) + s2) * 1024);
#pragma unroll
        for (int i = 0; i < 4; ++i) v[rr][i] = xp[lane + 64 * i];
      }
#pragma unroll
      for (int rr = 0; rr < 8; ++rr) {
        const int r = w * 8 + rr;
        float s = 0.f;
#pragma unroll
        for (int i = 0; i < 4; ++i) s += v[rr][i].x * v[rr][i].x + v[rr][i].y * v[rr][i].y + v[rr][i].z * v[rr][i].z + v[rr][i].w * v[rr][i].w;
        for (int m = 32; m >= 1; m >>= 1) s += __shfl_xor(s, m, 64);
        if (lane == 0) rinv[r] = rsqrtf(s * (1.0f / 1024.f) + 1e-6f);
#pragma unroll
        for (int i = 0; i < 4; ++i) {
          u32x2 pk; pk[0] = cvtpk(v[rr][i].x, v[rr][i].y); pk[1] = cvtpk(v[rr][i].z, v[rr][i].w);
          *(u32x2*)(atile + r * ASTRIDE + (lane + 64 * i) * 8) = pk;
        }
      }
    }
    __syncthreads();
    {
      f32x16 acc[2][2];
#pragma unroll
      for (int i = 0; i < 2; ++i)
#pragma unroll
        for (int j = 0; j < 2; ++j) acc[i][j] = zero16();
      gemm_tile<2, 4>(acc, atile, 0, p.WinF + (size_t)(2 * w) * 64 * 64, 64, 64, lane);
      {
        const bool odd = (lane & 1) != 0;
        const unsigned ubase = (unsigned)((((size_t)b * 4096 + s2 + 64 * (4 * h + (odd ? 1 : 0))) * 512 + 64 * w + ((lane & 31) & ~1)) * 2);
#pragma unroll
        for (int mt = 0; mt < 2; ++mt)
#pragma unroll
          for (int nt = 0; nt < 2; ++nt) {
            const unsigned tb = opqu(ubase + (unsigned)((32 * mt * 64 * 512 + 32 * nt) * 2));
            const float* rvp = rinv + opq(32 * mt + 4 * h);
            float vals[16];
#pragma unroll
            for (int r = 0; r < 16; ++r) vals[r] = acc[mt][nt][r] * rvp[(r & 3) + 8 * (r >> 2)];
            store_tile_pairs(vals, (char*)p.U + tb, 64u * 512u * 2u, odd);
          }
      }
    }
    {
      bf16x8 xs[8][2];
      {
        f32x16 acc[2][4];
#pragma unroll
        for (int i = 0; i < 2; ++i)
#pragma unroll
          for (int j = 0; j < 4; ++j) acc[i][j] = zero16();
        gemm_tile<4, 2>(acc, atile, 0, p.WinF + (size_t)(16 + 2 * w) * 64 * 64, 64, 64, opq(lane), 16);
#pragma unroll
        for (int mt = 0; mt < 2; ++mt) {
#pragma unroll
          for (int c = 0; c < 4; ++c) {
            const float* rvp = rinv + opq(32 * mt + 4 * h);
#pragma unroll
            for (int r = 0; r < 16; ++r) acc[mt][c][r] *= rvp[(r & 3) + 8 * (r >> 2)];
            const int ab = c >> 1, nt = c & 1;
            xs[ab * 4 + mt * 2 + 0][nt] = pack_step(acc[mt][c], 0);
            xs[ab * 4 + mt * 2 + 1][nt] = pack_step(acc[mt][c], 1);
          }
        }
      }
#pragma unroll
      for (int mt = 0; mt < 4; ++mt) {
        f32x16 t0 = zero16(), t1 = zero16();
        const bf16x8* mf = p.M1F + (size_t)(opq(mt * 8)) * 64 + lane;
#pragma unroll
        for (int ks = 0; ks < 8; ++ks) {
          bf16x8 a = mf[ks * 64];
          t0 = MFMA32(a, xs[ks][0], t0);
          t1 = MFMA32(a, xs[ks][1], t1);
        }
        const int ri = mt >> 1;
        const bool odd = (lane & 1) != 0;
        const unsigned tbase = opqu((unsigned)(((((size_t)b * 64 + 32 * (mt & 1) + 4 * h + (odd ? 1 : 0)) * 128 + ri * 64 + s2) * 512 + 64 * w + ((lane & 31) & ~1)) * 2));
        float v0[16], v1[16];
#pragma unroll
        for (int r = 0; r < 16; ++r) { v0[r] = t0[r]; v1[r] = t1[r]; }
        store_tile_pairs(v0, (char*)p.T + tbase, 128u * 512u * 2u, odd);
        store_tile_pairs(v1, (char*)p.T + tbase + 64, 128u * 512u * 2u, odd);
      }
    }
  }
}

#define XS_STRIDE 272
#define XS_BYTES (32 * XS_STRIDE)
DI void phase2(const MP& p, char* smem) {
  const int tid = threadIdx.x, lane = tid & 63, w = __builtin_amdgcn_readfirstlane(tid >> 6), h = lane >> 5;
  {
    const int nactive = min(8, (512 + (int)gridDim.x - 1) / (int)gridDim.x);
    if (nactive >= 8) {
      late_prep(p, (long)blockIdx.x * NTHR + tid, (long)gridDim.x * NTHR);
    } else if (w >= nactive) {
      const long nidle = 8 - nactive;
      late_prep(p, ((long)blockIdx.x * nidle + (w - nactive)) * 64 + lane, (long)gridDim.x * nidle * 64);
    }
  }
#pragma unroll 1
  for (int task = w * gridDim.x + blockIdx.x; task < 512; task += 8 * gridDim.x) {
    const int dir = task & 1, g = (task >> 1) & 31, bp = task >> 6;
    const int dg = dir * 32 + g;
    char* xt = smem + w * XS_BYTES;
    bf16x8 bfr[4], cf[4];
#pragma unroll
    for (int nt = 0; nt < 4; ++nt) bfr[nt] = p.s5B[(size_t)(dg * 4 + nt) * 64 + lane];
#pragma unroll
    for (int ks = 0; ks < 4; ++ks) cf[ks] = p.s5C[(size_t)(dg * 4 + ks) * 64 + lane];
    const int pp = lane & 31;
    const float lr0 = p.s5lam[((size_t)dg * 64 + pp) * 2], li0 = p.s5lam[((size_t)dg * 64 + pp) * 2 + 1];
    const float lr1 = p.s5lam[((size_t)dg * 64 + 32 + pp) * 2], li1 = p.s5lam[((size_t)dg * 64 + 32 + pp) * 2 + 1];
    const int rho = lane & 31;
    const int hr = (rho >> 2) & 1, rr = (rho & 3) + 4 * (rho >> 3);
    const size_t ubase = ((size_t)(2 * bp + hr) * 4096) * 512 + g * 16 + 8 * h;
    float xr0 = 0.f, xi0 = 0.f, xr1 = 0.f, xi1 = 0.f;
    bf16x8 aq[4];
#pragma unroll
    for (int d = 0; d < 4; ++d) { int q = 16 * d + rr; int tpos = dir ? (4095 - q) : q; aq[d] = *(const bf16x8*)(p.U + ubase + (size_t)tpos * 512); }
    unsigned short* yo = dir ? p.YB : p.YF;
#pragma unroll 1
    for (int step0 = 0; step0 < 256; step0 += 4) {
#pragma unroll
      for (int d = 0; d < 4; ++d) {
        const int step = step0 + d;
        bf16x8 a = aq[d];
        { int q = 16 * min(step + 4, 255) + rr; int tpos = dir ? (4095 - q) : q; aq[d] = *(const bf16x8*)(p.U + ubase + (size_t)tpos * 512); }
        f32x16 br0 = MFMA32(a, bfr[0], zero16());
        f32x16 br1 = MFMA32(a, bfr[1], zero16());
        f32x16 bi0 = MFMA32(a, bfr[2], zero16());
        f32x16 bi1 = MFMA32(a, bfr[3], zero16());
        char* xrow = xt + (h * 16) * XS_STRIDE + (2 * (lane & 31)) * 2;
#pragma unroll
        for (int r = 0; r < 16; ++r) {
          float n0r = fmaf(lr0, xr0, fmaf(-li0, xi0, br0[r]));
          float n0i = fmaf(lr0, xi0, fmaf(li0, xr0, bi0[r]));
          float n1r = fmaf(lr1, xr1, fmaf(-li1, xi1, br1[r]));
          float n1i = fmaf(lr1, xi1, fmaf(li1, xr1, bi1[r]));
          xr0 = n0r; xi0 = n0i; xr1 = n1r; xi1 = n1i;
          *(unsigned*)(xrow + r * XS_STRIDE) = cvtpk(xr0, xi0);
          *(unsigned*)(xrow + r * XS_STRIDE + 128) = cvtpk(xr1, xi1);
        }
        __builtin_amdgcn_wave_barrier();
#pragma unroll
        for (int mt = 0; mt < 2; ++mt) {
          f32x4 y = {0.f, 0.f, 0.f, 0.f};
#pragma unroll
          for (int ks = 0; ks < 4; ++ks) {
            bf16x8 xa = *(const bf16x8*)(xt + (mt * 16 + (lane & 15)) * XS_STRIDE + (32 * ks + 8 * (lane >> 4)) * 2);
            y = MFMA16(xa, cf[ks], y);
          }
          {
            const bool odd = (lane & 1) != 0;
#pragma unroll
            for (int r = 0; r < 4; r += 2) {
              const float send = odd ? y[r] : y[r + 1];
              const float recv = __builtin_bit_cast(float, __builtin_amdgcn_mov_dpp(__builtin_bit_cast(int, send), 0xB1, 0xF, 0xF, true));
              const float lo = odd ? recv : y[r], hi = odd ? y[r + 1] : recv;
              const int q = 16 * step + 4 * (lane >> 4) + r + (odd ? 1 : 0);
              const int tpos = dir ? (4095 - q) : q;
              *(unsigned*)(yo + ((size_t)(2 * bp + mt) * 4096 + tpos) * 512 + g * 16 + ((lane & 15) & ~1)) = cvtpk(lo, hi);
            }
          }
        }
        __builtin_amdgcn_wave_barrier();
      }
    }
  }
}
DI int f2key(float f) { return __float_as_int(__builtin_amdgcn_fmed3f(f, -60.f, 60.f) + 64.f); }
DI float key2f(int k) { return __int_as_float(k) - 64.f; }
#define CE_DESC(a, b) { int mx_ = max(a, b), mn_ = min(a, b); a = mx_; b = mn_; }
#define CE_ASC(a, b) { int mx_ = max(a, b), mn_ = min(a, b); a = mn_; b = mx_; }

#define S16(i, j) CE_DESC(v[i], v[j])
DI void sort16_desc(int (&v)[16]) {
  S16(0,13) S16(1,12) S16(2,15) S16(3,14) S16(4,8) S16(5,6) S16(7,11) S16(9,10)
  S16(0,5) S16(1,7) S16(2,9) S16(3,4) S16(6,13) S16(8,14) S16(10,15) S16(11,12)
  S16(0,1) S16(2,3) S16(4,5) S16(6,8) S16(7,9) S16(10,11) S16(12,13) S16(14,15)
  S16(0,2) S16(1,3) S16(4,10) S16(5,11) S16(6,7) S16(8,9) S16(12,14) S16(13,15)
  S16(1,2) S16(3,12) S16(4,6) S16(5,7) S16(8,10) S16(9,11) S16(13,14)
  S16(1,4) S16(2,6) S16(5,8) S16(7,10) S16(9,13) S16(11,14)
  S16(2,4) S16(3,6) S16(9,12) S16(11,13)
  S16(3,5) S16(6,8) S16(7,9) S16(10,12)
  S16(3,4) S16(5,6) S16(7,8) S16(9,10) S16(11,12)
  S16(6,7) S16(8,9)
}
DI void merge16_desc(int (&a)[16], const int (&b)[16]) {
#pragma unroll
  for (int i = 0; i < 16; ++i) a[i] = max(a[i], b[15 - i]);
#pragma unroll
  for (int j = 8; j > 0; j >>= 1) {
#pragma unroll
    for (int i = 0; i < 16; ++i) {
      const int l = i ^ j;
      if (l > i) { CE_DESC(a[i], a[l]); }
    }
  }
}
DI void top16_of_64(const int (&k)[64], int (&out)[16]) {
  int g1[16], g2[16], g3[16];
#pragma unroll
  for (int i = 0; i < 16; ++i) { out[i] = k[i]; g1[i] = k[16 + i]; g2[i] = k[32 + i]; g3[i] = k[48 + i]; }
  sort16_desc(out); sort16_desc(g1); sort16_desc(g2); sort16_desc(g3);
  merge16_desc(out, g1); merge16_desc(g2, g3); merge16_desc(out, g2);
}

DI float reduce_scatter32(float (&v)[32], int lane) {
  float a[16];
  {
    const bool up = (lane & 16) != 0;
#pragma unroll
    for (int i = 0; i < 16; ++i) { float keep = up ? v[16 + i] : v[i]; float send = up ? v[i] : v[16 + i]; a[i] = keep + __shfl_xor(send, 16, 64); }
  }
  float b[8];
  {
    const bool up = (lane & 8) != 0;
#pragma unroll
    for (int i = 0; i < 8; ++i) { float keep = up ? a[8 + i] : a[i]; float send = up ? a[i] : a[8 + i]; b[i] = keep + __shfl_xor(send, 8, 64); }
  }
  float c[4];
  {
    const bool up = (lane & 4) != 0;
#pragma unroll
    for (int i = 0; i < 4; ++i) { float keep = up ? b[4 + i] : b[i]; float send = up ? b[i] : b[4 + i]; c[i] = keep + __shfl_xor(send, 4, 64); }
  }
  float d[2];
  {
    const bool up = (lane & 2) != 0;
#pragma unroll
    for (int i = 0; i < 2; ++i) { float keep = up ? c[2 + i] : c[i]; float send = up ? c[i] : c[2 + i]; d[i] = keep + __shfl_xor(send, 2, 64); }
  }
  {
    const bool up = (lane & 1) != 0;
    float keep = up ? d[1] : d[0]; float send = up ? d[0] : d[1];
    return keep + __shfl_xor(send, 1, 64);
  }
}
DI float reduce_scatter64(float (&v)[64], int lane) {
  float a[32];
  const bool up = (lane & 32) != 0;
#pragma unroll
  for (int i = 0; i < 32; ++i) { float keep = up ? v[32 + i] : v[i]; float send = up ? v[i] : v[32 + i]; a[i] = keep + __shfl_xor(send, 32, 64); }
  return reduce_scatter32(a, lane);
}

__host__ __device__ constexpr int cand_ij(int c) {
  int n = 0;
  for (int a = 0; a < 16; ++a)
    for (int b = 0; b < 16; ++b)
      if ((a + 1) * (b + 1) <= 16) { if (n == c) return a * 16 + b; ++n; }
  return 0;
}
__host__ __device__ constexpr int cand_index(int i, int j) {
  int n = 0;
  for (int a = 0; a < 16; ++a)
    for (int b = 0; b < 16; ++b)
      if ((a + 1) * (b + 1) <= 16) { if (a == i && b == j) return n; ++n; }
  return n;
}
static_assert(cand_index(15, 0) == 49, "50 candidates");
DI float erf_as(float z) {
  const float az = fabsf(z);
  const float t = __builtin_amdgcn_rcpf(fmaf(0.3275911f, az, 1.0f));
  float pl = fmaf(1.061405429f, t, -1.453152027f);
  pl = fmaf(pl, t, 1.421413741f);
  pl = fmaf(pl, t, -0.284496736f);
  pl = fmaf(pl, t, 0.254829592f);
  pl *= t;
  const float ex = __expf(-az * az);
  const float r = fmaf(-pl, ex, 1.0f);
  return copysignf(r, z);
}
DI float gelu_f(float x) { return 0.5f * x * (1.0f + erf_as(x * 0.70710678118654752440f)); }

DI void phase3(const MP& p, char* smem) {
  const int tid = threadIdx.x, lane = tid & 63, w = __builtin_amdgcn_readfirstlane(tid >> 6), h = lane >> 5;
  char* atile = smem;
  float* rinv2 = (float*)(smem + ATILE_BYTES);
  float* part = rinv2 + 64;
  for (int tt = blockIdx.x; tt < 1024; tt += gridDim.x) {
    const int b = tt >> 6, k1 = tt & 63;
    const size_t tok0 = (size_t)b * 4096 + k1;
    __syncthreads();
#pragma unroll
    for (int it = 0; it < 8; ++it) {
      int chunk = opq(tid + NTHR * it);
      int r = chunk >> 6, c8 = chunk & 63;
      size_t off = (tok0 + 64 * (size_t)r) * 512 + c8 * 8;
      u32x4 yf = *(const u32x4*)(p.YF + off), yb = *(const u32x4*)(p.YB + off), uu = *(const u32x4*)(p.U + off);
      float4 d0 = *(const float4*)(p.ssm_d + c8 * 8), d1 = *(const float4*)(p.ssm_d + c8 * 8 + 4);
      float dd[8] = {d0.x, d0.y, d0.z, d0.w, d1.x, d1.y, d1.z, d1.w};
      u32x4 o;
#pragma unroll
      for (int q = 0; q < 4; ++q) {
        float lo = bflo(yf[q]) + bflo(yb[q]) + dd[2 * q] * bflo(uu[q]);
        float hi = bfhi(yf[q]) + bfhi(yb[q]) + dd[2 * q + 1] * bfhi(uu[q]);
        o[q] = cvtpk(gelu_f(lo), gelu_f(hi));
      }
      *(u32x4*)(atile + r * ASTRIDE + c8 * 16) = o;
    }
    __syncthreads();
    f32x16 gacc[2][2];
#pragma unroll
    for (int i = 0; i < 2; ++i)
#pragma unroll
      for (int j = 0; j < 2; ++j) gacc[i][j] = zero16();
    gemm_tile<2, 4>(gacc, atile, 0, p.WgluF + (size_t)(2 * w) * 32 * 64, 32, 32, opq(lane));
    {
      f32x16 facc[2][2];
#pragma unroll
      for (int i = 0; i < 2; ++i)
#pragma unroll
        for (int j = 0; j < 2; ++j) facc[i][j] = zero16();
      const int lnf = opq(lane);
      const unsigned short* m3 = p.M3T + ((size_t)k1 + 64 * (size_t)(lnf & 31)) * 128 + 8 * (lnf >> 5);
      const unsigned short* tb = p.T + (((size_t)b * 64 + k1) * 128 + 8 * (lnf >> 5)) * 512 + 64 * w + (lnf & 31);
#pragma unroll 4
      for (int ks = 0; ks < 8; ++ks) {
        bf16x8 a0 = *(const bf16x8*)(m3 + 16 * ks);
        bf16x8 a1 = *(const bf16x8*)(m3 + (size_t)32 * 64 * 128 + 16 * ks);
        bf16x8 b0, b1;
#pragma unroll
        for (int j = 0; j < 8; ++j) {
          b0[j] = (short)tb[((size_t)16 * ks + j) * 512];
          b1[j] = (short)tb[((size_t)16 * ks + j) * 512 + 32];
        }
        facc[0][0] = MFMA32(a0, b0, facc[0][0]); facc[1][0] = MFMA32(a1, b0, facc[1][0]);
        facc[0][1] = MFMA32(a0, b1, facc[0][1]); facc[1][1] = MFMA32(a1, b1, facc[1][1]);
      }
#pragma unroll
      for (int mt = 0; mt < 2; ++mt)
#pragma unroll
        for (int nt = 0; nt < 2; ++nt)
#pragma unroll
          for (int r = 0; r < 16; ++r) {
            int row = 32 * mt + crow(r, lnf >> 5), col = 512 + 64 * w + 32 * nt + (lnf & 31);
            *(unsigned short*)(atile + row * ASTRIDE + col * 2) = f2bf(facc[mt][nt][r]);
          }
    }
    __syncthreads();
    {
    const int lng = opq(lane);
#pragma unroll
    for (int mt = 0; mt < 2; ++mt)
#pragma unroll
      for (int nt = 0; nt < 2; ++nt)
#pragma unroll
        for (int r = 0; r < 16; ++r) {
          int row = 32 * mt + crow(r, lng >> 5), col = 64 * w + 32 * nt + (lng & 31);
          unsigned short* q = (unsigned short*)(atile + row * ASTRIDE + col * 2);
          float yv = bf2f(*q);
          *q = f2bf(yv / (1.0f + __expf(-gacc[mt][nt][r])));
        }
    }
    __syncthreads();
    {
      f32x16 acc[2][4];
#pragma unroll
      for (int i = 0; i < 2; ++i)
#pragma unroll
        for (int j = 0; j < 4; ++j) acc[i][j] = zero16();
      float pfx[4];
      {
        const int t_ = opq(tid);
#pragma unroll
        for (int q = 0; q < 4; ++q) { const int ln = t_ + NTHR * q; pfx[q] = p.x[(tok0 + 64 * (size_t)(ln >> 5)) * 1024 + (ln & 31) * 32]; }
      }
      gemm_tile<4, 2>(acc, atile, 0, p.WoutF + (size_t)(4 * w) * 64 * 64, 64, 64, opq(lane));
      asm volatile("" :: "v"(pfx[0]), "v"(pfx[1]), "v"(pfx[2]), "v"(pfx[3]));
      __syncthreads();
      float ss[32];
#pragma unroll
      for (int i = 0; i < 32; ++i) ss[i] = 0.f;
      {
        const int lnd = opq(lane);
        const unsigned gbase = (unsigned)(((tok0 + 256 * (lnd >> 5)) * 1024 + 128 * w + (lnd & 31)) * 4);
#pragma unroll
        for (int mt = 0; mt < 2; ++mt)
#pragma unroll
          for (int nt = 0; nt < 4; ++nt) {
            const unsigned gb = opqu(gbase + (unsigned)((32 * mt * 64 * 1024 + 32 * nt) * 4));
            char* lb = atile + opq((32 * mt + 4 * (lnd >> 5)) * ASTRIDE + (128 * w + 32 * nt + (lnd & 31)) * 2);
#pragma unroll
            for (int r = 0; r < 16; ++r) {
              const int rc = (r & 3) + 8 * (r >> 2);
              const unsigned go = gb + (unsigned)(rc * 64 * 1024 * 4);
              float v = *(const float*)((const char*)p.x + go) + acc[mt][nt][r];
              *(unsigned short*)(lb + rc * ASTRIDE) = f2bf(v);
              ss[mt * 16 + r] = fmaf(v, v, ss[mt * 16 + r]);
            }
          }
      }
      float tot = reduce_scatter32(ss, lane);
      {
        int L = lane & 31;
        part[w * 64 + 32 * (L >> 4) + crow(L & 15, h)] = tot;
      }
    }
    __syncthreads();
#pragma unroll 4
    for (int it = 0; it < 16; ++it) {
      const int chunk = opq(tid + NTHR * it);
      const int r = chunk >> 7, c8 = chunk & 127;
      const u32x4 xb = *(const u32x4*)(atile + r * ASTRIDE + c8 * 16);
      const size_t go = (tok0 + 64 * (size_t)r) * 1024 + c8 * 8;
      *(u32x4*)(p.X2B + go) = xb;
      unsigned hw[2], lw[2];
#pragma unroll
      for (int q = 0; q < 2; ++q) {
        hw[q] = 0u; lw[q] = 0u;
#pragma unroll
        for (int e = 0; e < 4; ++e) {
          const unsigned wv = xb[2 * q + (e >> 1)];
          const float x8 = ((e & 1) ? bfhi(wv) : bflo(wv)) * 8.f;
          const float hf = rintf(__builtin_amdgcn_fmed3f(x8, -127.f, 127.f));
          const float lf = rintf(__builtin_amdgcn_fmed3f((x8 - hf) * 128.f, -127.f, 127.f));
          hw[q] |= ((unsigned)((int)hf & 0xff)) << (8 * e);
          lw[q] |= ((unsigned)((int)lf & 0xff)) << (8 * e);
        }
      }
      u32x2 hv = {hw[0], hw[1]}, lv = {lw[0], lw[1]};
      *(u32x2*)(p.X8H + go) = hv;
      *(u32x2*)(p.X8L + go) = lv;
    }
    if (tid < 64) {
      float s = 0.f;
#pragma unroll
      for (int i = 0; i < 8; ++i) s += part[i * 64 + tid];
      rinv2[tid] = rsqrtf(s * (1.0f / 1024.f) + 1e-6f);
    }
    __syncthreads();
    int sk[2][16];
#pragma unroll
    for (int pq = 0; pq < 2; ++pq) {
      int run[2][16];
#pragma unroll
      for (int half = 0; half < 2; ++half) {
        f32x16 acc[2][2];
#pragma unroll
        for (int i = 0; i < 2; ++i)
#pragma unroll
          for (int j = 0; j < 2; ++j) acc[i][j] = zero16();
        {
          const int ln = opq(lane);
          const char* bbase = atile + (ln & 31) * ASTRIDE + (8 * (ln >> 5)) * 2;
          const char* wq = (const char*)(p.WqkF + (size_t)(8 * w + 4 * pq + 2 * half) * 64 * 64);
          const unsigned loff = (unsigned)ln * 16u;
          bf16x8 aq[PD][2];
#pragma unroll
          for (int d = 0; d < PD; ++d) { aq[d][0] = *(const bf16x8*)(wq + (unsigned)d * 1024u + loff); aq[d][1] = *(const bf16x8*)(wq + (unsigned)(64 + d) * 1024u + loff); }
#pragma unroll 1
          for (int ks0 = 0; ks0 < 64; ks0 += PD) {
#pragma unroll
            for (int d = 0; d < PD; ++d) {
              const int ks = ks0 + d;
              bf16x8 x0 = *(const bf16x8*)(bbase + ks * 32);
              bf16x8 x1 = *(const bf16x8*)(bbase + 32 * ASTRIDE + ks * 32);
              bf16x8 a0 = aq[d][0], a1 = aq[d][1];
              const unsigned ksn = opqs((unsigned)min(ks + PD, 63) * 1024u);
              aq[d][0] = *(const bf16x8*)(wq + ksn + loff); aq[d][1] = *(const bf16x8*)(wq + (ksn + 65536u) + loff);
              acc[0][0] = MFMA32(a0, x0, acc[0][0]); acc[0][1] = MFMA32(a0, x1, acc[0][1]);
              acc[1][0] = MFMA32(a1, x0, acc[1][0]); acc[1][1] = MFMA32(a1, x1, acc[1][1]);
            }
          }
        }
#pragma unroll
        for (int nt = 0; nt < 2; ++nt) {
#pragma unroll
          for (int mt = 0; mt < 2; ++mt) {
            int g[16];
            const int hb = opq(4 * h);
#pragma unroll
            for (int r = 0; r < 16; ++r) g[r] = (f2key(acc[mt][nt][r]) & ~0x7f) | (32 * (2 * half + mt) + (r & 3) + 8 * (r >> 2)) | hb;
            sort16_desc(g);
            if (half == 0 && mt == 0) {
#pragma unroll
              for (int i = 0; i < 16; ++i) run[nt][i] = g[i];
            } else {
              merge16_desc(run[nt], g);
            }
          }
        }
      }
      {
        int mine[16], other[16];
#pragma unroll
        for (int i = 0; i < 16; ++i) {
          const int give = h ? run[0][i] : run[1][i];
          mine[i] = h ? run[1][i] : run[0][i];
          other[i] = __shfl_xor(give, 32, 64);
        }
        merge16_desc(mine, other);
#pragma unroll
        for (int i = 0; i < 16; ++i) sk[pq][i] = mine[i];
      }
    }
    {
      float v0[16], v1[16];
      unsigned i0p[4], i1p[4];
      {
        int s0[16], s1[16];
#pragma unroll
        for (int i = 0; i < 16; ++i) { s0[i] = sk[0][i]; s1[i] = sk[1][i]; }
        const float sc = rinv2[32 * h + (lane & 31)];
#pragma unroll
        for (int i = 0; i < 16; ++i) { v0[i] = key2f(s0[i] & ~0x7f) * sc; v1[i] = key2f(s1[i] & ~0x7f) * sc; }
#pragma unroll
        for (int q = 0; q < 4; ++q) {
          i0p[q] = (unsigned)(s0[4 * q] & 0x7f) | ((unsigned)(s0[4 * q + 1] & 0x7f) << 8) | ((unsigned)(s0[4 * q + 2] & 0x7f) << 16) | ((unsigned)(s0[4 * q + 3] & 0x7f) << 24);
          i1p[q] = (unsigned)(s1[4 * q] & 0x7f) | ((unsigned)(s1[4 * q + 1] & 0x7f) << 8) | ((unsigned)(s1[4 * q + 2] & 0x7f) << 16) | ((unsigned)(s1[4 * q + 3] & 0x7f) << 24);
        }
      }
      int top[16];
#pragma unroll
      for (int grp = 0; grp < 4; ++grp) {
        int g[16];
#pragma unroll
        for (int t = 0; t < 16; ++t) {
          const int c = 16 * grp + t;
          if (c < 50) { const int ij = cand_ij(c); g[t] = (f2key(v0[ij >> 4] + v1[ij & 15]) & ~0xff) | ij; }
          else g[t] = (int)0x80000000;
        }
        sort16_desc(g);
        if (grp == 0) {
#pragma unroll
          for (int t = 0; t < 16; ++t) top[t] = g[t];
        } else {
          merge16_desc(top, g);
        }
      }
      float sum = 0.f;
      float mx = key2f(top[0] & ~0xff);
      float ev[16];
#pragma unroll
      for (int r = 0; r < 16; ++r) { ev[r] = __expf(key2f(top[r] & ~0xff) - mx); sum += ev[r]; }
      const float inv = 1.0f / sum;
      u32x4 o[4];
#pragma unroll
      for (int r = 0; r < 16; ++r) {
        int code = top[r] & 0xff, ci = code >> 4, cj = code & 15;
        unsigned w0 = (ci >> 2) == 0 ? i0p[0] : (ci >> 2) == 1 ? i0p[1] : (ci >> 2) == 2 ? i0p[2] : i0p[3];
        unsigned w1 = (cj >> 2) == 0 ? i1p[0] : (cj >> 2) == 1 ? i1p[1] : (cj >> 2) == 2 ? i1p[2] : i1p[3];
        unsigned e0 = (w0 >> ((ci & 3) * 8)) & 0x7f, e1 = (w1 >> ((cj & 3) * 8)) & 0x7f;
        unsigned e = e0 * 128 + e1;
        o[r >> 2][r & 3] = (e << 16) | (cvtpk(ev[r] * inv, 0.f) & 0xffffu);
      }
      const int lnp = opq(lane);
      unsigned* pr = p.PAIRS + (tok0 + 64 * (size_t)(32 * (lnp >> 5) + (lnp & 31))) * 128 + w * 16;
#pragma unroll
      for (int q = 0; q < 4; ++q) *(u32x4*)(pr + 4 * q) = o[q];
      {
        u32x4 e0, e1;
#pragma unroll
        for (int q = 0; q < 4; ++q) {
          e0[q] = (o[q >> 1][2 * (q & 1)] >> 16) | (o[q >> 1][2 * (q & 1) + 1] & 0xffff0000u);
          e1[q] = (o[2 + (q >> 1)][2 * (q & 1)] >> 16) | (o[2 + (q >> 1)][2 * (q & 1) + 1] & 0xffff0000u);
        }
        unsigned short* er = p.E16 + (tok0 + 64 * (size_t)(32 * (lnp >> 5) + (lnp & 31))) * 128 + w * 16;
        *(u32x4*)er = e0; *(u32x4*)(er + 8) = e1;
      }
    }
    if (tid < 64) p.RINV2[tok0 + 64 * (size_t)tid] = rinv2[tid];
  }
}


#define XB_TMO      128
#define XB_XCNT(j)  (256  + 64 * (j))
#define XB_XSUB(j)  (1280 + 64 * (j))
#define XB_XGEN(j)  (2304 + 64 * (j))
#define XB_TOP      3328
#define XB_TOPGEN   3392
#define XCD_BAR_WORDS 3456
#define XB_SPIN_CAP (1u << 22)
#define LAS __attribute__((address_space(3)))
DI unsigned xb_ld(unsigned* p) { return __hip_atomic_load(p, __ATOMIC_RELAXED, __HIP_MEMORY_SCOPE_AGENT); }
DI unsigned xb_add(unsigned* p, unsigned v) { return __hip_atomic_fetch_add(p, v, __ATOMIC_RELAXED, __HIP_MEMORY_SCOPE_AGENT); }
DI unsigned xb_xcc_id() { return (unsigned)__builtin_amdgcn_s_getreg((3 << 11) | 20) & 0xFu; }
#define XB_SPIN(cond, bar) do { unsigned _sp = 0; while (cond) { __builtin_amdgcn_s_sleep(1); \
    if ((++_sp & 255u) == 0u) { if (xb_ld(&(bar)[XB_TMO])) break; if (_sp > XB_SPIN_CAP) { atomicAdd(&(bar)[XB_TMO], 1u); break; } } } } while (0)
struct XcdBarrier { unsigned* bar; unsigned x; volatile LAS unsigned* st; };
DI XcdBarrier xcd_barrier_post(unsigned* bar, volatile LAS unsigned* st) {
  XcdBarrier b; b.bar = bar; b.x = xb_xcc_id(); b.st = st;
  if (threadIdx.x == 0) (void)xb_add(&bar[XB_XCNT(b.x)], 1u);
  return b;
}
DI void xcd_barrier_complete(unsigned* bar, unsigned x, unsigned& nloc, unsigned& nx) {
  const unsigned G = gridDim.x * gridDim.y * gridDim.z;
  unsigned sum, cnt, mine, sp = 0u;
  for (;;) {
    sum = 0u; cnt = 0u; mine = 0u;
#pragma unroll
    for (unsigned j = 0; j < 16; ++j) { const unsigned c = xb_ld(&bar[XB_XCNT(j)]); sum += c; cnt += (c > 0u) ? 1u : 0u; mine = (j == x) ? c : mine; }
    if (sum == G) break;
    __builtin_amdgcn_s_sleep(1);
    if ((++sp & 255u) == 0u) { if (xb_ld(&bar[XB_TMO])) break; if (sp > XB_SPIN_CAP) { atomicAdd(&bar[XB_TMO], 1u); break; } }
  }
  nloc = mine > 0u ? mine : 1u; nx = cnt > 0u ? cnt : 1u;
}
DI void xcd_barrier(const XcdBarrier& b) {
  asm volatile("s_waitcnt vmcnt(0)" ::: "memory");
  __syncthreads();
  if (threadIdx.x == 0) {
    unsigned* bar = b.bar;
    __builtin_amdgcn_s_waitcnt(0);
    unsigned nloc = b.st[0], nx = b.st[1];
    if (nloc == 0u) { xcd_barrier_complete(bar, b.x, nloc, nx); b.st[0] = nloc; b.st[1] = nx; }
    const unsigned old = xb_add(&bar[XB_XSUB(b.x)], 1u);
    const unsigned gen = old / nloc;
    if (old + 1u == (gen + 1u) * nloc) {
      __builtin_amdgcn_fence(__ATOMIC_RELEASE, "agent");
      asm volatile("s_waitcnt vmcnt(0)" ::: "memory");
      const unsigned og = xb_add(&bar[XB_TOP], 1u);
      const unsigned tg = og / nx;
      if (og + 1u == (tg + 1u) * nx) xb_add(&bar[XB_TOPGEN], 1u);
      else XB_SPIN(xb_ld(&bar[XB_TOPGEN]) == tg, bar);
      __builtin_amdgcn_fence(__ATOMIC_ACQUIRE, "agent");
      xb_add(&bar[XB_XGEN(b.x)], 1u);
      asm volatile("s_waitcnt vmcnt(0)" ::: "memory");
    } else {
      XB_SPIN(xb_ld(&bar[XB_XGEN(b.x)]) == gen, bar);
      __builtin_amdgcn_fence(__ATOMIC_ACQUIRE, "agent");
      asm volatile("s_waitcnt vmcnt(0)" ::: "memory");
    }
  }
  __syncthreads();
}

DI f32x2_t dec_lo(unsigned w) { return __builtin_amdgcn_cvt_pk_f32_fp8((int)w, false); }
DI f32x2_t dec_hi(unsigned w) { return __builtin_amdgcn_cvt_pk_f32_fp8((int)w, true); }
#define PCHUNK 16
#define NPCHUNK (NTOK / PCHUNK)
#define DPP_XOR1 0xB1
#define DPP_XOR2 0x4E
#define DPP_HALF_MIRROR 0x141
#define DPP_ROR8 0x128
template <int CTRL> DI int dpp_i(int v) { return __builtin_amdgcn_mov_dpp(v, CTRL, 0xF, 0xF, true); }
template <int CTRL> DI float dpp_f(float v) { return __builtin_bit_cast(float, __builtin_amdgcn_mov_dpp(__builtin_bit_cast(int, v), CTRL, 0xF, 0xF, true)); }
DI void phase4(const MP& p, char* smem) {
  const int lane = threadIdx.x & 63, w = __builtin_amdgcn_readfirstlane(threadIdx.x >> 6), g = lane >> 3, i = lane & 7;
  const unsigned xcc = xb_xcc_id() & 7u;
  const unsigned loff = 16u * (unsigned)i;
  char* stg = smem + w * 8192;
#pragma unroll 1
  for (int s = 0; s < 8; ++s) {
    const int slice = (int)((xcc + s) & 7u);
    unsigned* ctr = p.CTR + (size_t)slice * 64;
    const unsigned char* tbs = p.EU + (size_t)slice * 16384 * 128;
    _Float16* pre = (_Float16*)p.PRE + (size_t)slice * NTOK * 128 + 16 * g + 2 * i;
#pragma unroll 1
    for (;;) {
      unsigned c = 0;
      if (lane == 0) c = atomicAdd(ctr, 1u);
      c = (unsigned)__builtin_amdgcn_readfirstlane((int)c);
      if (c >= NPCHUNK) break;
      const size_t tokb = (size_t)c * PCHUNK;
      {
        const u32x4* ep = (const u32x4*)(p.E16 + tokb * 128) + lane;
        u32x4 ev[4], hv[2], lv[2];
#pragma unroll
        for (int j = 0; j < 4; ++j) ev[j] = ep[64 * j];
#pragma unroll
        for (int j = 0; j < 2; ++j) {
          const size_t xo = (tokb + 8 * j + (lane >> 3)) * 1024 + 128 * slice + loff;
          hv[j] = *(const u32x4*)(p.X8H + xo); lv[j] = *(const u32x4*)(p.X8L + xo);
        }
        __builtin_amdgcn_wave_barrier();
#pragma unroll
        for (int j = 0; j < 4; ++j) *(u32x4*)(stg + 1024 * j + 16 * lane) = ev[j];
#pragma unroll
        for (int j = 0; j < 2; ++j) { *(u32x4*)(stg + 4096 + 1024 * j + 16 * lane) = hv[j]; *(u32x4*)(stg + 6144 + 1024 * j + 16 * lane) = lv[j]; }
        __builtin_amdgcn_wave_barrier();
      }
#pragma unroll 1
      for (int tt = 0; tt < PCHUNK; ++tt) {
        const size_t tok = tokb + tt;
        const u32x4 pw0 = *(const u32x4*)(stg + 256 * tt + 32 * g), pw1 = *(const u32x4*)(stg + 256 * tt + 32 * g + 16);
        const u32x4 xh = *(const u32x4*)(stg + 4096 + 128 * tt + loff), xl = *(const u32x4*)(stg + 6144 + 128 * tt + loff);
        u32x4 ua[16];
#pragma unroll
        for (int k = 0; k < 16; ++k) {
          const unsigned e = __builtin_amdgcn_ubfe(k < 8 ? pw0[(k >> 1) & 3] : pw1[(k >> 1) & 3], 16 * (k & 1), 16);
          ua[k] = *(const u32x4*)(tbs + ((e << 7) | loff));
        }
        int v[16];
#pragma unroll
        for (int k = 0; k < 16; ++k) {
          int ah = 0, al = 0;
#pragma unroll
          for (int q = 0; q < 4; ++q) {
            ah = __builtin_amdgcn_sdot4((int)ua[k][q], (int)xh[q], ah, false);
            al = __builtin_amdgcn_sdot4((int)ua[k][q], (int)xl[q], al, false);
          }
          v[k] = (ah << 7) + al;
        }
        int a8[8], a4[4], a2[2];
        { const bool up = (lane & 4) != 0;
#pragma unroll
          for (int k = 0; k < 8; ++k) { const int keep = up ? v[8 + k] : v[k]; const int send = up ? v[k] : v[8 + k]; a8[k] = keep + dpp_i<DPP_HALF_MIRROR>(send); } }
        { const bool up = (lane & 2) != 0;
#pragma unroll
          for (int k = 0; k < 4; ++k) { const int keep = up ? a8[4 + k] : a8[k]; const int send = up ? a8[k] : a8[4 + k]; a4[k] = keep + dpp_i<DPP_XOR2>(send); } }
        { const bool up = (lane & 1) != 0;
#pragma unroll
          for (int k = 0; k < 2; ++k) { const int keep = up ? a4[2 + k] : a4[k]; const int send = up ? a4[k] : a4[2 + k]; a2[k] = keep + dpp_i<DPP_XOR1>(send); } }
        const float sc = 1.0f / 1048576.f;
        f16x2_t o2 = {(_Float16)((float)a2[0] * sc), (_Float16)((float)a2[1] * sc)};
        *(f16x2_t*)(pre + tok * 128) = o2;
      }
      __builtin_amdgcn_wave_barrier();
    }
  }
}
DI void phase5(const MP& p) {
  const long gtid = (long)blockIdx.x * NTHR + threadIdx.x;
  const long gsz = (long)gridDim.x * NTHR;
#pragma unroll 1
  for (long u = gtid; u < (long)NTOK * 32; u += gsz) {
    const long tok = u >> 5; const int q4 = (int)(u & 31) * 4;
    float4 s = make_float4(0.f, 0.f, 0.f, 0.f);
#pragma unroll
    for (int sl = 0; sl < 8; ++sl) {
      const u32x2 v = *(const u32x2*)((const _Float16*)p.PRE + ((size_t)sl * NTOK + tok) * 128 + q4);
      const f16x2_t v01 = as_h2(v[0]), v23 = as_h2(v[1]);
      s.x += (float)v01[0]; s.y += (float)v01[1]; s.z += (float)v23[0]; s.w += (float)v23[1];
    }
    const float ri = p.RINV2[tok];
    u32x4 pw = *(const u32x4*)(p.PAIRS + tok * 128 + q4);
    float4 a;
    a.x = gelu_f(s.x * ri) * bflo(pw[0]) * 16.f; a.y = gelu_f(s.y * ri) * bflo(pw[1]) * 16.f;
    a.z = gelu_f(s.z * ri) * bflo(pw[2]) * 16.f; a.w = gelu_f(s.w * ri) * bflo(pw[3]) * 16.f;
    int hw = __builtin_amdgcn_cvt_pk_fp8_f32(a.x, a.y, 0, false);
    hw = __builtin_amdgcn_cvt_pk_fp8_f32(a.z, a.w, hw, true);
    const f32x2_t d01 = __builtin_amdgcn_cvt_pk_f32_fp8(hw, false), d23 = __builtin_amdgcn_cvt_pk_f32_fp8(hw, true);
    int lw = __builtin_amdgcn_cvt_pk_fp8_f32((a.x - d01[0]) * 16.f, (a.y - d01[1]) * 16.f, 0, false);
    lw = __builtin_amdgcn_cvt_pk_fp8_f32((a.z - d23[0]) * 16.f, (a.w - d23[1]) * 16.f, lw, true);
    *(int*)(p.ACTH + tok * 128 + q4) = hw;
    *(int*)(p.ACTL + tok * 128 + q4) = lw;
  }
}
typedef int i32x8 __attribute__((ext_vector_type(8)));
struct V6Ctx {
  int lane, g, i, n, kq, bq, sc, tc, rg; bool valid; unsigned loff; unsigned sel[4]; int aoff;
};
DI void v6_load(const V6Ctx& c, u32x4 (&va)[16], u32x4& aw, unsigned*& xrow, const MP& p, const char* stg, const unsigned char* tbs, size_t tok, int tt, int slice) {
  aw = *(const u32x4*)(stg + c.aoff + 128 * tt);
  const u32x4 pw0 = *(const u32x4*)(stg + 256 * tt + 32 * c.g), pw1 = *(const u32x4*)(stg + 256 * tt + 32 * c.g + 16);
#pragma unroll
  for (int k = 0; k < 16; ++k) { const unsigned e = __builtin_amdgcn_ubfe(k < 8 ? pw0[(k >> 1) & 3] : pw1[(k >> 1) & 3], 16 * (k & 1), 16); va[k] = *(const u32x4*)(tbs + ((e << 7) | c.loff)); }
  xrow = (unsigned*)(p.OUTB + tok * 1024 + 128 * slice) + c.lane;
}
DI void v6_mma(const V6Ctx& c, const u32x4 (&va)[16], const u32x4 aw, float* red) {
  i32x8 B0, B1;
#pragma unroll
  for (int r = 0; r < 8; ++r) {
    B0[r] = (int)__builtin_amdgcn_perm(0u, aw[r >> 2], c.sel[r & 3]);
    B1[r] = (int)__builtin_amdgcn_perm(0u, aw[2 + (r >> 2)], c.sel[r & 3]);
  }
  float* dst = c.valid ? (red + (c.tc * 2 + c.sc) * 128 + 64 * (c.rg & 1) + c.bq) : (red + 512 + c.lane);
  const int st = c.valid ? 1 : 0;
#pragma unroll
  for (int q = 0; q < 4; ++q) {
    i32x8 A0, A1;
#pragma unroll
    for (int r = 0; r < 8; ++r) { A0[r] = (int)va[r][q]; A1[r] = (int)va[8 + r][q]; }
    f32x4 z = {0.f, 0.f, 0.f, 0.f};
    z = __builtin_amdgcn_mfma_scale_f32_16x16x128_f8f6f4(A0, B0, z, 0, 0, 0, 0x7f7f7f7f, 0, 0x7f7f7f7f);
    z = __builtin_amdgcn_mfma_scale_f32_16x16x128_f8f6f4(A1, B1, z, 0, 0, 0, 0x7f7f7f7f, 0, 0x7f7f7f7f);
#pragma unroll
    for (int r = 0; r < 4; ++r) {
      float v = z[r];
      asm volatile("" : "+v"(v));
      dst[st * (16 * r + 4 * q)] = v;
    }
  }
}
DI void v6_fin(const V6Ctx& c, const float* red, unsigned* xrow) {
  const f32x2_t h0 = *(const f32x2_t*)(red + 0 * 128 + 2 * c.lane), h1 = *(const f32x2_t*)(red + 1 * 128 + 2 * c.lane);
  const f32x2_t l0 = *(const f32x2_t*)(red + 2 * 128 + 2 * c.lane), l1 = *(const f32x2_t*)(red + 3 * 128 + 2 * c.lane);
  const float o0 = ((h0[0] + h1[0]) + (l0[0] + l1[0]) * (1.0f / 16.f)) * (1.0f / 64.f);
  const float o1 = ((h0[1] + h1[1]) + (l0[1] + l1[1]) * (1.0f / 16.f)) * (1.0f / 64.f);
  *xrow = cvtpk(o0, o1);
}
DI void phase6(const MP& p, char* smem) {
  V6Ctx c;
  c.lane = threadIdx.x & 63;
  const int w = __builtin_amdgcn_readfirstlane(threadIdx.x >> 6);
  c.g = c.lane >> 3; c.i = c.lane & 7; c.n = c.lane & 15; c.kq = c.lane >> 4; c.bq = c.n & 3; c.sc = (c.n >> 2) & 1; c.tc = c.n >> 3; c.rg = c.kq;
  c.loff = 16u * (unsigned)c.i;
  c.valid = ((c.rg >> 1) == c.sc);
#pragma unroll
  for (int j = 0; j < 4; ++j) c.sel[j] = (0x0c0c0c0cu & ~(0xffu << (8 * c.bq))) | ((unsigned)j << (8 * c.bq));
  c.aoff = 4096 + 2048 * c.tc + 16 * (2 * c.kq + c.sc);
  const unsigned xcc = xb_xcc_id() & 7u;
  float* redA = (float*)(smem + w * 4608);
  float* redB = redA + 576;
  char* stg = smem + 8 * 4608 + w * 8192;
#pragma unroll 1
  for (int s = 0; s < 8; ++s) {
    const int slice = (int)((xcc + s) & 7u);
    unsigned* ctr = p.CTR + (size_t)(8 + slice) * 64;
    const unsigned char* tbs = p.EV + (size_t)slice * 16384 * 128;
#pragma unroll 1
    for (;;) {
      unsigned cc = 0;
      if (c.lane == 0) cc = atomicAdd(ctr, 1u);
      cc = (unsigned)__builtin_amdgcn_readfirstlane((int)cc);
      if (cc >= NPCHUNK) break;
      const size_t tokb = (size_t)cc * PCHUNK;
      {
        const u32x4* ep = (const u32x4*)(p.E16 + tokb * 128) + c.lane;
        u32x4 ev[4], ah[2], al[2];
#pragma unroll
        for (int j = 0; j < 4; ++j) ev[j] = ep[64 * j];
#pragma unroll
        for (int j = 0; j < 2; ++j) { ah[j] = ((const u32x4*)(p.ACTH + tokb * 128))[64 * j + c.lane]; al[j] = ((const u32x4*)(p.ACTL + tokb * 128))[64 * j + c.lane]; }
        __builtin_amdgcn_wave_barrier();
#pragma unroll
        for (int j = 0; j < 4; ++j) *(u32x4*)(stg + 1024 * j + 16 * c.lane) = ev[j];
#pragma unroll
        for (int j = 0; j < 2; ++j) { *(u32x4*)(stg + 4096 + 1024 * j + 16 * c.lane) = ah[j]; *(u32x4*)(stg + 6144 + 1024 * j + 16 * c.lane) = al[j]; }
        __builtin_amdgcn_wave_barrier();
      }
#pragma unroll 1
      for (int tt = 0; tt < PCHUNK; tt += 2) {
        u32x4 vaA[16], vaB[16], awA, awB; unsigned *rowA, *rowB;
        v6_load(c, vaA, awA, rowA, p, stg, tbs, tokb + tt, tt, slice);
        v6_load(c, vaB, awB, rowB, p, stg, tbs, tokb + tt + 1, tt + 1, slice);
        v6_mma(c, vaA, awA, redA);
        v6_mma(c, vaB, awB, redB);
        __builtin_amdgcn_wave_barrier();
        v6_fin(c, redA, rowA);
        v6_fin(c, redB, rowB);
        __builtin_amdgcn_wave_barrier();
      }
    }
  }
}
DI void phase7(const MP& p) {
  const int lane = threadIdx.x & 63;
  const int gw = blockIdx.x * (NTHR / 64) + (threadIdx.x >> 6), nw = gridDim.x * (NTHR / 64);
  const float4* fp = (const float4*)p.fg + 4 * lane;
  float4 f[4];
#pragma unroll
  for (int q = 0; q < 4; ++q) f[q] = fp[q];
#pragma unroll 2
  for (int tok = gw; tok < NTOK; tok += nw) {
    const u32x4* xp = (const u32x4*)(p.X2B + (size_t)tok * 1024) + 2 * lane;
    const u32x4* op_ = (const u32x4*)(p.OUTB + (size_t)tok * 1024) + 2 * lane;
    const u32x4 a = xp[0], b = xp[1], oa = op_[0], ob = op_[1];
    float v[16];
#pragma unroll
    for (int q = 0; q < 4; ++q) {
      v[2 * q] = bflo(a[q]) + bflo(oa[q]); v[2 * q + 1] = bfhi(a[q]) + bfhi(oa[q]);
      v[8 + 2 * q] = bflo(b[q]) + bflo(ob[q]); v[8 + 2 * q + 1] = bfhi(b[q]) + bfhi(ob[q]);
    }
    float s = 0.f;
#pragma unroll
    for (int q = 0; q < 16; ++q) s = fmaf(v[q], v[q], s);
    for (int m = 32; m >= 1; m >>= 1) s += __shfl_xor(s, m, 64);
    const float r3 = rsqrtf(s * (1.0f / 1024.f) + 1e-6f);
    float4* op = (float4*)(p.out + (size_t)tok * 1024) + 4 * lane;
#pragma unroll
    for (int q = 0; q < 4; ++q)
      op[q] = make_float4(v[4 * q] * r3 * f[q].x, v[4 * q + 1] * r3 * f[q].y, v[4 * q + 2] * r3 * f[q].z, v[4 * q + 3] * r3 * f[q].w);
  }
}

#define SMEM_BYTES (ATILE_BYTES + 64 * 4 + 8 * 64 * 4)
__global__ void __launch_bounds__(NTHR) k_mega(MP p) {
  __shared__ __attribute__((aligned(16))) char smem[SMEM_BYTES];
  __shared__ uint4 xb_words;
  if (threadIdx.x == 0) xb_words = make_uint4(0u, 0u, 0u, 0u);
  __syncthreads();
  XcdBarrier gb = xcd_barrier_post(p.bar, (volatile LAS unsigned*)&xb_words);
  phase0(p, smem);
  xcd_barrier(gb);
  phase1(p, smem);
  xcd_barrier(gb);
  phase2(p, smem);
  xcd_barrier(gb);
  phase3(p, smem);
  xcd_barrier(gb);
  phase4(p, smem);
  xcd_barrier(gb);
  phase5(p);
  xcd_barrier(gb);
  phase6(p, smem);
  xcd_barrier(gb);
  phase7(p);
}

extern "C" void kernel_launch(void* const* d_in, const int* in_sizes, int n_in, void* d_out, int out_size, void* d_ws, size_t ws_size,
                              hipStream_t stream) {
  float* out = (float*)d_out;
  char* arena1 = (char*)d_ws;
  size_t o1 = 0;
  auto A1 = [&](size_t bytes) { void* r = arena1 + o1; o1 += (bytes + 255) & ~(size_t)255; return r; };
  MP p;
  memset(&p, 0, sizeof(p));
  p.x = (const float*)d_in[0]; p.g1 = (const float*)d_in[1]; p.w_in = (const float*)d_in[2]; p.a_re = (const float*)d_in[3];
  p.a_im = (const float*)d_in[4]; p.log_step = (const float*)d_in[5]; p.b_re = (const float*)d_in[6]; p.b_im = (const float*)d_in[7];
  p.c_re = (const float*)d_in[8]; p.c_im = (const float*)d_in[9]; p.ssm_d = (const float*)d_in[10]; p.w_glu = (const float*)d_in[11];
  p.w_f = (const float*)d_in[12]; p.w_out = (const float*)d_in[13]; p.g2 = (const float*)d_in[14]; p.w_q = (const float*)d_in[15];
  p.keys = (const float*)d_in[16]; p.eu = (const float*)d_in[17]; p.ev = (const float*)d_in[18]; p.fg = (const float*)d_in[19];
  p.out = out;
  p.U = (unsigned short*)A1((size_t)NTOK * 512 * 2);
  p.T = (unsigned short*)A1((size_t)NTOK * 1024 * 2);
  p.YF = (unsigned short*)A1((size_t)NTOK * 512 * 2);
  p.YB = (unsigned short*)A1((size_t)NTOK * 512 * 2);
  p.PAIRS = (unsigned*)A1((size_t)NTOK * 128 * 4);
  p.E16 = (unsigned short*)A1((size_t)NTOK * 128 * 2);
  p.EU = (unsigned char*)A1((size_t)16384 * 1024);
  p.EV = (unsigned char*)A1((size_t)16384 * 1024);
  p.WinF = (bf16x8*)A1((size_t)1024 * 1536 * 2);
  p.WgluF = (bf16x8*)A1((size_t)512 * 512 * 2);
  p.WoutF = (bf16x8*)A1((size_t)1024 * 1024 * 2);
  p.WqkF = (bf16x8*)A1((size_t)1024 * 2048 * 2);
  p.M1F = (bf16x8*)A1((size_t)128 * 128 * 2);
  p.M3T = (unsigned short*)A1((size_t)4096 * 128 * 2);
  p.s5lam = (float*)A1((size_t)64 * 64 * 2 * 4);
  p.s5B = (bf16x8*)A1((size_t)64 * 4 * 64 * 16);
  p.s5C = (bf16x8*)A1((size_t)64 * 4 * 64 * 16);
  p.bar = (unsigned*)A1((size_t)XCD_BAR_WORDS * 4);
  p.CTR = (unsigned*)A1((size_t)16 * 64 * 4);
  (void)hipMemsetAsync(p.bar, 0, (size_t)((char*)(p.CTR + 16 * 64) - (char*)p.bar), stream);
  p.RINV2 = (float*)A1((size_t)NTOK * 4);
  p.OUTB = (unsigned short*)A1((size_t)NTOK * 1024 * 2);
  p.X2B = (unsigned short*)A1((size_t)NTOK * 1024 * 2);
  p.ACTH = (unsigned char*)A1((size_t)NTOK * 128);
  p.ACTL = (unsigned char*)A1((size_t)NTOK * 128);
  p.X8H = (unsigned char*)A1((size_t)NTOK * 1024);
  p.X8L = (unsigned char*)A1((size_t)NTOK * 1024);
  p.PRE = (float*)A1((size_t)8 * NTOK * 128 * 2);
  static int grid_blocks = 0;
  if (!grid_blocks) {
    int dev = 0, cus = 0, per_cu = 0;
    (void)hipGetDevice(&dev);
    (void)hipDeviceGetAttribute(&cus, hipDeviceAttributeMultiprocessorCount, dev);
    (void)hipOccupancyMaxActiveBlocksPerMultiprocessor(&per_cu, k_mega, NTHR, 0);
    if (per_cu < 1) per_cu = 1;
    if (per_cu > 1) per_cu = 1;
    grid_blocks = cus * per_cu;
  }
  void* args[] = {&p};
  hipError_t e = hipLaunchCooperativeKernel((void*)k_mega, dim3(grid_blocks), dim3(NTHR), args, 0, stream);
  if (e != hipSuccess) fprintf(stderr, "cooperative launch failed: %s (grid %d)\n", hipGetErrorString(e), grid_blocks);
}
```

```cpp
#include <hip/hip_runtime.h>
#include <stdint.h>
#include <string.h>
#include <stdio.h>

#define NTOK 65536

__device__ __forceinline__ void dsincos(double x, double* s, double* c) {
  double q = rint(x * 0.63661977236758134308);
  double r = fma(-q, 1.57079632679489655800, x);
  r = fma(-q, 6.12323399573676603587e-17, r);
  double r2 = r * r;
  double sp = r * (1.0 + r2 * (-1.0 / 6 + r2 * (1.0 / 120 + r2 * (-1.0 / 5040 + r2 * (1.0 / 362880 + r2 * (-1.0 / 39916800 + r2 * (1.0 / 6227020800.0 + r2 * (-1.0 / 1307674368000.0))))))));
  double cp = 1.0 + r2 * (-0.5 + r2 * (1.0 / 24 + r2 * (-1.0 / 720 + r2 * (1.0 / 40320 + r2 * (-1.0 / 3628800 + r2 * (1.0 / 479001600.0 + r2 * (-1.0 / 87178291200.0)))))));
  long long qi = (long long)q;
  int m = (int)(qi & 3);
  double ss = (m == 0) ? sp : (m == 1) ? cp : (m == 2) ? -sp : -cp;
  double cc = (m == 0) ? cp : (m == 1) ? -sp : (m == 2) ? -cp : sp;
  *s = ss; *c = cc;
}

typedef short bf16x8 __attribute__((ext_vector_type(8)));
typedef float f32x16 __attribute__((ext_vector_type(16)));
typedef float f32x4 __attribute__((ext_vector_type(4)));
typedef unsigned u32x4 __attribute__((ext_vector_type(4)));
typedef unsigned u32x2 __attribute__((ext_vector_type(2)));
typedef float f32x2_t __attribute__((ext_vector_type(2)));
typedef __bf16 bf16x2_t __attribute__((ext_vector_type(2)));
typedef _Float16 f16x2_t __attribute__((ext_vector_type(2)));
typedef _Float16 f16x8_t __attribute__((ext_vector_type(8)));
__device__ __forceinline__ f16x2_t as_h2(unsigned v) { return __builtin_bit_cast(f16x2_t, v); }
#define DI __device__ __forceinline__
#define MFMA32(a, b, c) __builtin_amdgcn_mfma_f32_32x32x16_bf16((a), (b), (c), 0, 0, 0)
#define MFMA16(a, b, c) __builtin_amdgcn_mfma_f32_16x16x32_bf16((a), (b), (c), 0, 0, 0)
#define NTHR 512
#define ASTRIDE 2064
#define ATILE_BYTES (64 * ASTRIDE)

DI unsigned cvtpk(float lo, float hi) { f32x2_t v = {lo, hi}; bf16x2_t b = __builtin_convertvector(v, bf16x2_t); return __builtin_bit_cast(unsigned, b); }
DI unsigned short f2bf(float x) { return (unsigned short)(cvtpk(x, 0.f) & 0xffffu); }
DI float bf2f(unsigned h) { return __uint_as_float(h << 16); }
DI float bflo(unsigned w) { return __uint_as_float(w << 16); }
DI float bfhi(unsigned w) { return __uint_as_float(w & 0xffff0000u); }
DI int crow(int reg, int h) { return (reg & 3) + 8 * (reg >> 2) + 4 * h; }
DI f32x16 zero16() { f32x16 z; for (int i = 0; i < 16; ++i) z[i] = 0.f; return z; }

struct MP {
  const float *x, *g1, *w_in, *a_re, *a_im, *log_step, *b_re, *b_im, *c_re, *c_im, *ssm_d, *w_glu, *w_f, *w_out, *g2, *w_q, *keys, *eu, *ev, *fg;
  float* out;
  bf16x8 *WinF, *WgluF, *WoutF, *WqkF, *M1F, *s5B, *s5C;
  unsigned short *M3T, *U, *T, *YF, *YB;
  unsigned char *EU, *EV;
  float* s5lam;
  unsigned* PAIRS;
  unsigned short* E16;
  unsigned* bar;
  unsigned* CTR;
  float *RINV2, *PRE;
  unsigned short* OUTB;
  unsigned short* X2B;
  unsigned char *ACTH, *ACTL;
  unsigned char *X8H, *X8L;
};

DI void s5_params(const MP& p, int dg, int pp, float& lr, float& li, double& fr, double& fi) {
  double are = p.a_re[dg * 64 + pp], aim = p.a_im[dg * 64 + pp];
  double step = exp((double)p.log_step[dg]);
  double sn_, cs_;
  dsincos(aim * step, &sn_, &cs_);
  double mag = exp(are * step);
  double lrd = mag * cs_, lid = mag * sn_;
  double nr = lrd - 1.0, ni = lid;
  double den = are * are + aim * aim;
  fr = (nr * are + ni * aim) / den; fi = (ni * are - nr * aim) / den;
  lr = (float)lrd; li = (float)lid;
}

DI int opq(int v) { asm volatile("" : "+v"(v)); return v; }
DI unsigned opqu(unsigned v) { asm volatile("" : "+v"(v)); return v; }
DI unsigned opqs(unsigned v) { asm volatile("" : "+s"(v)); return v; }
DI void fold_dot8(float (&out)[8], const float* __restrict__ w0, size_t wstride, const float* lds, int stride, int n4) {
#pragma unroll
  for (int j = 0; j < 8; ++j) out[j] = 0.f;
#pragma unroll 2
  for (int m4 = 0; m4 < n4; ++m4) {
    const float l0 = lds[(4 * m4) * stride], l1 = lds[(4 * m4 + 1) * stride], l2 = lds[(4 * m4 + 2) * stride], l3 = lds[(4 * m4 + 3) * stride];
#pragma unroll
    for (int j = 0; j < 8; ++j) {
      const float4 wv = ((const float4*)(w0 + j * wstride))[m4];
      out[j] = fmaf(wv.x, l0, out[j]); out[j] = fmaf(wv.y, l1, out[j]); out[j] = fmaf(wv.z, l2, out[j]); out[j] = fmaf(wv.w, l3, out[j]);
    }
  }
}
DI void conv_frag(bf16x8* dst, const float* __restrict__ src, int ld, const float* __restrict__ kscale, int ntiles, int KS, long gtid, long gsz) {
  const long total = (long)ntiles * KS * 64;
#pragma unroll 1
  for (long u = gtid; u < total; u += gsz) {
    int lane = (int)(u & 63);
    long q = u >> 6;
    int ks = (int)(q % KS), nt = (int)(q / KS);
    int n = 32 * nt + (lane & 31), k0 = 16 * ks + 8 * (lane >> 5);
    u32x4 w;
#pragma unroll
    for (int jj = 0; jj < 4; ++jj) {
      int k = k0 + 2 * jj;
      float a = src[(size_t)k * ld + n], b = src[(size_t)(k + 1) * ld + n];
      if (kscale) { a *= kscale[k]; b *= kscale[k + 1]; }
      w[jj] = cvtpk(a, b);
    }
    dst[u] = __builtin_bit_cast(bf16x8, w);
  }
}

DI void late_prep(const MP& p, long gtid, long gsz) {
#pragma unroll 1
  for (long u = gtid; u < 4096 * 128; u += gsz) {
    int s2ri = (int)(u & 127), k = (int)(u >> 7);
    int ri = s2ri >> 6, s2 = s2ri & 63;
    double sv, cv;
    dsincos(6.283185307179586476925 * (double)((k * s2) & 4095) / 4096.0, &sv, &cv);
    p.M3T[u] = f2bf((float)(ri ? sv : cv));
  }
#pragma unroll 1
  for (long u = gtid; u < (long)16384 * 1024 / 16; u += gsz) {
    int d0 = (int)((u * 16) & 1023);
    const float4* s = (const float4*)(p.eu + u * 16);
    const float4* gq = (const float4*)(p.g2 + d0);
    const float4* s2 = (const float4*)(p.ev + u * 16);
    u32x4 ou, ov;
#pragma unroll
    for (int q = 0; q < 4; ++q) {
      float4 a = s[q], g = gq[q], b = s2[q];
      {
        const int q0 = (int)rintf(__builtin_amdgcn_fmed3f(a.x * g.x * 1024.f, -127.f, 127.f)), q1 = (int)rintf(__builtin_amdgcn_fmed3f(a.y * g.y * 1024.f, -127.f, 127.f));
        const int q2 = (int)rintf(__builtin_amdgcn_fmed3f(a.z * g.z * 1024.f, -127.f, 127.f)), q3 = (int)rintf(__builtin_amdgcn_fmed3f(a.w * g.w * 1024.f, -127.f, 127.f));
        ou[q] = (unsigned)(q0 & 0xff) | ((unsigned)(q1 & 0xff) << 8) | ((unsigned)(q2 & 0xff) << 16) | ((unsigned)(q3 & 0xff) << 24);
      }
      int w2 = __builtin_amdgcn_cvt_pk_fp8_f32(b.x * 4.f, b.y * 4.f, 0, false);
      w2 = __builtin_amdgcn_cvt_pk_fp8_f32(b.z * 4.f, b.w * 4.f, w2, true);
      ov[q] = (unsigned)w2;
    }
    {
      const long e = u >> 6; const int c16 = (int)(u & 63);
      const size_t dst = (((size_t)(c16 >> 3) * 16384 + (size_t)e) * 128) + (size_t)(c16 & 7) * 16;
      *(u32x4*)(p.EU + dst) = ou;
      *(u32x4*)(p.EV + dst) = ov;
    }
  }
}

DI void phase0(const MP& p, char* smem) {
  const int tid = threadIdx.x;
  const long gtid = (long)blockIdx.x * NTHR + tid;
  const long gsz = (long)gridDim.x * NTHR;
  conv_frag(p.WinF, p.w_in, 1024, p.g1, 16, 64, gtid, gsz);
  conv_frag(p.WgluF, p.w_glu, 512, nullptr, 16, 32, gtid, gsz);
  conv_frag(p.WoutF, p.w_out, 1024, nullptr, 32, 64, gtid, gsz);
#pragma unroll 1
  for (long u = gtid; u < 4 * 8 * 64; u += gsz) {
    int lane = (int)(u & 63), ks = (int)((u >> 6) & 7), mt = (int)(u >> 9);
    int row = 32 * mt + (lane & 31), h = lane >> 5;
    int ri = row >> 6, k1 = row & 63;
    u32x4 w;
#pragma unroll
    for (int jj = 0; jj < 4; ++jj) {
      float v2[2];
#pragma unroll
      for (int e = 0; e < 2; ++e) {
        int j = 2 * jj + e;
        int col = 16 * ks + 8 * (j >> 2) + 4 * h + (j & 3);
        int ab = col >> 6, s1 = col & 63;
        double sv, cv;
        dsincos(6.283185307179586476925 * (double)((k1 * s1) & 63) / 64.0, &sv, &cv);
        double val = (ri == 0) ? (ab == 0 ? cv : -sv) : (ab == 0 ? -sv : -cv);
        v2[e] = (float)val;
      }
      w[jj] = cvtpk(v2[0], v2[1]);
    }
    p.M1F[u] = __builtin_bit_cast(bf16x8, w);
  }
#pragma unroll 1
  for (long u = gtid; u < 64 * 64; u += gsz) {
    int pp = (int)(u & 63), dg = (int)(u >> 6);
    float lr, li; double fr, fi;
    s5_params(p, dg, pp, lr, li, fr, fi);
    p.s5lam[u * 2] = lr; p.s5lam[u * 2 + 1] = li;
  }
#pragma unroll 1
  for (long u = gtid; u < 64 * 4 * 64; u += gsz) {
    int lane = (int)(u & 63), nt = (int)((u >> 6) & 3), dg = (int)(u >> 8);
    int col = 32 * nt + (lane & 31), ri = col >> 6, pp = col & 63, h = lane >> 5;
    float lr, li; double fr, fi;
    s5_params(p, dg, pp, lr, li, fr, fi);
    const float* brp = p.b_re + ((size_t)dg * 64 + pp) * 16 + 8 * h;
    const float* bip = p.b_im + ((size_t)dg * 64 + pp) * 16 + 8 * h;
    u32x4 w;
#pragma unroll
    for (int jj = 0; jj < 4; ++jj) {
      double br0 = brp[2 * jj], bi0 = bip[2 * jj], br1 = brp[2 * jj + 1], bi1 = bip[2 * jj + 1];
      float v0 = (float)(ri ? (fr * bi0 + fi * br0) : (fr * br0 - fi * bi0));
      float v1 = (float)(ri ? (fr * bi1 + fi * br1) : (fr * br1 - fi * bi1));
      w[jj] = cvtpk(v0, v1);
    }
    p.s5B[u] = __builtin_bit_cast(bf16x8, w);
  }
#pragma unroll 1
  for (long u = gtid; u < 64 * 4 * 64; u += gsz) {
    int lane = (int)(u & 63), ks = (int)((u >> 6) & 3), dg = (int)(u >> 8);
    int c = lane & 15;
    u32x4 w;
#pragma unroll
    for (int jj = 0; jj < 4; ++jj) {
      int kk = 32 * ks + 8 * (lane >> 4) + 2 * jj;
      int pt = kk >> 6, pq = (kk & 63) >> 1;
      int pp = 32 * pt + pq;
      float vre = p.c_re[((size_t)dg * 16 + c) * 64 + pp];
      float vim = -p.c_im[((size_t)dg * 16 + c) * 64 + pp];
      w[jj] = cvtpk(vre, vim);
    }
    p.s5C[u] = __builtin_bit_cast(bf16x8, w);
  }
  {
    float* AB = (float*)smem;
    float* tab = AB + 128 * 32;
    const float nrm = 1.0f / sqrtf(4096.f * 128.f);
#pragma unroll 1
    for (int task = blockIdx.x; task < 128; task += gridDim.x) {
      int ntp = task >> 2, kq = task & 3;
      int ab = ntp >> 4, chbase = (ntp & 15) * 32, g = chbase >> 7, d0 = chbase & 127;
      __syncthreads();
      if (tid < 128) {
        double sv, cv;
        dsincos(6.283185307179586476925 * (double)tid / 128.0, &sv, &cv);
        tab[tid] = (float)(ab ? sv : cv);
      }
      __syncthreads();
#pragma unroll 1
      for (int o = tid; o < 128 * 32; o += NTHR) {
        int m = o >> 5, dd = o & 31;
        float s = 0.f;
#pragma unroll 4
        for (int c = 0; c < 128; ++c) s = fmaf(tab[(m * c) & 127], p.w_f[((size_t)g * 128 + c) * 128 + d0 + dd], s);
        AB[o] = s * nrm;
      }
      __syncthreads();
#pragma unroll 1
      for (int uu = tid; uu < 16 * 64; uu += NTHR) {
        int lane = uu & 63, ks = kq * 16 + (uu >> 6);
        int dd = lane & 31, h = lane >> 5;
        u32x4 w;
        {
          const int k0 = 16 * ks + 8 * h;
          float sv[8];
          fold_dot8(sv, p.w_in + (size_t)k0 * 1024 + 512 + 128 * g, 1024, AB + dd, 32, 32);
#pragma unroll
          for (int jj = 0; jj < 4; ++jj) w[jj] = cvtpk(sv[2 * jj] * p.g1[k0 + 2 * jj], sv[2 * jj + 1] * p.g1[k0 + 2 * jj + 1]);
        }
        p.WinF[((size_t)(16 + ntp) * 64 + ks) * 64 + lane] = __builtin_bit_cast(bf16x8, w);
      }
    }
  }
  {
    float* Ks = (float*)smem;
#pragma unroll 1
    for (int task = (int)((blockIdx.x + gridDim.x / 2) % gridDim.x); task < 128; task += gridDim.x) {
      int hp = task >> 3, kt = (task >> 1) & 3, chalf = task & 1;
      __syncthreads();
#pragma unroll 1
      for (int o = tid; o < 32 * 128; o += NTHR) {
        int kk = o >> 7, d = o & 127;
        Ks[kk * 129 + d] = p.keys[((size_t)hp * 128 + kt * 32 + kk) * 128 + d];
      }
      __syncthreads();
#pragma unroll 1
      for (int uu = tid; uu < 32 * 64; uu += NTHR) {
        int lane = uu & 63, ks = chalf * 32 + (uu >> 6);
        int kk = lane & 31, h = lane >> 5;
        u32x4 w;
        {
          const int c0 = 16 * ks + 8 * h;
          float sv[8];
          fold_dot8(sv, p.w_q + (size_t)c0 * 2048 + hp * 128, 2048, Ks + kk * 129, 1, 32);
#pragma unroll
          for (int jj = 0; jj < 4; ++jj) w[jj] = cvtpk(sv[2 * jj] * p.g2[c0 + 2 * jj], sv[2 * jj + 1] * p.g2[c0 + 2 * jj + 1]);
        }
        p.WqkF[((size_t)(hp * 4 + kt) * 64 + ks) * 64 + lane] = __builtin_bit_cast(bf16x8, w);
      }
    }
  }
}

#define PD 4
template <int NT, int PDT>
DI void gemm_tile(f32x16 (&acc)[2][NT], const char* atile, int acol0, const bf16x8* __restrict__ wf, int KS, int nks, int lane, int stride2 = 2) {
  const char* abase = atile + (lane & 31) * ASTRIDE + (acol0 + 8 * (lane >> 5)) * 2;
  const char* wbase = (const char*)wf;
  const unsigned loff = (unsigned)lane * 16u;
  unsigned noff[NT];
#pragma unroll
  for (int nt = 0; nt < NT; ++nt) noff[nt] = (unsigned)(((nt & 1) + (nt >> 1) * stride2) * KS) * 1024u;
  bf16x8 bq[PDT][NT];
#pragma unroll
  for (int d = 0; d < PDT; ++d)
#pragma unroll
    for (int nt = 0; nt < NT; ++nt) bq[d][nt] = *(const bf16x8*)(wbase + (noff[nt] + (unsigned)d * 1024u) + loff);
#pragma unroll 1
  for (int ks0 = 0; ks0 < nks; ks0 += PDT) {
#pragma unroll
    for (int d = 0; d < PDT; ++d) {
      const int ks = ks0 + d;
      bf16x8 a0 = *(const bf16x8*)(abase + ks * 32);
      bf16x8 a1 = *(const bf16x8*)(abase + 32 * ASTRIDE + ks * 32);
      bf16x8 b[NT];
#pragma unroll
      for (int nt = 0; nt < NT; ++nt) b[nt] = bq[d][nt];
      const unsigned ksn = (unsigned)min(ks + PDT, nks - 1) * 1024u;
#pragma unroll
      for (int nt = 0; nt < NT; ++nt) bq[d][nt] = *(const bf16x8*)(wbase + (noff[nt] + ksn) + loff);
#pragma unroll
      for (int nt = 0; nt < NT; ++nt) {
        acc[0][nt] = MFMA32(a0, b[nt], acc[0][nt]);
        acc[1][nt] = MFMA32(a1, b[nt], acc[1][nt]);
      }
    }
  }
}

DI bf16x8 pack_step(const f32x16& x, int s) {
  u32x4 w;
  w[0] = cvtpk(x[8 * s + 0], x[8 * s + 1]); w[1] = cvtpk(x[8 * s + 2], x[8 * s + 3]);
  w[2] = cvtpk(x[8 * s + 4], x[8 * s + 5]); w[3] = cvtpk(x[8 * s + 6], x[8 * s + 7]);
  return __builtin_bit_cast(bf16x8, w);
}


template <typename PT>
DI void store_tile_pairs(const float (&vals)[16], PT base, unsigned rs, bool odd) {
#pragma unroll
  for (int r = 0; r < 16; r += 2) {
    const float send = odd ? vals[r] : vals[r + 1];
    const float recv = __builtin_bit_cast(float, __builtin_amdgcn_mov_dpp(__builtin_bit_cast(int, send), 0xB1, 0xF, 0xF, true));
    const float lo = odd ? recv : vals[r];
    const float hi = odd ? vals[r + 1] : recv;
    const int rc = (r & 3) + 8 * (r >> 2);
    *(unsigned*)(base + (size_t)rc * rs) = cvtpk(lo, hi);
  }
}
DI void phase1(const MP& p, char* smem) {
  const int tid = threadIdx.x, w = __builtin_amdgcn_readfirstlane(tid >> 6);
  char* atile = smem;
  float* rinv = (float*)(smem + ATILE_BYTES);
  for (int tt = blockIdx.x; tt < 1024; tt += gridDim.x) {
    const int b = tt >> 6, s2 = tt & 63;
    const int lane = opq((int)threadIdx.x & 63), h = lane >> 5;
    __syncthreads();
    {
      float4 v[8][4];
#pragma unroll
      for (int rr = 0; rr < 8; ++rr) {
        const float4* xp = (const float4*)(p.x + ((size_t)b * 4096 + 64 * (w * 8 + rr) + s2) * 1024);
#pragma unroll
        for (int i = 0; i < 4; ++i) v[rr][i] = xp[lane + 64 * i];
      }
#pragma unroll
      for (int rr = 0; rr < 8; ++rr) {
        const int r = w * 8 + rr;
        float s = 0.f;
#pragma unroll
        for (int i = 0; i < 4; ++i) s += v[rr][i].x * v[rr][i].x + v[rr][i].y * v[rr][i].y + v[rr][i].z * v[rr][i].z + v[rr][i].w * v[rr][i].w;
        for (int m = 32; m >= 1; m >>= 1) s += __shfl_xor(s, m, 64);
        if (lane == 0) rinv[r] = rsqrtf(s * (1.0f / 1024.f) + 1e-6f);
#pragma unroll
        for (int i = 0; i < 4; ++i) {
          u32x2 pk; pk[0] = cvtpk(v[rr][i].x, v[rr][i].y); pk[1] = cvtpk(v[rr][i].z, v[rr][i].w);
          *(u32x2*)(atile + r * ASTRIDE + (lane + 64 * i) * 8) = pk;
        }
      }
    }
    __syncthreads();
    {
      f32x16 acc[2][2];
#pragma unroll
      for (int i = 0; i < 2; ++i)
#pragma unroll
        for (int j = 0; j < 2; ++j) acc[i][j] = zero16();
      gemm_tile<2, 4>(acc, atile, 0, p.WinF + (size_t)(2 * w) * 64 * 64, 64, 64, lane);
      {
        const bool odd = (lane & 1) != 0;
        const unsigned ubase = (unsigned)((((size_t)b * 4096 + s2 + 64 * (4 * h + (odd ? 1 : 0))) * 512 + 64 * w + ((lane & 31) & ~1)) * 2);
#pragma unroll
        for (int mt = 0; mt < 2; ++mt)
#pragma unroll
          for (int nt = 0; nt < 2; ++nt) {
            const unsigned tb = opqu(ubase + (unsigned)((32 * mt * 64 * 512 + 32 * nt) * 2));
            const float* rvp = rinv + opq(32 * mt + 4 * h);
            float vals[16];
#pragma unroll
            for (int r = 0; r < 16; ++r) vals[r] = acc[mt][nt][r] * rvp[(r & 3) + 8 * (r >> 2)];
            store_tile_pairs(vals, (char*)p.U + tb, 64u * 512u * 2u, odd);
          }
      }
    }
    {
      bf16x8 xs[8][2];
      {
        f32x16 acc[2][4];
#pragma unroll
        for (int i = 0; i < 2; ++i)
#pragma unroll
          for (int j = 0; j < 4; ++j) acc[i][j] = zero16();
        gemm_tile<4, 2>(acc, atile, 0, p.WinF + (size_t)(16 + 2 * w) * 64 * 64, 64, 64, opq(lane), 16);
#pragma unroll
        for (int mt = 0; mt < 2; ++mt) {
#pragma unroll
          for (int c = 0; c < 4; ++c) {
            const float* rvp = rinv + opq(32 * mt + 4 * h);
#pragma unroll
            for (int r = 0; r < 16; ++r) acc[mt][c][r] *= rvp[(r & 3) + 8 * (r >> 2)];
            const int ab = c >> 1, nt = c & 1;
            xs[ab * 4 + mt * 2 + 0][nt] = pack_step(acc[mt][c], 0);
            xs[ab * 4 + mt * 2 + 1][nt] = pack_step(acc[mt][c], 1);
          }
        }
      }
#pragma unroll
      for (int mt = 0; mt < 4; ++mt) {
        f32x16 t0 = zero16(), t1 = zero16();
        const bf16x8* mf = p.M1F + (size_t)(opq(mt * 8)) * 64 + lane;
#pragma unroll
        for (int ks = 0; ks < 8; ++ks) {
          bf16x8 a = mf[ks * 64];
          t0 = MFMA32(a, xs[ks][0], t0);
          t1 = MFMA32(a, xs[ks][1], t1);
        }
        const int ri = mt >> 1;
        const bool odd = (lane & 1) != 0;
        const unsigned tbase = opqu((unsigned)(((((size_t)b * 64 + 32 * (mt & 1) + 4 * h + (odd ? 1 : 0)) * 128 + ri * 64 + s2) * 512 + 64 * w + ((lane & 31) & ~1)) * 2));
        float v0[16], v1[16];
#pragma unroll
        for (int r = 0; r < 16; ++r) { v0[r] = t0[r]; v1[r] = t1[r]; }
        store_tile_pairs(v0, (char*)p.T + tbase, 128u * 512u * 2u, odd);
        store_tile_pairs(v1, (char*)p.T + tbase + 64, 128u * 512u * 2u, odd);
      }
    }
  }
}

#define XS_STRIDE 272
#define XS_BYTES (32 * XS_STRIDE)
DI void phase2(const MP& p, char* smem) {
  const int tid = threadIdx.x, lane = tid & 63, w = __builtin_amdgcn_readfirstlane(tid >> 6), h = lane >> 5;
  {
    const int nactive = min(8, (512 + (int)gridDim.x - 1) / (int)gridDim.x);
    if (nactive >= 8) {
      late_prep(p, (long)blockIdx.x * NTHR + tid, (long)gridDim.x * NTHR);
    } else if (w >= nactive) {
      const long nidle = 8 - nactive;
      late_prep(p, ((long)blockIdx.x * nidle + (w - nactive)) * 64 + lane, (long)gridDim.x * nidle * 64);
    }
  }
#pragma unroll 1
  for (int task = w * gridDim.x + blockIdx.x; task < 512; task += 8 * gridDim.x) {
    const int dir = task & 1, g = (task >> 1) & 31, bp = task >> 6;
    const int dg = dir * 32 + g;
    char* xt = smem + w * XS_BYTES;
    bf16x8 bfr[4], cf[4];
#pragma unroll
    for (int nt = 0; nt < 4; ++nt) bfr[nt] = p.s5B[(size_t)(dg * 4 + nt) * 64 + lane];
#pragma unroll
    for (int ks = 0; ks < 4; ++ks) cf[ks] = p.s5C[(size_t)(dg * 4 + ks) * 64 + lane];
    const int pp = lane & 31;
    const float lr0 = p.s5lam[((size_t)dg * 64 + pp) * 2], li0 = p.s5lam[((size_t)dg * 64 + pp) * 2 + 1];
    const float lr1 = p.s5lam[((size_t)dg * 64 + 32 + pp) * 2], li1 = p.s5lam[((size_t)dg * 64 + 32 + pp) * 2 + 1];
    const int rho = lane & 31;
    const int hr = (rho >> 2) & 1, rr = (rho & 3) + 4 * (rho >> 3);
    const size_t ubase = ((size_t)(2 * bp + hr) * 4096) * 512 + g * 16 + 8 * h;
    float xr0 = 0.f, xi0 = 0.f, xr1 = 0.f, xi1 = 0.f;
    bf16x8 aq[4];
#pragma unroll
    for (int d = 0; d < 4; ++d) { int q = 16 * d + rr; int tpos = dir ? (4095 - q) : q; aq[d] = *(const bf16x8*)(p.U + ubase + (size_t)tpos * 512); }
    unsigned short* yo = dir ? p.YB : p.YF;
#pragma unroll 1
    for (int step0 = 0; step0 < 256; step0 += 4) {
#pragma unroll
      for (int d = 0; d < 4; ++d) {
        const int step = step0 + d;
        bf16x8 a = aq[d];
        { int q = 16 * min(step + 4, 255) + rr; int tpos = dir ? (4095 - q) : q; aq[d] = *(const bf16x8*)(p.U + ubase + (size_t)tpos * 512); }
        f32x16 br0 = MFMA32(a, bfr[0], zero16());
        f32x16 br1 = MFMA32(a, bfr[1], zero16());
        f32x16 bi0 = MFMA32(a, bfr[2], zero16());
        f32x16 bi1 = MFMA32(a, bfr[3], zero16());
        char* xrow = xt + (h * 16) * XS_STRIDE + (2 * (lane & 31)) * 2;
#pragma unroll
        for (int r = 0; r < 16; ++r) {
          float n0r = fmaf(lr0, xr0, fmaf(-li0, xi0, br0[r]));
          float n0i = fmaf(lr0, xi0, fmaf(li0, xr0, bi0[r]));
          float n1r = fmaf(lr1, xr1, fmaf(-li1, xi1, br1[r]));
          float n1i = fmaf(lr1, xi1, fmaf(li1, xr1, bi1[r]));
          xr0 = n0r; xi0 = n0i; xr1 = n1r; xi1 = n1i;
          *(unsigned*)(xrow + r * XS_STRIDE) = cvtpk(xr0, xi0);
          *(unsigned*)(xrow + r * XS_STRIDE + 128) = cvtpk(xr1, xi1);
        }
        __builtin_amdgcn_wave_barrier();
#pragma unroll
        for (int mt = 0; mt < 2; ++mt) {
          f32x4 y = {0.f, 0.f, 0.f, 0.f};
#pragma unroll
          for (int ks = 0; ks < 4; ++ks) {
            bf16x8 xa = *(const bf16x8*)(xt + (mt * 16 + (lane & 15)) * XS_STRIDE + (32 * ks + 8 * (lane >> 4)) * 2);
            y = MFMA16(xa, cf[ks], y);
          }
          {
            const bool odd = (lane & 1) != 0;
#pragma unroll
            for (int r = 0; r < 4; r += 2) {
              const float send = odd ? y[r] : y[r + 1];
              const float recv = __builtin_bit_cast(float, __builtin_amdgcn_mov_dpp(__builtin_bit_cast(int, send), 0xB1, 0xF, 0xF, true));
              const float lo = odd ? recv : y[r], hi = odd ? y[r + 1] : recv;
              const int q = 16 * step + 4 * (lane >> 4) + r + (odd ? 1 : 0);
              const int tpos = dir ? (4095 - q) : q;
              *(unsigned*)(yo + ((size_t)(2 * bp + mt) * 4096 + tpos) * 512 + g * 16 + ((lane & 15) & ~1)) = cvtpk(lo, hi);
            }
          }
        }
        __builtin_amdgcn_wave_barrier();
      }
    }
  }
}
DI int f2key(float f) { return __float_as_int(__builtin_amdgcn_fmed3f(f, -60.f, 60.f) + 64.f); }
DI float key2f(int k) { return __int_as_float(k) - 64.f; }
#define CE_DESC(a, b) { int mx_ = max(a, b), mn_ = min(a, b); a = mx_; b = mn_; }
#define CE_ASC(a, b) { int mx_ = max(a, b), mn_ = min(a, b); a = mn_; b = mx_; }

#define S16(i, j) CE_DESC(v[i], v[j])
DI void sort16_desc(int (&v)[16]) {
  S16(0,13) S16(1,12) S16(2,15) S16(3,14) S16(4,8) S16(5,6) S16(7,11) S16(9,10)
  S16(0,5) S16(1,7) S16(2,9) S16(3,4) S16(6,13) S16(8,14) S16(10,15) S16(11,12)
  S16(0,1) S16(2,3) S16(4,5) S16(6,8) S16(7,9) S16(10,11) S16(12,13) S16(14,15)
  S16(0,2) S16(1,3) S16(4,10) S16(5,11) S16(6,7) S16(8,9) S16(12,14) S16(13,15)
  S16(1,2) S16(3,12) S16(4,6) S16(5,7) S16(8,10) S16(9,11) S16(13,14)
  S16(1,4) S16(2,6) S16(5,8) S16(7,10) S16(9,13) S16(11,14)
  S16(2,4) S16(3,6) S16(9,12) S16(11,13)
  S16(3,5) S16(6,8) S16(7,9) S16(10,12)
  S16(3,4) S16(5,6) S16(7,8) S16(9,10) S16(11,12)
  S16(6,7) S16(8,9)
}
DI void merge16_desc(int (&a)[16], const int (&b)[16]) {
#pragma unroll
  for (int i = 0; i < 16; ++i) a[i] = max(a[i], b[15 - i]);
#pragma unroll
  for (int j = 8; j > 0; j >>= 1) {
#pragma unroll
    for (int i = 0; i < 16; ++i) {
      const int l = i ^ j;
      if (l > i) { CE_DESC(a[i], a[l]); }
    }
  }
}
DI void top16_of_64(const int (&k)[64], int (&out)[16]) {
  int g1[16], g2[16], g3[16];
#pragma unroll
  for (int i = 0; i < 16; ++i) { out[i] = k[i]; g1[i] = k[16 + i]; g2[i] = k[32 + i]; g3[i] = k[48 + i]; }
  sort16_desc(out); sort16_desc(g1); sort16_desc(g2); sort16_desc(g3);
  merge16_desc(out, g1); merge16_desc(g2, g3); merge16_desc(out, g2);
}

DI float reduce_scatter32(float (&v)[32], int lane) {
  float a[16];
  {
    const bool up = (lane & 16) != 0;
#pragma unroll
    for (int i = 0; i < 16; ++i) { float keep = up ? v[16 + i] : v[i]; float send = up ? v[i] : v[16 + i]; a[i] = keep + __shfl_xor(send, 16, 64); }
  }
  float b[8];
  {
    const bool up = (lane & 8) != 0;
#pragma unroll
    for (int i = 0; i < 8; ++i) { float keep = up ? a[8 + i] : a[i]; float send = up ? a[i] : a[8 + i]; b[i] = keep + __shfl_xor(send, 8, 64); }
  }
  float c[4];
  {
    const bool up = (lane & 4) != 0;
#pragma unroll
    for (int i = 0; i < 4; ++i) { float keep = up ? b[4 + i] : b[i]; float send = up ? b[i] : b[4 + i]; c[i] = keep + __shfl_xor(send, 4, 64); }
  }
  float d[2];
  {
    const bool up = (lane & 2) != 0;
#pragma unroll
    for (int i = 0; i < 2; ++i) { float keep = up ? c[2 + i] : c[i]; float send = up ? c[i] : c[2 + i]; d[i] = keep + __shfl_xor(send, 2, 64); }
  }
  {
    const bool up = (lane & 1) != 0;
    float keep = up ? d[1] : d[0]; float send = up ? d[0] : d[1];
    return keep + __shfl_xor(send, 1, 64);
  }
}
DI float reduce_scatter64(float (&v)[64], int lane) {
  float a[32];
  const bool up = (lane & 32) != 0;
#pragma unroll
  for (int i = 0; i < 32; ++i) { float keep = up ? v[32 + i] : v[i]; float send = up ? v[i] : v[32 + i]; a[i] = keep + __shfl_xor(send, 32, 64); }
  return reduce_scatter32(a, lane);
}

__host__ __device__ constexpr int cand_ij(int c) {
  int n = 0;
  for (int a = 0; a < 16; ++a)
    for (int b = 0; b < 16; ++b)
      if ((a + 1) * (b + 1) <= 16) { if (n == c) return a * 16 + b; ++n; }
  return 0;
}
__host__ __device__ constexpr int cand_index(int i, int j) {
  int n = 0;
  for (int a = 0; a < 16; ++a)
    for (int b = 0; b < 16; ++b)
      if ((a + 1) * (b + 1) <= 16) { if (a == i && b == j) return n; ++n; }
  return n;
}
static_assert(cand_index(15, 0) == 49, "50 candidates");
DI float erf_as(float z) {
  const float az = fabsf(z);
  const float t = __builtin_amdgcn_rcpf(fmaf(0.3275911f, az, 1.0f));
  float pl = fmaf(1.061405429f, t, -1.453152027f);
  pl = fmaf(pl, t, 1.421413741f);
  pl = fmaf(pl, t, -0.284496736f);
  pl = fmaf(pl, t, 0.254829592f);
  pl *= t;
  const float ex = __expf(-az * az);
  const float r = fmaf(-pl, ex, 1.0f);
  return copysignf(r, z);
}
DI float gelu_f(float x) { return 0.5f * x * (1.0f + erf_as(x * 0.70710678118654752440f)); }

DI void phase3(const MP& p, char* smem) {
  const int tid = threadIdx.x, lane = tid & 63, w = __builtin_amdgcn_readfirstlane(tid >> 6), h = lane >> 5;
  char* atile = smem;
  float* rinv2 = (float*)(smem + ATILE_BYTES);
  float* part = rinv2 + 64;
  for (int tt = blockIdx.x; tt < 1024; tt += gridDim.x) {
    const int b = tt >> 6, k1 = tt & 63;
    const size_t tok0 = (size_t)b * 4096 + k1;
    __syncthreads();
#pragma unroll
    for (int it = 0; it < 8; ++it) {
      int chunk = opq(tid + NTHR * it);
      int r = chunk >> 6, c8 = chunk & 63;
      size_t off = (tok0 + 64 * (size_t)r) * 512 + c8 * 8;
      u32x4 yf = *(const u32x4*)(p.YF + off), yb = *(const u32x4*)(p.YB + off), uu = *(const u32x4*)(p.U + off);
      float4 d0 = *(const float4*)(p.ssm_d + c8 * 8), d1 = *(const float4*)(p.ssm_d + c8 * 8 + 4);
      float dd[8] = {d0.x, d0.y, d0.z, d0.w, d1.x, d1.y, d1.z, d1.w};
      u32x4 o;
#pragma unroll
      for (int q = 0; q < 4; ++q) {
        float lo = bflo(yf[q]) + bflo(yb[q]) + dd[2 * q] * bflo(uu[q]);
        float hi = bfhi(yf[q]) + bfhi(yb[q]) + dd[2 * q + 1] * bfhi(uu[q]);
        o[q] = cvtpk(gelu_f(lo), gelu_f(hi));
      }
      *(u32x4*)(atile + r * ASTRIDE + c8 * 16) = o;
    }
    __syncthreads();
    f32x16 gacc[2][2];
#pragma unroll
    for (int i = 0; i < 2; ++i)
#pragma unroll
      for (int j = 0; j < 2; ++j) gacc[i][j] = zero16();
    gemm_tile<2, 4>(gacc, atile, 0, p.WgluF + (size_t)(2 * w) * 32 * 64, 32, 32, opq(lane));
    {
      f32x16 facc[2][2];
#pragma unroll
      for (int i = 0; i < 2; ++i)
#pragma unroll
        for (int j = 0; j < 2; ++j) facc[i][j] = zero16();
      const int lnf = opq(lane);
      const unsigned short* m3 = p.M3T + ((size_t)k1 + 64 * (size_t)(lnf & 31)) * 128 + 8 * (lnf >> 5);
      const unsigned short* tb = p.T + (((size_t)b * 64 + k1) * 128 + 8 * (lnf >> 5)) * 512 + 64 * w + (lnf & 31);
#pragma unroll 4
      for (int ks = 0; ks < 8; ++ks) {
        bf16x8 a0 = *(const bf16x8*)(m3 + 16 * ks);
        bf16x8 a1 = *(const bf16x8*)(m3 + (size_t)32 * 64 * 128 + 16 * ks);
        bf16x8 b0, b1;
#pragma unroll
        for (int j = 0; j < 8; ++j) {
          b0[j] = (short)tb[((size_t)16 * ks + j) * 512];
          b1[j] = (short)tb[((size_t)16 * ks + j) * 512 + 32];
        }
        facc[0][0] = MFMA32(a0, b0, facc[0][0]); facc[1][0] = MFMA32(a1, b0, facc[1][0]);
        facc[0][1] = MFMA32(a0, b1, facc[0][1]); facc[1][1] = MFMA32(a1, b1, facc[1][1]);
      }
#pragma unroll
      for (int mt = 0; mt < 2; ++mt)
#pragma unroll
        for (int nt = 0; nt < 2; ++nt)
#pragma unroll
          for (int r = 0; r < 16; ++r) {
            int row = 32 * mt + crow(r, lnf >> 5), col = 512 + 64 * w + 32 * nt + (lnf & 31);
            *(unsigned short*)(atile + row * ASTRIDE + col * 2) = f2bf(facc[mt][nt][r]);
          }
    }
    __syncthreads();
    {
    const int lng = opq(lane);
#pragma unroll
    for (int mt = 0; mt < 2; ++mt)
#pragma unroll
      for (int nt = 0; nt < 2; ++nt)
#pragma unroll
        for (int r = 0; r < 16; ++r) {
          int row = 32 * mt + crow(r, lng >> 5), col = 64 * w + 32 * nt + (lng & 31);
          unsigned short* q = (unsigned short*)(atile + row * ASTRIDE + col * 2);
          float yv = bf2f(*q);
          *q = f2bf(yv / (1.0f + __expf(-gacc[mt][nt][r])));
        }
    }
    __syncthreads();
    {
      f32x16 acc[2][4];
#pragma unroll
      for (int i = 0; i < 2; ++i)
#pragma unroll
        for (int j = 0; j < 4; ++j) acc[i][j] = zero16();
      float pfx[4];
      {
        const int t_ = opq(tid);
#pragma unroll
        for (int q = 0; q < 4; ++q) { const int ln = t_ + NTHR * q; pfx[q] = p.x[(tok0 + 64 * (size_t)(ln >> 5)) * 1024 + (ln & 31) * 32]; }
      }
      gemm_tile<4, 2>(acc, atile, 0, p.WoutF + (size_t)(4 * w) * 64 * 64, 64, 64, opq(lane));
      asm volatile("" :: "v"(pfx[0]), "v"(pfx[1]), "v"(pfx[2]), "v"(pfx[3]));
      __syncthreads();
      float ss[32];
#pragma unroll
      for (int i = 0; i < 32; ++i) ss[i] = 0.f;
      {
        const int lnd = opq(lane);
        const unsigned gbase = (unsigned)(((tok0 + 256 * (lnd >> 5)) * 1024 + 128 * w + (lnd & 31)) * 4);
#pragma unroll
        for (int mt = 0; mt < 2; ++mt)
#pragma unroll
          for (int nt = 0; nt < 4; ++nt) {
            const unsigned gb = opqu(gbase + (unsigned)((32 * mt * 64 * 1024 + 32 * nt) * 4));
            const bool odd = (lnd & 1) != 0;
            char* lb = atile + opq((32 * mt + 4 * (lnd >> 5) + (odd ? 1 : 0)) * ASTRIDE + (128 * w + 32 * nt + ((lnd & 31) & ~1)) * 2);
#pragma unroll
            for (int r = 0; r < 16; r += 2) {
              const int rc = (r & 3) + 8 * (r >> 2);
              const unsigned go0 = gb + (unsigned)(rc * 64 * 1024 * 4), go1 = gb + (unsigned)((rc + 1) * 64 * 1024 * 4);
              const float v0 = *(const float*)((const char*)p.x + go0) + acc[mt][nt][r];
              const float v1 = *(const float*)((const char*)p.x + go1) + acc[mt][nt][r + 1];
              ss[mt * 16 + r] = fmaf(v0, v0, ss[mt * 16 + r]);
              ss[mt * 16 + r + 1] = fmaf(v1, v1, ss[mt * 16 + r + 1]);
              const float send = odd ? v0 : v1;
              const float recv = __builtin_bit_cast(float, __builtin_amdgcn_mov_dpp(__builtin_bit_cast(int, send), 0xB1, 0xF, 0xF, true));
              *(unsigned*)(lb + rc * ASTRIDE) = cvtpk(odd ? recv : v0, odd ? v1 : recv);
            }
          }
      }
      float tot = reduce_scatter32(ss, lane);
      {
        int L = lane & 31;
        part[w * 64 + 32 * (L >> 4) + crow(L & 15, h)] = tot;
      }
    }
    __syncthreads();
#pragma unroll 4
    for (int it = 0; it < 16; ++it) {
      const int chunk = opq(tid + NTHR * it);
      const int r = chunk >> 7, c8 = chunk & 127;
      const u32x4 xb = *(const u32x4*)(atile + r * ASTRIDE + c8 * 16);
      const size_t go = (tok0 + 64 * (size_t)r) * 1024 + c8 * 8;
      *(u32x4*)(p.X2B + go) = xb;
      unsigned hw[2], lw[2];
#pragma unroll
      for (int q = 0; q < 2; ++q) {
        hw[q] = 0u; lw[q] = 0u;
#pragma unroll
        for (int e = 0; e < 4; ++e) {
          const unsigned wv = xb[2 * q + (e >> 1)];
          const float x8 = ((e & 1) ? bfhi(wv) : bflo(wv)) * 8.f;
          const float hf = rintf(__builtin_amdgcn_fmed3f(x8, -127.f, 127.f));
          const float lf = rintf(__builtin_amdgcn_fmed3f((x8 - hf) * 128.f, -127.f, 127.f));
          hw[q] |= ((unsigned)((int)hf & 0xff)) << (8 * e);
          lw[q] |= ((unsigned)((int)lf & 0xff)) << (8 * e);
        }
      }
      u32x2 hv = {hw[0], hw[1]}, lv = {lw[0], lw[1]};
      *(u32x2*)(p.X8H + go) = hv;
      *(u32x2*)(p.X8L + go) = lv;
    }
    if (tid < 64) {
      float s = 0.f;
#pragma unroll
      for (int i = 0; i < 8; ++i) s += part[i * 64 + tid];
      rinv2[tid] = rsqrtf(s * (1.0f / 1024.f) + 1e-6f);
    }
    __syncthreads();
    int sk[2][16];
#pragma unroll
    for (int pq = 0; pq < 2; ++pq) {
      int run[2][16];
#pragma unroll
      for (int half = 0; half < 2; ++half) {
        f32x16 acc[2][2];
#pragma unroll
        for (int i = 0; i < 2; ++i)
#pragma unroll
          for (int j = 0; j < 2; ++j) acc[i][j] = zero16();
        {
          const int ln = opq(lane);
          const char* bbase = atile + (ln & 31) * ASTRIDE + (8 * (ln >> 5)) * 2;
          const char* wq = (const char*)(p.WqkF + (size_t)(8 * w + 4 * pq + 2 * half) * 64 * 64);
          const unsigned loff = (unsigned)ln * 16u;
          bf16x8 aq[PD][2];
#pragma unroll
          for (int d = 0; d < PD; ++d) { aq[d][0] = *(const bf16x8*)(wq + (unsigned)d * 1024u + loff); aq[d][1] = *(const bf16x8*)(wq + (unsigned)(64 + d) * 1024u + loff); }
#pragma unroll 1
          for (int ks0 = 0; ks0 < 64; ks0 += PD) {
#pragma unroll
            for (int d = 0; d < PD; ++d) {
              const int ks = ks0 + d;
              bf16x8 x0 = *(const bf16x8*)(bbase + ks * 32);
              bf16x8 x1 = *(const bf16x8*)(bbase + 32 * ASTRIDE + ks * 32);
              bf16x8 a0 = aq[d][0], a1 = aq[d][1];
              const unsigned ksn = opqs((unsigned)min(ks + PD, 63) * 1024u);
              aq[d][0] = *(const bf16x8*)(wq + ksn + loff); aq[d][1] = *(const bf16x8*)(wq + (ksn + 65536u) + loff);
              acc[0][0] = MFMA32(a0, x0, acc[0][0]); acc[0][1] = MFMA32(a0, x1, acc[0][1]);
              acc[1][0] = MFMA32(a1, x0, acc[1][0]); acc[1][1] = MFMA32(a1, x1, acc[1][1]);
            }
          }
        }
#pragma unroll
        for (int nt = 0; nt < 2; ++nt) {
#pragma unroll
          for (int mt = 0; mt < 2; ++mt) {
            int g[16];
            const int hb = opq(4 * h);
#pragma unroll
            for (int r = 0; r < 16; ++r) g[r] = (f2key(acc[mt][nt][r]) & ~0x7f) | (32 * (2 * half + mt) + (r & 3) + 8 * (r >> 2)) | hb;
            sort16_desc(g);
            if (half == 0 && mt == 0) {
#pragma unroll
              for (int i = 0; i < 16; ++i) run[nt][i] = g[i];
            } else {
              merge16_desc(run[nt], g);
            }
          }
        }
      }
      {
        int mine[16], other[16];
#pragma unroll
        for (int i = 0; i < 16; ++i) {
          const int give = h ? run[0][i] : run[1][i];
          mine[i] = h ? run[1][i] : run[0][i];
          other[i] = __shfl_xor(give, 32, 64);
        }
        merge16_desc(mine, other);
#pragma unroll
        for (int i = 0; i < 16; ++i) sk[pq][i] = mine[i];
      }
    }
    {
      float v0[16], v1[16];
      unsigned i0p[4], i1p[4];
      {
        int s0[16], s1[16];
#pragma unroll
        for (int i = 0; i < 16; ++i) { s0[i] = sk[0][i]; s1[i] = sk[1][i]; }
        const float sc = rinv2[32 * h + (lane & 31)];
#pragma unroll
        for (int i = 0; i < 16; ++i) { v0[i] = key2f(s0[i] & ~0x7f) * sc; v1[i] = key2f(s1[i] & ~0x7f) * sc; }
#pragma unroll
        for (int q = 0; q < 4; ++q) {
          i0p[q] = (unsigned)(s0[4 * q] & 0x7f) | ((unsigned)(s0[4 * q + 1] & 0x7f) << 8) | ((unsigned)(s0[4 * q + 2] & 0x7f) << 16) | ((unsigned)(s0[4 * q + 3] & 0x7f) << 24);
          i1p[q] = (unsigned)(s1[4 * q] & 0x7f) | ((unsigned)(s1[4 * q + 1] & 0x7f) << 8) | ((unsigned)(s1[4 * q + 2] & 0x7f) << 16) | ((unsigned)(s1[4 * q + 3] & 0x7f) << 24);
        }
      }
      int top[16];
#pragma unroll
      for (int grp = 0; grp < 4; ++grp) {
        int g[16];
#pragma unroll
        for (int t = 0; t < 16; ++t) {
          const int c = 16 * grp + t;
          if (c < 50) { const int ij = cand_ij(c); g[t] = (f2key(v0[ij >> 4] + v1[ij & 15]) & ~0xff) | ij; }
          else g[t] = (int)0x80000000;
        }
        sort16_desc(g);
        if (grp == 0) {
#pragma unroll
          for (int t = 0; t < 16; ++t) top[t] = g[t];
        } else {
          merge16_desc(top, g);
        }
      }
      float sum = 0.f;
      float mx = key2f(top[0] & ~0xff);
      float ev[16];
#pragma unroll
      for (int r = 0; r < 16; ++r) { ev[r] = __expf(key2f(top[r] & ~0xff) - mx); sum += ev[r]; }
      const float inv = 1.0f / sum;
      u32x4 o[4];
#pragma unroll
      for (int r = 0; r < 16; ++r) {
        int code = top[r] & 0xff, ci = code >> 4, cj = code & 15;
        unsigned w0 = (ci >> 2) == 0 ? i0p[0] : (ci >> 2) == 1 ? i0p[1] : (ci >> 2) == 2 ? i0p[2] : i0p[3];
        unsigned w1 = (cj >> 2) == 0 ? i1p[0] : (cj >> 2) == 1 ? i1p[1] : (cj >> 2) == 2 ? i1p[2] : i1p[3];
        unsigned e0 = (w0 >> ((ci & 3) * 8)) & 0x7f, e1 = (w1 >> ((cj & 3) * 8)) & 0x7f;
        unsigned e = e0 * 128 + e1;
        o[r >> 2][r & 3] = (e << 16) | (cvtpk(ev[r] * inv, 0.f) & 0xffffu);
      }
      const int lnp = opq(lane);
      unsigned* pr = p.PAIRS + (tok0 + 64 * (size_t)(32 * (lnp >> 5) + (lnp & 31))) * 128 + w * 16;
#pragma unroll
      for (int q = 0; q < 4; ++q) *(u32x4*)(pr + 4 * q) = o[q];
      {
        u32x4 e0, e1;
#pragma unroll
        for (int q = 0; q < 4; ++q) {
          e0[q] = (o[q >> 1][2 * (q & 1)] >> 16) | (o[q >> 1][2 * (q & 1) + 1] & 0xffff0000u);
          e1[q] = (o[2 + (q >> 1)][2 * (q & 1)] >> 16) | (o[2 + (q >> 1)][2 * (q & 1) + 1] & 0xffff0000u);
        }
        unsigned short* er = p.E16 + (tok0 + 64 * (size_t)(32 * (lnp >> 5) + (lnp & 31))) * 128 + w * 16;
        *(u32x4*)er = e0; *(u32x4*)(er + 8) = e1;
      }
    }
    if (tid < 64) p.RINV2[tok0 + 64 * (size_t)tid] = rinv2[tid];
  }
}


#define XB_TMO      128
#define XB_XCNT(j)  (256  + 64 * (j))
#define XB_XSUB(j)  (1280 + 64 * (j))
#define XB_XGEN(j)  (2304 + 64 * (j))
#define XB_TOP      3328
#define XB_TOPGEN   3392
#define XCD_BAR_WORDS 3456
#define XB_SPIN_CAP (1u << 22)
#define LAS __attribute__((address_space(3)))
DI unsigned xb_ld(unsigned* p) { return __hip_atomic_load(p, __ATOMIC_RELAXED, __HIP_MEMORY_SCOPE_AGENT); }
DI unsigned xb_add(unsigned* p, unsigned v) { return __hip_atomic_fetch_add(p, v, __ATOMIC_RELAXED, __HIP_MEMORY_SCOPE_AGENT); }
DI unsigned xb_xcc_id() { return (unsigned)__builtin_amdgcn_s_getreg((3 << 11) | 20) & 0xFu; }
#define XB_SPIN(cond, bar) do { unsigned _sp = 0; while (cond) { __builtin_amdgcn_s_sleep(1); \
    if ((++_sp & 255u) == 0u) { if (xb_ld(&(bar)[XB_TMO])) break; if (_sp > XB_SPIN_CAP) { atomicAdd(&(bar)[XB_TMO], 1u); break; } } } } while (0)
struct XcdBarrier { unsigned* bar; unsigned x; volatile LAS unsigned* st; };
DI XcdBarrier xcd_barrier_post(unsigned* bar, volatile LAS unsigned* st) {
  XcdBarrier b; b.bar = bar; b.x = xb_xcc_id(); b.st = st;
  if (threadIdx.x == 0) (void)xb_add(&bar[XB_XCNT(b.x)], 1u);
  return b;
}
DI void xcd_barrier_complete(unsigned* bar, unsigned x, unsigned& nloc, unsigned& nx) {
  const unsigned G = gridDim.x * gridDim.y * gridDim.z;
  unsigned sum, cnt, mine, sp = 0u;
  for (;;) {
    sum = 0u; cnt = 0u; mine = 0u;
#pragma unroll
    for (unsigned j = 0; j < 16; ++j) { const unsigned c = xb_ld(&bar[XB_XCNT(j)]); sum += c; cnt += (c > 0u) ? 1u : 0u; mine = (j == x) ? c : mine; }
    if (sum == G) break;
    __builtin_amdgcn_s_sleep(1);
    if ((++sp & 255u) == 0u) { if (xb_ld(&bar[XB_TMO])) break; if (sp > XB_SPIN_CAP) { atomicAdd(&bar[XB_TMO], 1u); break; } }
  }
  nloc = mine > 0u ? mine : 1u; nx = cnt > 0u ? cnt : 1u;
}
DI void xcd_barrier(const XcdBarrier& b) {
  asm volatile("s_waitcnt vmcnt(0)" ::: "memory");
  __syncthreads();
  if (threadIdx.x == 0) {
    unsigned* bar = b.bar;
    __builtin_amdgcn_s_waitcnt(0);
    unsigned nloc = b.st[0], nx = b.st[1];
    if (nloc == 0u) { xcd_barrier_complete(bar, b.x, nloc, nx); b.st[0] = nloc; b.st[1] = nx; }
    const unsigned old = xb_add(&bar[XB_XSUB(b.x)], 1u);
    const unsigned gen = old / nloc;
    if (old + 1u == (gen + 1u) * nloc) {
      __builtin_amdgcn_fence(__ATOMIC_RELEASE, "agent");
      asm volatile("s_waitcnt vmcnt(0)" ::: "memory");
      const unsigned og = xb_add(&bar[XB_TOP], 1u);
      const unsigned tg = og / nx;
      if (og + 1u == (tg + 1u) * nx) xb_add(&bar[XB_TOPGEN], 1u);
      else XB_SPIN(xb_ld(&bar[XB_TOPGEN]) == tg, bar);
      __builtin_amdgcn_fence(__ATOMIC_ACQUIRE, "agent");
      xb_add(&bar[XB_XGEN(b.x)], 1u);
      asm volatile("s_waitcnt vmcnt(0)" ::: "memory");
    } else {
      XB_SPIN(xb_ld(&bar[XB_XGEN(b.x)]) == gen, bar);
      __builtin_amdgcn_fence(__ATOMIC_ACQUIRE, "agent");
      asm volatile("s_waitcnt vmcnt(0)" ::: "memory");
    }
  }
  __syncthreads();
}

DI f32x2_t dec_lo(unsigned w) { return __builtin_amdgcn_cvt_pk_f32_fp8((int)w, false); }
DI f32x2_t dec_hi(unsigned w) { return __builtin_amdgcn_cvt_pk_f32_fp8((int)w, true); }
#define PCHUNK 16
#define NPCHUNK (NTOK / PCHUNK)
#define DPP_XOR1 0xB1
#define DPP_XOR2 0x4E
#define DPP_HALF_MIRROR 0x141
#define DPP_ROR8 0x128
template <int CTRL> DI int dpp_i(int v) { return __builtin_amdgcn_mov_dpp(v, CTRL, 0xF, 0xF, true); }
template <int CTRL> DI float dpp_f(float v) { return __builtin_bit_cast(float, __builtin_amdgcn_mov_dpp(__builtin_bit_cast(int, v), CTRL, 0xF, 0xF, true)); }
DI void phase4(const MP& p, char* smem) {
  const int lane = threadIdx.x & 63, w = __builtin_amdgcn_readfirstlane(threadIdx.x >> 6), g = lane >> 3, i = lane & 7;
  const unsigned xcc = xb_xcc_id() & 7u;
  const unsigned loff = 16u * (unsigned)i;
  char* stg = smem + w * 8192;
#pragma unroll 1
  for (int s = 0; s < 8; ++s) {
    const int slice = (int)((xcc + s) & 7u);
    unsigned* ctr = p.CTR + (size_t)slice * 64;
    const unsigned char* tbs = p.EU + (size_t)slice * 16384 * 128;
    _Float16* pre = (_Float16*)p.PRE + (size_t)slice * NTOK * 128 + 16 * g + 2 * i;
#pragma unroll 1
    for (;;) {
      unsigned c = 0;
      if (lane == 0) c = atomicAdd(ctr, 1u);
      c = (unsigned)__builtin_amdgcn_readfirstlane((int)c);
      if (c >= NPCHUNK) break;
      const size_t tokb = (size_t)c * PCHUNK;
      {
        const u32x4* ep = (const u32x4*)(p.E16 + tokb * 128) + lane;
        u32x4 ev[4], hv[2], lv[2];
#pragma unroll
        for (int j = 0; j < 4; ++j) ev[j] = ep[64 * j];
#pragma unroll
        for (int j = 0; j < 2; ++j) {
          const size_t xo = (tokb + 8 * j + (lane >> 3)) * 1024 + 128 * slice + loff;
          hv[j] = *(const u32x4*)(p.X8H + xo); lv[j] = *(const u32x4*)(p.X8L + xo);
        }
        __builtin_amdgcn_wave_barrier();
#pragma unroll
        for (int j = 0; j < 4; ++j) *(u32x4*)(stg + 1024 * j + 16 * lane) = ev[j];
#pragma unroll
        for (int j = 0; j < 2; ++j) { *(u32x4*)(stg + 4096 + 1024 * j + 16 * lane) = hv[j]; *(u32x4*)(stg + 6144 + 1024 * j + 16 * lane) = lv[j]; }
        __builtin_amdgcn_wave_barrier();
      }
#pragma unroll 1
      for (int tt = 0; tt < PCHUNK; ++tt) {
        const size_t tok = tokb + tt;
        const u32x4 pw0 = *(const u32x4*)(stg + 256 * tt + 32 * g), pw1 = *(const u32x4*)(stg + 256 * tt + 32 * g + 16);
        const u32x4 xh = *(const u32x4*)(stg + 4096 + 128 * tt + loff), xl = *(const u32x4*)(stg + 6144 + 128 * tt + loff);
        u32x4 ua[16];
#pragma unroll
        for (int k = 0; k < 16; ++k) {
          const unsigned e = __builtin_amdgcn_ubfe(k < 8 ? pw0[(k >> 1) & 3] : pw1[(k >> 1) & 3], 16 * (k & 1), 16);
          ua[k] = *(const u32x4*)(tbs + ((e << 7) | loff));
        }
        int v[16];
#pragma unroll
        for (int k = 0; k < 16; ++k) {
          int ah = 0, al = 0;
#pragma unroll
          for (int q = 0; q < 4; ++q) {
            ah = __builtin_amdgcn_sdot4((int)ua[k][q], (int)xh[q], ah, false);
            al = __builtin_amdgcn_sdot4((int)ua[k][q], (int)xl[q], al, false);
          }
          v[k] = (ah << 7) + al;
        }
        int a8[8], a4[4], a2[2];
        { const bool up = (lane & 4) != 0;
#pragma unroll
          for (int k = 0; k < 8; ++k) { const int keep = up ? v[8 + k] : v[k]; const int send = up ? v[k] : v[8 + k]; a8[k] = keep + dpp_i<DPP_HALF_MIRROR>(send); } }
        { const bool up = (lane & 2) != 0;
#pragma unroll
          for (int k = 0; k < 4; ++k) { const int keep = up ? a8[4 + k] : a8[k]; const int send = up ? a8[k] : a8[4 + k]; a4[k] = keep + dpp_i<DPP_XOR2>(send); } }
        { const bool up = (lane & 1) != 0;
#pragma unroll
          for (int k = 0; k < 2; ++k) { const int keep = up ? a4[2 + k] : a4[k]; const int send = up ? a4[k] : a4[2 + k]; a2[k] = keep + dpp_i<DPP_XOR1>(send); } }
        const float sc = 1.0f / 1048576.f;
        f16x2_t o2 = {(_Float16)((float)a2[0] * sc), (_Float16)((float)a2[1] * sc)};
        *(f16x2_t*)(pre + tok * 128) = o2;
      }
      __builtin_amdgcn_wave_barrier();
    }
  }
}
DI void phase5(const MP& p) {
  const long gtid = (long)blockIdx.x * NTHR + threadIdx.x;
  const long gsz = (long)gridDim.x * NTHR;
#pragma unroll 1
  for (long u = gtid; u < (long)NTOK * 32; u += gsz) {
    const long tok = u >> 5; const int q4 = (int)(u & 31) * 4;
    float4 s = make_float4(0.f, 0.f, 0.f, 0.f);
#pragma unroll
    for (int sl = 0; sl < 8; ++sl) {
      const u32x2 v = *(const u32x2*)((const _Float16*)p.PRE + ((size_t)sl * NTOK + tok) * 128 + q4);
      const f16x2_t v01 = as_h2(v[0]), v23 = as_h2(v[1]);
      s.x += (float)v01[0]; s.y += (float)v01[1]; s.z += (float)v23[0]; s.w += (float)v23[1];
    }
    const float ri = p.RINV2[tok];
    u32x4 pw = *(const u32x4*)(p.PAIRS + tok * 128 + q4);
    float4 a;
    a.x = gelu_f(s.x * ri) * bflo(pw[0]) * 16.f; a.y = gelu_f(s.y * ri) * bflo(pw[1]) * 16.f;
    a.z = gelu_f(s.z * ri) * bflo(pw[2]) * 16.f; a.w = gelu_f(s.w * ri) * bflo(pw[3]) * 16.f;
    int hw = __builtin_amdgcn_cvt_pk_fp8_f32(a.x, a.y, 0, false);
    hw = __builtin_amdgcn_cvt_pk_fp8_f32(a.z, a.w, hw, true);
    const f32x2_t d01 = __builtin_amdgcn_cvt_pk_f32_fp8(hw, false), d23 = __builtin_amdgcn_cvt_pk_f32_fp8(hw, true);
    int lw = __builtin_amdgcn_cvt_pk_fp8_f32((a.x - d01[0]) * 16.f, (a.y - d01[1]) * 16.f, 0, false);
    lw = __builtin_amdgcn_cvt_pk_fp8_f32((a.z - d23[0]) * 16.f, (a.w - d23[1]) * 16.f, lw, true);
    *(int*)(p.ACTH + tok * 128 + q4) = hw;
    *(int*)(p.ACTL + tok * 128 + q4) = lw;
  }
}
typedef int i32x8 __attribute__((ext_vector_type(8)));
struct V6Ctx {
  int lane, g, i, n, kq, bq, sc, tc, rg; bool valid; unsigned loff; unsigned sel[4]; int aoff;
};
DI void v6_load(const V6Ctx& c, u32x4 (&va)[16], u32x4& aw, unsigned*& xrow, const MP& p, const char* stg, const unsigned char* tbs, size_t tok, int tt, int slice) {
  aw = *(const u32x4*)(stg + c.aoff + 128 * tt);
  const u32x4 pw0 = *(const u32x4*)(stg + 256 * tt + 32 * c.g), pw1 = *(const u32x4*)(stg + 256 * tt + 32 * c.g + 16);
#pragma unroll
  for (int k = 0; k < 16; ++k) { const unsigned e = __builtin_amdgcn_ubfe(k < 8 ? pw0[(k >> 1) & 3] : pw1[(k >> 1) & 3], 16 * (k & 1), 16); va[k] = *(const u32x4*)(tbs + ((e << 7) | c.loff)); }
  xrow = (unsigned*)(p.OUTB + tok * 1024 + 128 * slice) + c.lane;
}
DI void v6_mma(const V6Ctx& c, const u32x4 (&va)[16], const u32x4 aw, float* red) {
  i32x8 B0, B1;
#pragma unroll
  for (int r = 0; r < 8; ++r) {
    B0[r] = (int)__builtin_amdgcn_perm(0u, aw[r >> 2], c.sel[r & 3]);
    B1[r] = (int)__builtin_amdgcn_perm(0u, aw[2 + (r >> 2)], c.sel[r & 3]);
  }
  float* dst = c.valid ? (red + (c.tc * 2 + c.sc) * 128 + 64 * (c.rg & 1) + c.bq) : (red + 512 + c.lane);
  const int st = c.valid ? 1 : 0;
#pragma unroll
  for (int q = 0; q < 4; ++q) {
    i32x8 A0, A1;
#pragma unroll
    for (int r = 0; r < 8; ++r) { A0[r] = (int)va[r][q]; A1[r] = (int)va[8 + r][q]; }
    f32x4 z = {0.f, 0.f, 0.f, 0.f};
    z = __builtin_amdgcn_mfma_scale_f32_16x16x128_f8f6f4(A0, B0, z, 0, 0, 0, 0x7f7f7f7f, 0, 0x7f7f7f7f);
    z = __builtin_amdgcn_mfma_scale_f32_16x16x128_f8f6f4(A1, B1, z, 0, 0, 0, 0x7f7f7f7f, 0, 0x7f7f7f7f);
#pragma unroll
    for (int r = 0; r < 4; ++r) {
      float v = z[r];
      asm volatile("" : "+v"(v));
      dst[st * (16 * r + 4 * q)] = v;
    }
  }
}
DI void v6_fin(const V6Ctx& c, const float* red, unsigned* xrow) {
  const f32x2_t h0 = *(const f32x2_t*)(red + 0 * 128 + 2 * c.lane), h1 = *(const f32x2_t*)(red + 1 * 128 + 2 * c.lane);
  const f32x2_t l0 = *(const f32x2_t*)(red + 2 * 128 + 2 * c.lane), l1 = *(const f32x2_t*)(red + 3 * 128 + 2 * c.lane);
  const float o0 = ((h0[0] + h1[0]) + (l0[0] + l1[0]) * (1.0f / 16.f)) * (1.0f / 64.f);
  const float o1 = ((h0[1] + h1[1]) + (l0[1] + l1[1]) * (1.0f / 16.f)) * (1.0f / 64.f);
  *xrow = cvtpk(o0, o1);
}
DI void phase6(const MP& p, char* smem) {
  V6Ctx c;
  c.lane = threadIdx.x & 63;
  const int w = __builtin_amdgcn_readfirstlane(threadIdx.x >> 6);
  c.g = c.lane >> 3; c.i = c.lane & 7; c.n = c.lane & 15; c.kq = c.lane >> 4; c.bq = c.n & 3; c.sc = (c.n >> 2) & 1; c.tc = c.n >> 3; c.rg = c.kq;
  c.loff = 16u * (unsigned)c.i;
  c.valid = ((c.rg >> 1) == c.sc);
#pragma unroll
  for (int j = 0; j < 4; ++j) c.sel[j] = (0x0c0c0c0cu & ~(0xffu << (8 * c.bq))) | ((unsigned)j << (8 * c.bq));
  c.aoff = 4096 + 2048 * c.tc + 16 * (2 * c.kq + c.sc);
  const unsigned xcc = xb_xcc_id() & 7u;
  float* redA = (float*)(smem + w * 4608);
  float* redB = redA + 576;
  char* stg = smem + 8 * 4608 + w * 8192;
#pragma unroll 1
  for (int s = 0; s < 8; ++s) {
    const int slice = (int)((xcc + s) & 7u);
    unsigned* ctr = p.CTR + (size_t)(8 + slice) * 64;
    const unsigned char* tbs = p.EV + (size_t)slice * 16384 * 128;
#pragma unroll 1
    for (;;) {
      unsigned cc = 0;
      if (c.lane == 0) cc = atomicAdd(ctr, 1u);
      cc = (unsigned)__builtin_amdgcn_readfirstlane((int)cc);
      if (cc >= NPCHUNK) break;
      const size_t tokb = (size_t)cc * PCHUNK;
      {
        const u32x4* ep = (const u32x4*)(p.E16 + tokb * 128) + c.lane;
        u32x4 ev[4], ah[2], al[2];
#pragma unroll
        for (int j = 0; j < 4; ++j) ev[j] = ep[64 * j];
#pragma unroll
        for (int j = 0; j < 2; ++j) { ah[j] = ((const u32x4*)(p.ACTH + tokb * 128))[64 * j + c.lane]; al[j] = ((const u32x4*)(p.ACTL + tokb * 128))[64 * j + c.lane]; }
        __builtin_amdgcn_wave_barrier();
#pragma unroll
        for (int j = 0; j < 4; ++j) *(u32x4*)(stg + 1024 * j + 16 * c.lane) = ev[j];
#pragma unroll
        for (int j = 0; j < 2; ++j) { *(u32x4*)(stg + 4096 + 1024 * j + 16 * c.lane) = ah[j]; *(u32x4*)(stg + 6144 + 1024 * j + 16 * c.lane) = al[j]; }
        __builtin_amdgcn_wave_barrier();
      }
#pragma unroll 1
      for (int tt = 0; tt < PCHUNK; tt += 2) {
        u32x4 vaA[16], vaB[16], awA, awB; unsigned *rowA, *rowB;
        v6_load(c, vaA, awA, rowA, p, stg, tbs, tokb + tt, tt, slice);
        v6_load(c, vaB, awB, rowB, p, stg, tbs, tokb + tt + 1, tt + 1, slice);
        v6_mma(c, vaA, awA, redA);
        v6_mma(c, vaB, awB, redB);
        __builtin_amdgcn_wave_barrier();
        v6_fin(c, redA, rowA);
        v6_fin(c, redB, rowB);
        __builtin_amdgcn_wave_barrier();
      }
    }
  }
}
DI void phase7(const MP& p) {
  const int lane = threadIdx.x & 63;
  const int gw = blockIdx.x * (NTHR / 64) + (threadIdx.x >> 6), nw = gridDim.x * (NTHR / 64);
  const float4* fp = (const float4*)p.fg + 4 * lane;
  float4 f[4];
#pragma unroll
  for (int q = 0; q < 4; ++q) f[q] = fp[q];
#pragma unroll 2
  for (int tok = gw; tok < NTOK; tok += nw) {
    const u32x4* xp = (const u32x4*)(p.X2B + (size_t)tok * 1024) + 2 * lane;
    const u32x4* op_ = (const u32x4*)(p.OUTB + (size_t)tok * 1024) + 2 * lane;
    const u32x4 a = xp[0], b = xp[1], oa = op_[0], ob = op_[1];
    float v[16];
#pragma unroll
    for (int q = 0; q < 4; ++q) {
      v[2 * q] = bflo(a[q]) + bflo(oa[q]); v[2 * q + 1] = bfhi(a[q]) + bfhi(oa[q]);
      v[8 + 2 * q] = bflo(b[q]) + bflo(ob[q]); v[8 + 2 * q + 1] = bfhi(b[q]) + bfhi(ob[q]);
    }
    float s = 0.f;
#pragma unroll
    for (int q = 0; q < 16; ++q) s = fmaf(v[q], v[q], s);
    for (int m = 32; m >= 1; m >>= 1) s += __shfl_xor(s, m, 64);
    const float r3 = rsqrtf(s * (1.0f / 1024.f) + 1e-6f);
    float4* op = (float4*)(p.out + (size_t)tok * 1024) + 4 * lane;
#pragma unroll
    for (int q = 0; q < 4; ++q)
      op[q] = make_float4(v[4 * q] * r3 * f[q].x, v[4 * q + 1] * r3 * f[q].y, v[4 * q + 2] * r3 * f[q].z, v[4 * q + 3] * r3 * f[q].w);
  }
}

#define SMEM_BYTES (ATILE_BYTES + 64 * 4 + 8 * 64 * 4)
__global__ void __launch_bounds__(NTHR) k_mega(MP p) {
  __shared__ __attribute__((aligned(16))) char smem[SMEM_BYTES];
  __shared__ uint4 xb_words;
  if (threadIdx.x == 0) xb_words = make_uint4(0u, 0u, 0u, 0u);
  __syncthreads();
  XcdBarrier gb = xcd_barrier_post(p.bar, (volatile LAS unsigned*)&xb_words);
  phase0(p, smem);
  xcd_barrier(gb);
  phase1(p, smem);
  xcd_barrier(gb);
  phase2(p, smem);
  xcd_barrier(gb);
  phase3(p, smem);
  xcd_barrier(gb);
  phase4(p, smem);
  xcd_barrier(gb);
  phase5(p);
  xcd_barrier(gb);
  phase6(p, smem);
  xcd_barrier(gb);
  phase7(p);
}

extern "C" void kernel_launch(void* const* d_in, const int* in_sizes, int n_in, void* d_out, int out_size, void* d_ws, size_t ws_size,
                              hipStream_t stream) {
  float* out = (float*)d_out;
  char* arena1 = (char*)d_ws;
  size_t o1 = 0;
  auto A1 = [&](size_t bytes) { void* r = arena1 + o1; o1 += (bytes + 255) & ~(size_t)255; return r; };
  MP p;
  memset(&p, 0, sizeof(p));
  p.x = (const float*)d_in[0]; p.g1 = (const float*)d_in[1]; p.w_in = (const float*)d_in[2]; p.a_re = (const float*)d_in[3];
  p.a_im = (const float*)d_in[4]; p.log_step = (const float*)d_in[5]; p.b_re = (const float*)d_in[6]; p.b_im = (const float*)d_in[7];
  p.c_re = (const float*)d_in[8]; p.c_im = (const float*)d_in[9]; p.ssm_d = (const float*)d_in[10]; p.w_glu = (const float*)d_in[11];
  p.w_f = (const float*)d_in[12]; p.w_out = (const float*)d_in[13]; p.g2 = (const float*)d_in[14]; p.w_q = (const float*)d_in[15];
  p.keys = (const float*)d_in[16]; p.eu = (const float*)d_in[17]; p.ev = (const float*)d_in[18]; p.fg = (const float*)d_in[19];
  p.out = out;
  p.U = (unsigned short*)A1((size_t)NTOK * 512 * 2);
  p.T = (unsigned short*)A1((size_t)NTOK * 1024 * 2);
  p.YF = (unsigned short*)A1((size_t)NTOK * 512 * 2);
  p.YB = (unsigned short*)A1((size_t)NTOK * 512 * 2);
  p.PAIRS = (unsigned*)A1((size_t)NTOK * 128 * 4);
  p.E16 = (unsigned short*)A1((size_t)NTOK * 128 * 2);
  p.EU = (unsigned char*)A1((size_t)16384 * 1024);
  p.EV = (unsigned char*)A1((size_t)16384 * 1024);
  p.WinF = (bf16x8*)A1((size_t)1024 * 1536 * 2);
  p.WgluF = (bf16x8*)A1((size_t)512 * 512 * 2);
  p.WoutF = (bf16x8*)A1((size_t)1024 * 1024 * 2);
  p.WqkF = (bf16x8*)A1((size_t)1024 * 2048 * 2);
  p.M1F = (bf16x8*)A1((size_t)128 * 128 * 2);
  p.M3T = (unsigned short*)A1((size_t)4096 * 128 * 2);
  p.s5lam = (float*)A1((size_t)64 * 64 * 2 * 4);
  p.s5B = (bf16x8*)A1((size_t)64 * 4 * 64 * 16);
  p.s5C = (bf16x8*)A1((size_t)64 * 4 * 64 * 16);
  p.bar = (unsigned*)A1((size_t)XCD_BAR_WORDS * 4);
  p.CTR = (unsigned*)A1((size_t)16 * 64 * 4);
  (void)hipMemsetAsync(p.bar, 0, (size_t)((char*)(p.CTR + 16 * 64) - (char*)p.bar), stream);
  p.RINV2 = (float*)A1((size_t)NTOK * 4);
  p.OUTB = (unsigned short*)A1((size_t)NTOK * 1024 * 2);
  p.X2B = (unsigned short*)A1((size_t)NTOK * 1024 * 2);
  p.ACTH = (unsigned char*)A1((size_t)NTOK * 128);
  p.ACTL = (unsigned char*)A1((size_t)NTOK * 128);
  p.X8H = (unsigned char*)A1((size_t)NTOK * 1024);
  p.X8L = (unsigned char*)A1((size_t)NTOK * 1024);
  p.PRE = (float*)A1((size_t)8 * NTOK * 128 * 2);
  static int grid_blocks = 0;
  if (!grid_blocks) {
    int dev = 0, cus = 0, per_cu = 0;
    (void)hipGetDevice(&dev);
    (void)hipDeviceGetAttribute(&cus, hipDeviceAttributeMultiprocessorCount, dev);
    (void)hipOccupancyMaxActiveBlocksPerMultiprocessor(&per_cu, k_mega, NTHR, 0);
    if (per_cu < 1) per_cu = 1;
    if (per_cu > 1) per_cu = 1;
    grid_blocks = cus * per_cu;
  }
  void* args[] = {&p};
  hipError_t e = hipLaunchCooperativeKernel((void*)k_mega, dim3(grid_blocks), dim3(NTHR), args, 0, stream);
  if (e != hipSuccess) fprintf(stderr, "cooperative launch failed: %s (grid %d)\n", hipGetErrorString(e), grid_blocks);
}
```

```cpp
#include <hip/hip_runtime.h>
#include <stdint.h>
#include <string.h>
#include <stdio.h>

#define NTOK 65536

__device__ __forceinline__ void dsincos(double x, double* s, double* c) {
  double q = rint(x * 0.63661977236758134308);
  double r = fma(-q, 1.57079632679489655800, x);
  r = fma(-q, 6.12323399573676603587e-17, r);
  double r2 = r * r;
  double sp = r * (1.0 + r2 * (-1.0 / 6 + r2 * (1.0 / 120 + r2 * (-1.0 / 5040 + r2 * (1.0 / 362880 + r2 * (-1.0 / 39916800 + r2 * (1.0 / 6227020800.0 + r2 * (-1.0 / 1307674368000.0))))))));
  double cp = 1.0 + r2 * (-0.5 + r2 * (1.0 / 24 + r2 * (-1.0 / 720 + r2 * (1.0 / 40320 + r2 * (-1.0 / 3628800 + r2 * (1.0 / 479001600.0 + r2 * (-1.0 / 87178291200.0)))))));
  long long qi = (long long)q;
  int m = (int)(qi & 3);
  double ss = (m == 0) ? sp : (m == 1) ? cp : (m == 2) ? -sp : -cp;
  double cc = (m == 0) ? cp : (m == 1) ? -sp : (m == 2) ? -cp : sp;
  *s = ss; *c = cc;
}

typedef short bf16x8 __attribute__((ext_vector_type(8)));
typedef float f32x16 __attribute__((ext_vector_type(16)));
typedef float f32x4 __attribute__((ext_vector_type(4)));
typedef unsigned u32x4 __attribute__((ext_vector_type(4)));
typedef unsigned u32x2 __attribute__((ext_vector_type(2)));
typedef float f32x2_t __attribute__((ext_vector_type(2)));
typedef __bf16 bf16x2_t __attribute__((ext_vector_type(2)));
typedef _Float16 f16x2_t __attribute__((ext_vector_type(2)));
typedef _Float16 f16x8_t __attribute__((ext_vector_type(8)));
__device__ __forceinline__ f16x2_t as_h2(unsigned v) { return __builtin_bit_cast(f16x2_t, v); }
#define DI __device__ __forceinline__
#define MFMA32(a, b, c) __builtin_amdgcn_mfma_f32_32x32x16_bf16((a), (b), (c), 0, 0, 0)
#define MFMA16(a, b, c) __builtin_amdgcn_mfma_f32_16x16x32_bf16((a), (b), (c), 0, 0, 0)
#define NTHR 512
#define ASTRIDE 2064
#define ATILE_BYTES (64 * ASTRIDE)

DI unsigned cvtpk(float lo, float hi) { f32x2_t v = {lo, hi}; bf16x2_t b = __builtin_convertvector(v, bf16x2_t); return __builtin_bit_cast(unsigned, b); }
DI unsigned short f2bf(float x) { return (unsigned short)(cvtpk(x, 0.f) & 0xffffu); }
DI float bf2f(unsigned h) { return __uint_as_float(h << 16); }
DI float bflo(unsigned w) { return __uint_as_float(w << 16); }
DI float bfhi(unsigned w) { return __uint_as_float(w & 0xffff0000u); }
DI int crow(int reg, int h) { return (reg & 3) + 8 * (reg >> 2) + 4 * h; }
DI f32x16 zero16() { f32x16 z; for (int i = 0; i < 16; ++i) z[i] = 0.f; return z; }

struct MP {
  const float *x, *g1, *w_in, *a_re, *a_im, *log_step, *b_re, *b_im, *c_re, *c_im, *ssm_d, *w_glu, *w_f, *w_out, *g2, *w_q, *keys, *eu, *ev, *fg;
  float* out;
  bf16x8 *WinF, *WgluF, *WoutF, *WqkF, *M1F, *s5B, *s5C;
  unsigned short *M3T, *U, *T, *YF, *YB;
  unsigned char *EU, *EV;
  float* s5lam;
  unsigned* PAIRS;
  unsigned short* E16;
  unsigned* bar;
  unsigned* CTR;
  float *RINV2, *PRE;
  unsigned short* OUTB;
  unsigned short* X2B;
  unsigned char *ACTH, *ACTL;
  unsigned char *X8H, *X8L;
};

DI void s5_params(const MP& p, int dg, int pp, float& lr, float& li, double& fr, double& fi) {
  double are = p.a_re[dg * 64 + pp], aim = p.a_im[dg * 64 + pp];
  double step = exp((double)p.log_step[dg]);
  double sn_, cs_;
  dsincos(aim * step, &sn_, &cs_);
  double mag = exp(are * step);
  double lrd = mag * cs_, lid = mag * sn_;
  double nr = lrd - 1.0, ni = lid;
  double den = are * are + aim * aim;
  fr = (nr * are + ni * aim) / den; fi = (ni * are - nr * aim) / den;
  lr = (float)lrd; li = (float)lid;
}

DI int opq(int v) { asm volatile("" : "+v"(v)); return v; }
DI unsigned opqu(unsigned v) { asm volatile("" : "+v"(v)); return v; }
DI unsigned opqs(unsigned v) { asm volatile("" : "+s"(v)); return v; }
DI void fold_dot8(float (&out)[8], const float* __restrict__ w0, size_t wstride, const float* lds, int stride, int n4) {
#pragma unroll
  for (int j = 0; j < 8; ++j) out[j] = 0.f;
#pragma unroll 2
  for (int m4 = 0; m4 < n4; ++m4) {
    const float l0 = lds[(4 * m4) * stride], l1 = lds[(4 * m4 + 1) * stride], l2 = lds[(4 * m4 + 2) * stride], l3 = lds[(4 * m4 + 3) * stride];
#pragma unroll
    for (int j = 0; j < 8; ++j) {
      const float4 wv = ((const float4*)(w0 + j * wstride))[m4];
      out[j] = fmaf(wv.x, l0, out[j]); out[j] = fmaf(wv.y, l1, out[j]); out[j] = fmaf(wv.z, l2, out[j]); out[j] = fmaf(wv.w, l3, out[j]);
    }
  }
}
DI void conv_frag(bf16x8* dst, const float* __restrict__ src, int ld, const float* __restrict__ kscale, int ntiles, int KS, long gtid, long gsz) {
  const long total = (long)ntiles * KS * 64;
#pragma unroll 1
  for (long u = gtid; u < total; u += gsz) {
    int lane = (int)(u & 63);
    long q = u >> 6;
    int ks = (int)(q % KS), nt = (int)(q / KS);
    int n = 32 * nt + (lane & 31), k0 = 16 * ks + 8 * (lane >> 5);
    u32x4 w;
#pragma unroll
    for (int jj = 0; jj < 4; ++jj) {
      int k = k0 + 2 * jj;
      float a = src[(size_t)k * ld + n], b = src[(size_t)(k + 1) * ld + n];
      if (kscale) { a *= kscale[k]; b *= kscale[k + 1]; }
      w[jj] = cvtpk(a, b);
    }
    dst[u] = __builtin_bit_cast(bf16x8, w);
  }
}

DI void late_prep(const MP& p, long gtid, long gsz) {
#pragma unroll 1
  for (long u = gtid; u < 4096 * 128; u += gsz) {
    int s2ri = (int)(u & 127), k = (int)(u >> 7);
    int ri = s2ri >> 6, s2 = s2ri & 63;
    double sv, cv;
    dsincos(6.283185307179586476925 * (double)((k * s2) & 4095) / 4096.0, &sv, &cv);
    p.M3T[u] = f2bf((float)(ri ? sv : cv));
  }
#pragma unroll 1
  for (long u = gtid; u < (long)16384 * 1024 / 16; u += gsz) {
    int d0 = (int)((u * 16) & 1023);
    const float4* s = (const float4*)(p.eu + u * 16);
    const float4* gq = (const float4*)(p.g2 + d0);
    const float4* s2 = (const float4*)(p.ev + u * 16);
    u32x4 ou, ov;
#pragma unroll
    for (int q = 0; q < 4; ++q) {
      float4 a = s[q], g = gq[q], b = s2[q];
      {
        const int q0 = (int)rintf(__builtin_amdgcn_fmed3f(a.x * g.x * 1024.f, -127.f, 127.f)), q1 = (int)rintf(__builtin_amdgcn_fmed3f(a.y * g.y * 1024.f, -127.f, 127.f));
        const int q2 = (int)rintf(__builtin_amdgcn_fmed3f(a.z * g.z * 1024.f, -127.f, 127.f)), q3 = (int)rintf(__builtin_amdgcn_fmed3f(a.w * g.w * 1024.f, -127.f, 127.f));
        ou[q] = (unsigned)(q0 & 0xff) | ((unsigned)(q1 & 0xff) << 8) | ((unsigned)(q2 & 0xff) << 16) | ((unsigned)(q3 & 0xff) << 24);
      }
      int w2 = __builtin_amdgcn_cvt_pk_fp8_f32(b.x * 4.f, b.y * 4.f, 0, false);
      w2 = __builtin_amdgcn_cvt_pk_fp8_f32(b.z * 4.f, b.w * 4.f, w2, true);
      ov[q] = (unsigned)w2;
    }
    {
      const long e = u >> 6; const int c16 = (int)(u & 63);
      const size_t dst = (((size_t)(c16 >> 3) * 16384 + (size_t)e) * 128) + (size_t)(c16 & 7) * 16;
      *(u32x4*)(p.EU + dst) = ou;
      *(u32x4*)(p.EV + dst) = ov;
    }
  }
}

DI void phase0(const MP& p, char* smem) {
  const int tid = threadIdx.x;
  const long gtid = (long)blockIdx.x * NTHR + tid;
  const long gsz = (long)gridDim.x * NTHR;
  conv_frag(p.WinF, p.w_in, 1024, p.g1, 16, 64, gtid, gsz);
  conv_frag(p.WgluF, p.w_glu, 512, nullptr, 16, 32, gtid, gsz);
  conv_frag(p.WoutF, p.w_out, 1024, nullptr, 32, 64, gtid, gsz);
#pragma unroll 1
  for (long u = gtid; u < 4 * 8 * 64; u += gsz) {
    int lane = (int)(u & 63), ks = (int)((u >> 6) & 7), mt = (int)(u >> 9);
    int row = 32 * mt + (lane & 31), h = lane >> 5;
    int ri = row >> 6, k1 = row & 63;
    u32x4 w;
#pragma unroll
    for (int jj = 0; jj < 4; ++jj) {
      float v2[2];
#pragma unroll
      for (int e = 0; e < 2; ++e) {
        int j = 2 * jj + e;
        int col = 16 * ks + 8 * (j >> 2) + 4 * h + (j & 3);
        int ab = col >> 6, s1 = col & 63;
        double sv, cv;
        dsincos(6.283185307179586476925 * (double)((k1 * s1) & 63) / 64.0, &sv, &cv);
        double val = (ri == 0) ? (ab == 0 ? cv : -sv) : (ab == 0 ? -sv : -cv);
        v2[e] = (float)val;
      }
      w[jj] = cvtpk(v2[0], v2[1]);
    }
    p.M1F[u] = __builtin_bit_cast(bf16x8, w);
  }
#pragma unroll 1
  for (long u = gtid; u < 64 * 64; u += gsz) {
    int pp = (int)(u & 63), dg = (int)(u >> 6);
    float lr, li; double fr, fi;
    s5_params(p, dg, pp, lr, li, fr, fi);
    p.s5lam[u * 2] = lr; p.s5lam[u * 2 + 1] = li;
  }
#pragma unroll 1
  for (long u = gtid; u < 64 * 4 * 64; u += gsz) {
    int lane = (int)(u & 63), nt = (int)((u >> 6) & 3), dg = (int)(u >> 8);
    int col = 32 * nt + (lane & 31), ri = col >> 6, pp = col & 63, h = lane >> 5;
    float lr, li; double fr, fi;
    s5_params(p, dg, pp, lr, li, fr, fi);
    const float* brp = p.b_re + ((size_t)dg * 64 + pp) * 16 + 8 * h;
    const float* bip = p.b_im + ((size_t)dg * 64 + pp) * 16 + 8 * h;
    u32x4 w;
#pragma unroll
    for (int jj = 0; jj < 4; ++jj) {
      double br0 = brp[2 * jj], bi0 = bip[2 * jj], br1 = brp[2 * jj + 1], bi1 = bip[2 * jj + 1];
      float v0 = (float)(ri ? (fr * bi0 + fi * br0) : (fr * br0 - fi * bi0));
      float v1 = (float)(ri ? (fr * bi1 + fi * br1) : (fr * br1 - fi * bi1));
      w[jj] = cvtpk(v0, v1);
    }
    p.s5B[u] = __builtin_bit_cast(bf16x8, w);
  }
#pragma unroll 1
  for (long u = gtid; u < 64 * 4 * 64; u += gsz) {
    int lane = (int)(u & 63), ks = (int)((u >> 6) & 3), dg = (int)(u >> 8);
    int c = lane & 15;
    u32x4 w;
#pragma unroll
    for (int jj = 0; jj < 4; ++jj) {
      int kk = 32 * ks + 8 * (lane >> 4) + 2 * jj;
      int pt = kk >> 6, pq = (kk & 63) >> 1;
      int pp = 32 * pt + pq;
      float vre = p.c_re[((size_t)dg * 16 + c) * 64 + pp];
      float vim = -p.c_im[((size_t)dg * 16 + c) * 64 + pp];
      w[jj] = cvtpk(vre, vim);
    }
    p.s5C[u] = __builtin_bit_cast(bf16x8, w);
  }
  {
    float* AB = (float*)smem;
    float* tab = AB + 128 * 32;
    const float nrm = 1.0f / sqrtf(4096.f * 128.f);
#pragma unroll 1
    for (int task = blockIdx.x; task < 128; task += gridDim.x) {
      int ntp = task >> 2, kq = task & 3;
      int ab = ntp >> 4, chbase = (ntp & 15) * 32, g = chbase >> 7, d0 = chbase & 127;
      __syncthreads();
      if (tid < 128) {
        double sv, cv;
        dsincos(6.283185307179586476925 * (double)tid / 128.0, &sv, &cv);
        tab[tid] = (float)(ab ? sv : cv);
      }
      __syncthreads();
#pragma unroll 1
      for (int o = tid; o < 128 * 32; o += NTHR) {
        int m = o >> 5, dd = o & 31;
        float s = 0.f;
#pragma unroll 4
        for (int c = 0; c < 128; ++c) s = fmaf(tab[(m * c) & 127], p.w_f[((size_t)g * 128 + c) * 128 + d0 + dd], s);
        AB[o] = s * nrm;
      }
      __syncthreads();
#pragma unroll 1
      for (int uu = tid; uu < 16 * 64; uu += NTHR) {
        int lane = uu & 63, ks = kq * 16 + (uu >> 6);
        int dd = lane & 31, h = lane >> 5;
        u32x4 w;
        {
          const int k0 = 16 * ks + 8 * h;
          float sv[8];
          fold_dot8(sv, p.w_in + (size_t)k0 * 1024 + 512 + 128 * g, 1024, AB + dd, 32, 32);
#pragma unroll
          for (int jj = 0; jj < 4; ++jj) w[jj] = cvtpk(sv[2 * jj] * p.g1[k0 + 2 * jj], sv[2 * jj + 1] * p.g1[k0 + 2 * jj + 1]);
        }
        p.WinF[((size_t)(16 + ntp) * 64 + ks) * 64 + lane] = __builtin_bit_cast(bf16x8, w);
      }
    }
  }
  {
    float* Ks = (float*)smem;
#pragma unroll 1
    for (int task = (int)((blockIdx.x + gridDim.x / 2) % gridDim.x); task < 128; task += gridDim.x) {
      int hp = task >> 3, kt = (task >> 1) & 3, chalf = task & 1;
      __syncthreads();
#pragma unroll 1
      for (int o = tid; o < 32 * 128; o += NTHR) {
        int kk = o >> 7, d = o & 127;
        Ks[kk * 129 + d] = p.keys[((size_t)hp * 128 + kt * 32 + kk) * 128 + d];
      }
      __syncthreads();
#pragma unroll 1
      for (int uu = tid; uu < 32 * 64; uu += NTHR) {
        int lane = uu & 63, ks = chalf * 32 + (uu >> 6);
        int kk = lane & 31, h = lane >> 5;
        u32x4 w;
        {
          const int c0 = 16 * ks + 8 * h;
          float sv[8];
          fold_dot8(sv, p.w_q + (size_t)c0 * 2048 + hp * 128, 2048, Ks + kk * 129, 1, 32);
#pragma unroll
          for (int jj = 0; jj < 4; ++jj) w[jj] = cvtpk(sv[2 * jj] * p.g2[c0 + 2 * jj], sv[2 * jj + 1] * p.g2[c0 + 2 * jj + 1]);
        }
        p.WqkF[((size_t)(hp * 4 + kt) * 64 + ks) * 64 + lane] = __builtin_bit_cast(bf16x8, w);
      }
    }
  }
}

#define PD 4
template <int NT, int PDT>
DI void gemm_tile(f32x16 (&acc)[2][NT], const char* atile, int acol0, const bf16x8* __restrict__ wf, int KS, int nks, int lane, int stride2 = 2) {
  const char* abase = atile + (lane & 31) * ASTRIDE + (acol0 + 8 * (lane >> 5)) * 2;
  const char* wbase = (const char*)wf;
  const unsigned loff = (unsigned)lane * 16u;
  unsigned noff[NT];
#pragma unroll
  for (int nt = 0; nt < NT; ++nt) noff[nt] = (unsigned)(((nt & 1) + (nt >> 1) * stride2) * KS) * 1024u;
  bf16x8 bq[PDT][NT];
#pragma unroll
  for (int d = 0; d < PDT; ++d)
#pragma unroll
    for (int nt = 0; nt < NT; ++nt) bq[d][nt] = *(const bf16x8*)(wbase + (noff[nt] + (unsigned)d * 1024u) + loff);
#pragma unroll 1
  for (int ks0 = 0; ks0 < nks; ks0 += PDT) {
#pragma unroll
    for (int d = 0; d < PDT; ++d) {
      const int ks = ks0 + d;
      bf16x8 a0 = *(const bf16x8*)(abase + ks * 32);
      bf16x8 a1 = *(const bf16x8*)(abase + 32 * ASTRIDE + ks * 32);
      bf16x8 b[NT];
#pragma unroll
      for (int nt = 0; nt < NT; ++nt) b[nt] = bq[d][nt];
      const unsigned ksn = (unsigned)min(ks + PDT, nks - 1) * 1024u;
#pragma unroll
      for (int nt = 0; nt < NT; ++nt) bq[d][nt] = *(const bf16x8*)(wbase + (noff[nt] + ksn) + loff);
#pragma unroll
      for (int nt = 0; nt < NT; ++nt) {
        acc[0][nt] = MFMA32(a0, b[nt], acc[0][nt]);
        acc[1][nt] = MFMA32(a1, b[nt], acc[1][nt]);
      }
    }
  }
}

DI bf16x8 pack_step(const f32x16& x, int s) {
  u32x4 w;
  w[0] = cvtpk(x[8 * s + 0], x[8 * s + 1]); w[1] = cvtpk(x[8 * s + 2], x[8 * s + 3]);
  w[2] = cvtpk(x[8 * s + 4], x[8 * s + 5]); w[3] = cvtpk(x[8 * s + 6], x[8 * s + 7]);
  return __builtin_bit_cast(bf16x8, w);
}


template <typename PT>
DI void store_tile_pairs(const float (&vals)[16], PT base, unsigned rs, bool odd) {
#pragma unroll
  for (int r = 0; r < 16; r += 2) {
    const float send = odd ? vals[r] : vals[r + 1];
    const float recv = __builtin_bit_cast(float, __builtin_amdgcn_mov_dpp(__builtin_bit_cast(int, send), 0xB1, 0xF, 0xF, true));
    const float lo = odd ? recv : vals[r];
    const float hi = odd ? vals[r + 1] : recv;
    const int rc = (r & 3) + 8 * (r >> 2);
    *(unsigned*)(base + (size_t)rc * rs) = cvtpk(lo, hi);
  }
}
DI void phase1(const MP& p, char* smem) {
  const int tid = threadIdx.x, w = __builtin_amdgcn_readfirstlane(tid >> 6);
  char* atile = smem;
  float* rinv = (float*)(smem + ATILE_BYTES);
  for (int tt = blockIdx.x; tt < 1024; tt += gridDim.x) {
    const int b = tt >> 6, s2 = tt & 63;
    const int lane = opq((int)threadIdx.x & 63), h = lane >> 5;
    __syncthreads();
    {
      float4 v[8][4];
#pragma unroll
      for (int rr = 0; rr < 8; ++rr) {
        const float4* xp = (const float4*)(p.x + ((size_t)b * 4096 + 64 * (w * 8 + rr) + s2) * 1024);
#pragma unroll
        for (int i = 0; i < 4; ++i) v[rr][i] = xp[lane + 64 * i];
      }
#pragma unroll
      for (int rr = 0; rr < 8; ++rr) {
        const int r = w * 8 + rr;
        float s = 0.f;
#pragma unroll
        for (int i = 0; i < 4; ++i) s += v[rr][i].x * v[rr][i].x + v[rr][i].y * v[rr][i].y + v[rr][i].z * v[rr][i].z + v[rr][i].w * v[rr][i].w;
        for (int m = 32; m >= 1; m >>= 1) s += __shfl_xor(s, m, 64);
        if (lane == 0) rinv[r] = rsqrtf(s * (1.0f / 1024.f) + 1e-6f);
#pragma unroll
        for (int i = 0; i < 4; ++i) {
          u32x2 pk; pk[0] = cvtpk(v[rr][i].x, v[rr][i].y); pk[1] = cvtpk(v[rr][i].z, v[rr][i].w);
          *(u32x2*)(atile + r * ASTRIDE + (lane + 64 * i) * 8) = pk;
        }
      }
    }
    __syncthreads();
    {
      f32x16 acc[2][2];
#pragma unroll
      for (int i = 0; i < 2; ++i)
#pragma unroll
        for (int j = 0; j < 2; ++j) acc[i][j] = zero16();
      gemm_tile<2, 4>(acc, atile, 0, p.WinF + (size_t)(2 * w) * 64 * 64, 64, 64, lane);
      {
        const bool odd = (lane & 1) != 0;
        const unsigned ubase = (unsigned)((((size_t)b * 4096 + s2 + 64 * (4 * h + (odd ? 1 : 0))) * 512 + 64 * w + ((lane & 31) & ~1)) * 2);
#pragma unroll
        for (int mt = 0; mt < 2; ++mt)
#pragma unroll
          for (int nt = 0; nt < 2; ++nt) {
            const unsigned tb = opqu(ubase + (unsigned)((32 * mt * 64 * 512 + 32 * nt) * 2));
            const float* rvp = rinv + opq(32 * mt + 4 * h);
            float vals[16];
#pragma unroll
            for (int r = 0; r < 16; ++r) vals[r] = acc[mt][nt][r] * rvp[(r & 3) + 8 * (r >> 2)];
            store_tile_pairs(vals, (char*)p.U + tb, 64u * 512u * 2u, odd);
          }
      }
    }
    {
      bf16x8 xs[8][2];
      {
        f32x16 acc[2][4];
#pragma unroll
        for (int i = 0; i < 2; ++i)
#pragma unroll
          for (int j = 0; j < 4; ++j) acc[i][j] = zero16();
        gemm_tile<4, 2>(acc, atile, 0, p.WinF + (size_t)(16 + 2 * w) * 64 * 64, 64, 64, opq(lane), 16);
#pragma unroll
        for (int mt = 0; mt < 2; ++mt) {
#pragma unroll
          for (int c = 0; c < 4; ++c) {
            const float* rvp = rinv + opq(32 * mt + 4 * h);
#pragma unroll
            for (int r = 0; r < 16; ++r) acc[mt][c][r] *= rvp[(r & 3) + 8 * (r >> 2)];
            const int ab = c >> 1, nt = c & 1;
            xs[ab * 4 + mt * 2 + 0][nt] = pack_step(acc[mt][c], 0);
            xs[ab * 4 + mt * 2 + 1][nt] = pack_step(acc[mt][c], 1);
          }
        }
      }
#pragma unroll
      for (int mt = 0; mt < 4; ++mt) {
        f32x16 t0 = zero16(), t1 = zero16();
        const bf16x8* mf = p.M1F + (size_t)(opq(mt * 8)) * 64 + lane;
#pragma unroll
        for (int ks = 0; ks < 8; ++ks) {
          bf16x8 a = mf[ks * 64];
          t0 = MFMA32(a, xs[ks][0], t0);
          t1 = MFMA32(a, xs[ks][1], t1);
        }
        const int ri = mt >> 1;
        const bool odd = (lane & 1) != 0;
        const unsigned tbase = opqu((unsigned)(((((size_t)b * 64 + 32 * (mt & 1) + 4 * h + (odd ? 1 : 0)) * 128 + ri * 64 + s2) * 512 + 64 * w + ((lane & 31) & ~1)) * 2));
        float v0[16], v1[16];
#pragma unroll
        for (int r = 0; r < 16; ++r) { v0[r] = t0[r]; v1[r] = t1[r]; }
        store_tile_pairs(v0, (char*)p.T + tbase, 128u * 512u * 2u, odd);
        store_tile_pairs(v1, (char*)p.T + tbase + 64, 128u * 512u * 2u, odd);
      }
    }
  }
}

#define XS_STRIDE 272
#define XS_BYTES (32 * XS_STRIDE)
typedef volatile __attribute__((address_space(3))) int* ldsflag_t;
DI void flag_wait(ldsflag_t f, int target) { while (*f < target) __builtin_amdgcn_s_sleep(1); asm volatile("" ::: "memory"); }
DI void flag_set(ldsflag_t f, int v) { asm volatile("s_waitcnt lgkmcnt(0)" ::: "memory"); *f = v; }
DI void phase2(const MP& p, char* smem) {
  const int tid = threadIdx.x, lane = tid & 63, w = __builtin_amdgcn_readfirstlane(tid >> 6), h = lane >> 5;
  ldsflag_t flags = (ldsflag_t)(smem + 4 * XS_BYTES);
  if (tid < 8) flags[tid] = 0;
  __syncthreads();
  if (w >= 6) {
    late_prep(p, ((long)blockIdx.x * 2 + (w - 6)) * 64 + lane, (long)gridDim.x * 2 * 64);
    return;
  }
  const int slot = w / 3, role = w - 3 * slot;
  ldsflag_t fA0 = flags + 3 * slot, fA1 = fA0 + 1, fB = fA0 + 2;
  char* xt = smem + slot * 2 * XS_BYTES;
  int round = 0;
#pragma unroll 1
  for (int t0 = blockIdx.x * 2; t0 < 512; t0 += gridDim.x * 2, ++round) {
    const int task = t0 + slot;
    if (task >= 512) break;
    const int dir = task & 1, bp = (task >> 1) & 7, g = (task >> 4) & 31;
    const int dg = dir * 32 + g;
    const int base = round * 256;
    if (role < 2) {
      const int pt = role;
      const bf16x8 bf_re = p.s5B[(size_t)(dg * 4 + 0 + pt) * 64 + lane], bf_im = p.s5B[(size_t)(dg * 4 + 2 + pt) * 64 + lane];
      const int pp = 32 * pt + (lane & 31);
      const float lr = p.s5lam[((size_t)dg * 64 + pp) * 2], li = p.s5lam[((size_t)dg * 64 + pp) * 2 + 1];
      const int rho = lane & 31;
      const int hr = (rho >> 2) & 1, rr = (rho & 3) + 4 * (rho >> 3);
      const size_t ubase = ((size_t)(2 * bp + hr) * 4096) * 512 + g * 16 + 8 * h;
      float xr = 0.f, xi = 0.f;
      const float nli = -li;
      bf16x8 aq[4];
#pragma unroll
      for (int d = 0; d < 4; ++d) { int q = 16 * d + rr; int tpos = dir ? (4095 - q) : q; aq[d] = *(const bf16x8*)(p.U + ubase + (size_t)tpos * 512); }
      ldsflag_t fmine = pt ? fA1 : fA0;
#pragma unroll 1
      for (int step0 = 0; step0 < 256; step0 += 4) {
#pragma unroll
        for (int d = 0; d < 4; ++d) {
          const int step = step0 + d;
          const bf16x8 a = aq[d];
          { int q = 16 * min(step + 4, 255) + rr; int tpos = dir ? (4095 - q) : q; aq[d] = *(const bf16x8*)(p.U + ubase + (size_t)tpos * 512); }
          const f32x16 bre = MFMA32(a, bf_re, zero16());
          const f32x16 bim = MFMA32(a, bf_im, zero16());
          flag_wait(fB, base + step - 1);
          char* xrow = xt + (d & 1) * XS_BYTES + (h * 16) * XS_STRIDE + (pt * 64 + 2 * (lane & 31)) * 2;
#pragma unroll
          for (int r = 0; r < 16; ++r) {
            float ir = fmaf(nli, xi, bre[r]);
            float ii = fmaf(li, xr, bim[r]);
            asm volatile("" : "+v"(ir));
            asm volatile("" : "+v"(ii));
            float nr = fmaf(lr, xr, ir);
            float ni = fmaf(lr, xi, ii);
            asm volatile("" : "+v"(nr));
            asm volatile("" : "+v"(ni));
            xr = nr; xi = ni;
            *(unsigned*)(xrow + r * XS_STRIDE) = cvtpk(xr, xi);
          }
          flag_set(fmine, base + step + 1);
        }
      }
    } else {
      bf16x8 cf[4];
#pragma unroll
      for (int ks = 0; ks < 4; ++ks) cf[ks] = p.s5C[(size_t)(dg * 4 + ks) * 64 + lane];
      unsigned short* yo = dir ? p.YB : p.YF;
      const bool odd = (lane & 1) != 0;
#pragma unroll 1
      for (int step = 0; step < 256; ++step) {
        flag_wait(fA0, base + step + 1);
        flag_wait(fA1, base + step + 1);
        const char* xb = xt + (step & 1) * XS_BYTES;
        bf16x8 xa[2][4];
#pragma unroll
        for (int mt = 0; mt < 2; ++mt)
#pragma unroll
          for (int ks = 0; ks < 4; ++ks) xa[mt][ks] = *(const bf16x8*)(xb + (mt * 16 + (lane & 15)) * XS_STRIDE + (32 * ks + 8 * (lane >> 4)) * 2);
        flag_set(fB, base + step + 1);
#pragma unroll
        for (int mt = 0; mt < 2; ++mt) {
          f32x4 y = {0.f, 0.f, 0.f, 0.f};
#pragma unroll
          for (int ks = 0; ks < 4; ++ks) y = MFMA16(xa[mt][ks], cf[ks], y);
#pragma unroll
          for (int r = 0; r < 4; r += 2) {
            const float send = odd ? y[r] : y[r + 1];
            const float recv = __builtin_bit_cast(float, __builtin_amdgcn_mov_dpp(__builtin_bit_cast(int, send), 0xB1, 0xF, 0xF, true));
            const float lo = odd ? recv : y[r], hi = odd ? y[r + 1] : recv;
            const int q = 16 * step + 4 * (lane >> 4) + r + (odd ? 1 : 0);
            const int tpos = dir ? (4095 - q) : q;
            *(unsigned*)(yo + ((size_t)(2 * bp + mt) * 4096 + tpos) * 512 + g * 16 + ((lane & 15) & ~1)) = cvtpk(lo, hi);
          }
        }
      }
    }
  }
}

DI int f2key(float f) { return __float_as_int(__builtin_amdgcn_fmed3f(f, -60.f, 60.f) + 64.f); }
DI float key2f(int k) { return __int_as_float(k) - 64.f; }
#define CE_DESC(a, b) { int mx_ = max(a, b), mn_ = min(a, b); a = mx_; b = mn_; }
#define CE_ASC(a, b) { int mx_ = max(a, b), mn_ = min(a, b); a = mn_; b = mx_; }

#define S16(i, j) CE_DESC(v[i], v[j])
DI void sort16_desc(int (&v)[16]) {
  S16(0,13) S16(1,12) S16(2,15) S16(3,14) S16(4,8) S16(5,6) S16(7,11) S16(9,10)
  S16(0,5) S16(1,7) S16(2,9) S16(3,4) S16(6,13) S16(8,14) S16(10,15) S16(11,12)
  S16(0,1) S16(2,3) S16(4,5) S16(6,8) S16(7,9) S16(10,11) S16(12,13) S16(14,15)
  S16(0,2) S16(1,3) S16(4,10) S16(5,11) S16(6,7) S16(8,9) S16(12,14) S16(13,15)
  S16(1,2) S16(3,12) S16(4,6) S16(5,7) S16(8,10) S16(9,11) S16(13,14)
  S16(1,4) S16(2,6) S16(5,8) S16(7,10) S16(9,13) S16(11,14)
  S16(2,4) S16(3,6) S16(9,12) S16(11,13)
  S16(3,5) S16(6,8) S16(7,9) S16(10,12)
  S16(3,4) S16(5,6) S16(7,8) S16(9,10) S16(11,12)
  S16(6,7) S16(8,9)
}
DI void merge16_desc(int (&a)[16], const int (&b)[16]) {
#pragma unroll
  for (int i = 0; i < 16; ++i) a[i] = max(a[i], b[15 - i]);
#pragma unroll
  for (int j = 8; j > 0; j >>= 1) {
#pragma unroll
    for (int i = 0; i < 16; ++i) {
      const int l = i ^ j;
      if (l > i) { CE_DESC(a[i], a[l]); }
    }
  }
}
DI void top16_of_64(const int (&k)[64], int (&out)[16]) {
  int g1[16], g2[16], g3[16];
#pragma unroll
  for (int i = 0; i < 16; ++i) { out[i] = k[i]; g1[i] = k[16 + i]; g2[i] = k[32 + i]; g3[i] = k[48 + i]; }
  sort16_desc(out); sort16_desc(g1); sort16_desc(g2); sort16_desc(g3);
  merge16_desc(out, g1); merge16_desc(g2, g3); merge16_desc(out, g2);
}

DI float reduce_scatter32(float (&v)[32], int lane) {
  float a[16];
  {
    const bool up = (lane & 16) != 0;
#pragma unroll
    for (int i = 0; i < 16; ++i) { float keep = up ? v[16 + i] : v[i]; float send = up ? v[i] : v[16 + i]; a[i] = keep + __shfl_xor(send, 16, 64); }
  }
  float b[8];
  {
    const bool up = (lane & 8) != 0;
#pragma unroll
    for (int i = 0; i < 8; ++i) { float keep = up ? a[8 + i] : a[i]; float send = up ? a[i] : a[8 + i]; b[i] = keep + __shfl_xor(send, 8, 64); }
  }
  float c[4];
  {
    const bool up = (lane & 4) != 0;
#pragma unroll
    for (int i = 0; i < 4; ++i) { float keep = up ? b[4 + i] : b[i]; float send = up ? b[i] : b[4 + i]; c[i] = keep + __shfl_xor(send, 4, 64); }
  }
  float d[2];
  {
    const bool up = (lane & 2) != 0;
#pragma unroll
    for (int i = 0; i < 2; ++i) { float keep = up ? c[2 + i] : c[i]; float send = up ? c[i] : c[2 + i]; d[i] = keep + __shfl_xor(send, 2, 64); }
  }
  {
    const bool up = (lane & 1) != 0;
    float keep = up ? d[1] : d[0]; float send = up ? d[0] : d[1];
    return keep + __shfl_xor(send, 1, 64);
  }
}
DI float reduce_scatter64(float (&v)[64], int lane) {
  float a[32];
  const bool up = (lane & 32) != 0;
#pragma unroll
  for (int i = 0; i < 32; ++i) { float keep = up ? v[32 + i] : v[i]; float send = up ? v[i] : v[32 + i]; a[i] = keep + __shfl_xor(send, 32, 64); }
  return reduce_scatter32(a, lane);
}

__host__ __device__ constexpr int cand_ij(int c) {
  int n = 0;
  for (int a = 0; a < 16; ++a)
    for (int b = 0; b < 16; ++b)
      if ((a + 1) * (b + 1) <= 16) { if (n == c) return a * 16 + b; ++n; }
  return 0;
}
__host__ __device__ constexpr int cand_index(int i, int j) {
  int n = 0;
  for (int a = 0; a < 16; ++a)
    for (int b = 0; b < 16; ++b)
      if ((a + 1) * (b + 1) <= 16) { if (a == i && b == j) return n; ++n; }
  return n;
}
static_assert(cand_index(15, 0) == 49, "50 candidates");
DI float erf_as(float z) {
  const float az = fabsf(z);
  const float t = __builtin_amdgcn_rcpf(fmaf(0.3275911f, az, 1.0f));
  float pl = fmaf(1.061405429f, t, -1.453152027f);
  pl = fmaf(pl, t, 1.421413741f);
  pl = fmaf(pl, t, -0.284496736f);
  pl = fmaf(pl, t, 0.254829592f);
  pl *= t;
  const float ex = __expf(-az * az);
  const float r = fmaf(-pl, ex, 1.0f);
  return copysignf(r, z);
}
DI float gelu_f(float x) { return 0.5f * x * (1.0f + erf_as(x * 0.70710678118654752440f)); }

DI void phase3(const MP& p, char* smem) {
  const int tid = threadIdx.x, lane = tid & 63, w = __builtin_amdgcn_readfirstlane(tid >> 6), h = lane >> 5;
  char* atile = smem;
  float* rinv2 = (float*)(smem + ATILE_BYTES);
  float* part = rinv2 + 64;
  for (int tt = blockIdx.x; tt < 1024; tt += gridDim.x) {
    const int b = tt >> 6, k1 = tt & 63;
    const size_t tok0 = (size_t)b * 4096 + k1;
    __syncthreads();
#pragma unroll
    for (int it = 0; it < 8; ++it) {
      int chunk = opq(tid + NTHR * it);
      int r = chunk >> 6, c8 = chunk & 63;
      size_t off = (tok0 + 64 * (size_t)r) * 512 + c8 * 8;
      u32x4 yf = *(const u32x4*)(p.YF + off), yb = *(const u32x4*)(p.YB + off), uu = *(const u32x4*)(p.U + off);
      float4 d0 = *(const float4*)(p.ssm_d + c8 * 8), d1 = *(const float4*)(p.ssm_d + c8 * 8 + 4);
      float dd[8] = {d0.x, d0.y, d0.z, d0.w, d1.x, d1.y, d1.z, d1.w};
      u32x4 o;
#pragma unroll
      for (int q = 0; q < 4; ++q) {
        float lo = bflo(yf[q]) + bflo(yb[q]) + dd[2 * q] * bflo(uu[q]);
        float hi = bfhi(yf[q]) + bfhi(yb[q]) + dd[2 * q + 1] * bfhi(uu[q]);
        o[q] = cvtpk(gelu_f(lo), gelu_f(hi));
      }
      *(u32x4*)(atile + r * ASTRIDE + c8 * 16) = o;
    }
    __syncthreads();
    f32x16 gacc[2][2];
#pragma unroll
    for (int i = 0; i < 2; ++i)
#pragma unroll
      for (int j = 0; j < 2; ++j) gacc[i][j] = zero16();
    gemm_tile<2, 4>(gacc, atile, 0, p.WgluF + (size_t)(2 * w) * 32 * 64, 32, 32, opq(lane));
    {
      f32x16 facc[2][2];
#pragma unroll
      for (int i = 0; i < 2; ++i)
#pragma unroll
        for (int j = 0; j < 2; ++j) facc[i][j] = zero16();
      const int lnf = opq(lane);
      const unsigned short* m3 = p.M3T + ((size_t)k1 + 64 * (size_t)(lnf & 31)) * 128 + 8 * (lnf >> 5);
      const unsigned short* tb = p.T + (((size_t)b * 64 + k1) * 128 + 8 * (lnf >> 5)) * 512 + 64 * w + (lnf & 31);
#pragma unroll 4
      for (int ks = 0; ks < 8; ++ks) {
        bf16x8 a0 = *(const bf16x8*)(m3 + 16 * ks);
        bf16x8 a1 = *(const bf16x8*)(m3 + (size_t)32 * 64 * 128 + 16 * ks);
        bf16x8 b0, b1;
#pragma unroll
        for (int j = 0; j < 8; ++j) {
          b0[j] = (short)tb[((size_t)16 * ks + j) * 512];
          b1[j] = (short)tb[((size_t)16 * ks + j) * 512 + 32];
        }
        facc[0][0] = MFMA32(a0, b0, facc[0][0]); facc[1][0] = MFMA32(a1, b0, facc[1][0]);
        facc[0][1] = MFMA32(a0, b1, facc[0][1]); facc[1][1] = MFMA32(a1, b1, facc[1][1]);
      }
#pragma unroll
      for (int mt = 0; mt < 2; ++mt)
#pragma unroll
        for (int nt = 0; nt < 2; ++nt)
#pragma unroll
          for (int r = 0; r < 16; ++r) {
            int row = 32 * mt + crow(r, lnf >> 5), col = 512 + 64 * w + 32 * nt + (lnf & 31);
            *(unsigned short*)(atile + row * ASTRIDE + col * 2) = f2bf(facc[mt][nt][r]);
          }
    }
    __syncthreads();
    {
    const int lng = opq(lane);
#pragma unroll
    for (int mt = 0; mt < 2; ++mt)
#pragma unroll
      for (int nt = 0; nt < 2; ++nt)
#pragma unroll
        for (int r = 0; r < 16; ++r) {
          int row = 32 * mt + crow(r, lng >> 5), col = 64 * w + 32 * nt + (lng & 31);
          unsigned short* q = (unsigned short*)(atile + row * ASTRIDE + col * 2);
          float yv = bf2f(*q);
          *q = f2bf(yv / (1.0f + __expf(-gacc[mt][nt][r])));
        }
    }
    __syncthreads();
    {
      f32x16 acc[2][4];
#pragma unroll
      for (int i = 0; i < 2; ++i)
#pragma unroll
        for (int j = 0; j < 4; ++j) acc[i][j] = zero16();
      float pfx[4];
      {
        const int t_ = opq(tid);
#pragma unroll
        for (int q = 0; q < 4; ++q) { const int ln = t_ + NTHR * q; pfx[q] = p.x[(tok0 + 64 * (size_t)(ln >> 5)) * 1024 + (ln & 31) * 32]; }
      }
      gemm_tile<4, 2>(acc, atile, 0, p.WoutF + (size_t)(4 * w) * 64 * 64, 64, 64, opq(lane));
      asm volatile("" :: "v"(pfx[0]), "v"(pfx[1]), "v"(pfx[2]), "v"(pfx[3]));
      __syncthreads();
      float ss[32];
#pragma unroll
      for (int i = 0; i < 32; ++i) ss[i] = 0.f;
      {
        const int lnd = opq(lane);
        const unsigned gbase = (unsigned)(((tok0 + 256 * (lnd >> 5)) * 1024 + 128 * w + (lnd & 31)) * 4);
#pragma unroll
        for (int mt = 0; mt < 2; ++mt)
#pragma unroll
          for (int nt = 0; nt < 4; ++nt) {
            const unsigned gb = opqu(gbase + (unsigned)((32 * mt * 64 * 1024 + 32 * nt) * 4));
            const bool odd = (lnd & 1) != 0;
            char* lb = atile + opq((32 * mt + 4 * (lnd >> 5) + (odd ? 1 : 0)) * ASTRIDE + (128 * w + 32 * nt + ((lnd & 31) & ~1)) * 2);
#pragma unroll
            for (int r = 0; r < 16; r += 2) {
              const int rc = (r & 3) + 8 * (r >> 2);
              const unsigned go0 = gb + (unsigned)(rc * 64 * 1024 * 4), go1 = gb + (unsigned)((rc + 1) * 64 * 1024 * 4);
              const float v0 = *(const float*)((const char*)p.x + go0) + acc[mt][nt][r];
              const float v1 = *(const float*)((const char*)p.x + go1) + acc[mt][nt][r + 1];
              ss[mt * 16 + r] = fmaf(v0, v0, ss[mt * 16 + r]);
              ss[mt * 16 + r + 1] = fmaf(v1, v1, ss[mt * 16 + r + 1]);
              const float send = odd ? v0 : v1;
              const float recv = __builtin_bit_cast(float, __builtin_amdgcn_mov_dpp(__builtin_bit_cast(int, send), 0xB1, 0xF, 0xF, true));
              *(unsigned*)(lb + rc * ASTRIDE) = cvtpk(odd ? recv : v0, odd ? v1 : recv);
            }
          }
      }
      float tot = reduce_scatter32(ss, lane);
      {
        int L = lane & 31;
        part[w * 64 + 32 * (L >> 4) + crow(L & 15, h)] = tot;
      }
    }
    __syncthreads();
#pragma unroll 4
    for (int it = 0; it < 16; ++it) {
      const int chunk = opq(tid + NTHR * it);
      const int r = chunk >> 7, c8 = chunk & 127;
      const u32x4 xb = *(const u32x4*)(atile + r * ASTRIDE + c8 * 16);
      const size_t go = (tok0 + 64 * (size_t)r) * 1024 + c8 * 8;
      *(u32x4*)(p.X2B + go) = xb;
      unsigned hw[2], lw[2];
#pragma unroll
      for (int q = 0; q < 2; ++q) {
        hw[q] = 0u; lw[q] = 0u;
#pragma unroll
        for (int e = 0; e < 4; ++e) {
          const unsigned wv = xb[2 * q + (e >> 1)];
          const float x8 = ((e & 1) ? bfhi(wv) : bflo(wv)) * 8.f;
          const float hf = rintf(__builtin_amdgcn_fmed3f(x8, -127.f, 127.f));
          const float lf = rintf(__builtin_amdgcn_fmed3f((x8 - hf) * 128.f, -127.f, 127.f));
          hw[q] |= ((unsigned)((int)hf & 0xff)) << (8 * e);
          lw[q] |= ((unsigned)((int)lf & 0xff)) << (8 * e);
        }
      }
      u32x2 hv = {hw[0], hw[1]}, lv = {lw[0], lw[1]};
      *(u32x2*)(p.X8H + go) = hv;
      *(u32x2*)(p.X8L + go) = lv;
    }
    if (tid < 64) {
      float s = 0.f;
#pragma unroll
      for (int i = 0; i < 8; ++i) s += part[i * 64 + tid];
      rinv2[tid] = rsqrtf(s * (1.0f / 1024.f) + 1e-6f);
    }
    __syncthreads();
    int sk[2][16];
#pragma unroll
    for (int pq = 0; pq < 2; ++pq) {
      int run[2][16];
#pragma unroll
      for (int half = 0; half < 2; ++half) {
        f32x16 acc[2][2];
#pragma unroll
        for (int i = 0; i < 2; ++i)
#pragma unroll
          for (int j = 0; j < 2; ++j) acc[i][j] = zero16();
        {
          const int ln = opq(lane);
          const char* bbase = atile + (ln & 31) * ASTRIDE + (8 * (ln >> 5)) * 2;
          const char* wq = (const char*)(p.WqkF + (size_t)(8 * w + 4 * pq + 2 * half) * 64 * 64);
          const unsigned loff = (unsigned)ln * 16u;
          bf16x8 aq[PD][2];
#pragma unroll
          for (int d = 0; d < PD; ++d) { aq[d][0] = *(const bf16x8*)(wq + (unsigned)d * 1024u + loff); aq[d][1] = *(const bf16x8*)(wq + (unsigned)(64 + d) * 1024u + loff); }
#pragma unroll 1
          for (int ks0 = 0; ks0 < 64; ks0 += PD) {
#pragma unroll
            for (int d = 0; d < PD; ++d) {
              const int ks = ks0 + d;
              bf16x8 x0 = *(const bf16x8*)(bbase + ks * 32);
              bf16x8 x1 = *(const bf16x8*)(bbase + 32 * ASTRIDE + ks * 32);
              bf16x8 a0 = aq[d][0], a1 = aq[d][1];
              const unsigned ksn = opqs((unsigned)min(ks + PD, 63) * 1024u);
              aq[d][0] = *(const bf16x8*)(wq + ksn + loff); aq[d][1] = *(const bf16x8*)(wq + (ksn + 65536u) + loff);
              acc[0][0] = MFMA32(a0, x0, acc[0][0]); acc[0][1] = MFMA32(a0, x1, acc[0][1]);
              acc[1][0] = MFMA32(a1, x0, acc[1][0]); acc[1][1] = MFMA32(a1, x1, acc[1][1]);
            }
          }
        }
#pragma unroll
        for (int nt = 0; nt < 2; ++nt) {
#pragma unroll
          for (int mt = 0; mt < 2; ++mt) {
            int g[16];
            const int hb = opq(4 * h);
#pragma unroll
            for (int r = 0; r < 16; ++r) g[r] = (f2key(acc[mt][nt][r]) & ~0x7f) | (32 * (2 * half + mt) + (r & 3) + 8 * (r >> 2)) | hb;
            sort16_desc(g);
            if (half == 0 && mt == 0) {
#pragma unroll
              for (int i = 0; i < 16; ++i) run[nt][i] = g[i];
            } else {
              merge16_desc(run[nt], g);
            }
          }
        }
      }
      {
        int mine[16], other[16];
#pragma unroll
        for (int i = 0; i < 16; ++i) {
          const int give = h ? run[0][i] : run[1][i];
          mine[i] = h ? run[1][i] : run[0][i];
          other[i] = __shfl_xor(give, 32, 64);
        }
        merge16_desc(mine, other);
#pragma unroll
        for (int i = 0; i < 16; ++i) sk[pq][i] = mine[i];
      }
    }
    {
      float v0[16], v1[16];
      unsigned i0p[4], i1p[4];
      {
        int s0[16], s1[16];
#pragma unroll
        for (int i = 0; i < 16; ++i) { s0[i] = sk[0][i]; s1[i] = sk[1][i]; }
        const float sc = rinv2[32 * h + (lane & 31)];
#pragma unroll
        for (int i = 0; i < 16; ++i) { v0[i] = key2f(s0[i] & ~0x7f) * sc; v1[i] = key2f(s1[i] & ~0x7f) * sc; }
#pragma unroll
        for (int q = 0; q < 4; ++q) {
          i0p[q] = (unsigned)(s0[4 * q] & 0x7f) | ((unsigned)(s0[4 * q + 1] & 0x7f) << 8) | ((unsigned)(s0[4 * q + 2] & 0x7f) << 16) | ((unsigned)(s0[4 * q + 3] & 0x7f) << 24);
          i1p[q] = (unsigned)(s1[4 * q] & 0x7f) | ((unsigned)(s1[4 * q + 1] & 0x7f) << 8) | ((unsigned)(s1[4 * q + 2] & 0x7f) << 16) | ((unsigned)(s1[4 * q + 3] & 0x7f) << 24);
        }
      }
      int top[16];
#pragma unroll
      for (int grp = 0; grp < 4; ++grp) {
        int g[16];
#pragma unroll
        for (int t = 0; t < 16; ++t) {
          const int c = 16 * grp + t;
          if (c < 50) { const int ij = cand_ij(c); g[t] = (f2key(v0[ij >> 4] + v1[ij & 15]) & ~0xff) | ij; }
          else g[t] = (int)0x80000000;
        }
        sort16_desc(g);
        if (grp == 0) {
#pragma unroll
          for (int t = 0; t < 16; ++t) top[t] = g[t];
        } else {
          merge16_desc(top, g);
        }
      }
      float sum = 0.f;
      float mx = key2f(top[0] & ~0xff);
      float ev[16];
#pragma unroll
      for (int r = 0; r < 16; ++r) { ev[r] = __expf(key2f(top[r] & ~0xff) - mx); sum += ev[r]; }
      const float inv = 1.0f / sum;
      u32x4 o[4];
#pragma unroll
      for (int r = 0; r < 16; ++r) {
        int code = top[r] & 0xff, ci = code >> 4, cj = code & 15;
        unsigned w0 = (ci >> 2) == 0 ? i0p[0] : (ci >> 2) == 1 ? i0p[1] : (ci >> 2) == 2 ? i0p[2] : i0p[3];
        unsigned w1 = (cj >> 2) == 0 ? i1p[0] : (cj >> 2) == 1 ? i1p[1] : (cj >> 2) == 2 ? i1p[2] : i1p[3];
        unsigned e0 = (w0 >> ((ci & 3) * 8)) & 0x7f, e1 = (w1 >> ((cj & 3) * 8)) & 0x7f;
        unsigned e = e0 * 128 + e1;
        o[r >> 2][r & 3] = (e << 16) | (cvtpk(ev[r] * inv, 0.f) & 0xffffu);
      }
      const int lnp = opq(lane);
      unsigned* pr = p.PAIRS + (tok0 + 64 * (size_t)(32 * (lnp >> 5) + (lnp & 31))) * 128 + w * 16;
#pragma unroll
      for (int q = 0; q < 4; ++q) *(u32x4*)(pr + 4 * q) = o[q];
      {
        u32x4 e0, e1;
#pragma unroll
        for (int q = 0; q < 4; ++q) {
          e0[q] = (o[q >> 1][2 * (q & 1)] >> 16) | (o[q >> 1][2 * (q & 1) + 1] & 0xffff0000u);
          e1[q] = (o[2 + (q >> 1)][2 * (q & 1)] >> 16) | (o[2 + (q >> 1)][2 * (q & 1) + 1] & 0xffff0000u);
        }
        unsigned short* er = p.E16 + (tok0 + 64 * (size_t)(32 * (lnp >> 5) + (lnp & 31))) * 128 + w * 16;
        *(u32x4*)er = e0; *(u32x4*)(er + 8) = e1;
      }
    }
    if (tid < 64) p.RINV2[tok0 + 64 * (size_t)tid] = rinv2[tid];
  }
}


#define XB_TMO      128
#define XB_XCNT(j)  (256  + 64 * (j))
#define XB_XSUB(j)  (1280 + 64 * (j))
#define XB_XGEN(j)  (2304 + 64 * (j))
#define XB_TOP      3328
#define XB_TOPGEN   3392
#define XCD_BAR_WORDS 3456
#define XB_SPIN_CAP (1u << 22)
#define LAS __attribute__((address_space(3)))
DI unsigned xb_ld(unsigned* p) { return __hip_atomic_load(p, __ATOMIC_RELAXED, __HIP_MEMORY_SCOPE_AGENT); }
DI unsigned xb_add(unsigned* p, unsigned v) { return __hip_atomic_fetch_add(p, v, __ATOMIC_RELAXED, __HIP_MEMORY_SCOPE_AGENT); }
DI unsigned xb_xcc_id() { return (unsigned)__builtin_amdgcn_s_getreg((3 << 11) | 20) & 0xFu; }
#define XB_SPIN(cond, bar) do { unsigned _sp = 0; while (cond) { __builtin_amdgcn_s_sleep(1); \
    if ((++_sp & 255u) == 0u) { if (xb_ld(&(bar)[XB_TMO])) break; if (_sp > XB_SPIN_CAP) { atomicAdd(&(bar)[XB_TMO], 1u); break; } } } } while (0)
struct XcdBarrier { unsigned* bar; unsigned x; volatile LAS unsigned* st; };
DI XcdBarrier xcd_barrier_post(unsigned* bar, volatile LAS unsigned* st) {
  XcdBarrier b; b.bar = bar; b.x = xb_xcc_id(); b.st = st;
  if (threadIdx.x == 0) (void)xb_add(&bar[XB_XCNT(b.x)], 1u);
  return b;
}
DI void xcd_barrier_complete(unsigned* bar, unsigned x, unsigned& nloc, unsigned& nx) {
  const unsigned G = gridDim.x * gridDim.y * gridDim.z;
  unsigned sum, cnt, mine, sp = 0u;
  for (;;) {
    sum = 0u; cnt = 0u; mine = 0u;
#pragma unroll
    for (unsigned j = 0; j < 16; ++j) { const unsigned c = xb_ld(&bar[XB_XCNT(j)]); sum += c; cnt += (c > 0u) ? 1u : 0u; mine = (j == x) ? c : mine; }
    if (sum == G) break;
    __builtin_amdgcn_s_sleep(1);
    if ((++sp & 255u) == 0u) { if (xb_ld(&bar[XB_TMO])) break; if (sp > XB_SPIN_CAP) { atomicAdd(&bar[XB_TMO], 1u); break; } }
  }
  nloc = mine > 0u ? mine : 1u; nx = cnt > 0u ? cnt : 1u;
}
DI void xcd_barrier(const XcdBarrier& b) {
  asm volatile("s_waitcnt vmcnt(0)" ::: "memory");
  __syncthreads();
  if (threadIdx.x == 0) {
    unsigned* bar = b.bar;
    __builtin_amdgcn_s_waitcnt(0);
    unsigned nloc = b.st[0], nx = b.st[1];
    if (nloc == 0u) { xcd_barrier_complete(bar, b.x, nloc, nx); b.st[0] = nloc; b.st[1] = nx; }
    const unsigned old = xb_add(&bar[XB_XSUB(b.x)], 1u);
    const unsigned gen = old / nloc;
    if (old + 1u == (gen + 1u) * nloc) {
      __builtin_amdgcn_fence(__ATOMIC_RELEASE, "agent");
      asm volatile("s_waitcnt vmcnt(0)" ::: "memory");
      const unsigned og = xb_add(&bar[XB_TOP], 1u);
      const unsigned tg = og / nx;
      if (og + 1u == (tg + 1u) * nx) xb_add(&bar[XB_TOPGEN], 1u);
      else XB_SPIN(xb_ld(&bar[XB_TOPGEN]) == tg, bar);
      __builtin_amdgcn_fence(__ATOMIC_ACQUIRE, "agent");
      xb_add(&bar[XB_XGEN(b.x)], 1u);
      asm volatile("s_waitcnt vmcnt(0)" ::: "memory");
    } else {
      XB_SPIN(xb_ld(&bar[XB_XGEN(b.x)]) == gen, bar);
      __builtin_amdgcn_fence(__ATOMIC_ACQUIRE, "agent");
      asm volatile("s_waitcnt vmcnt(0)" ::: "memory");
    }
  }
  __syncthreads();
}

DI f32x2_t dec_lo(unsigned w) { return __builtin_amdgcn_cvt_pk_f32_fp8((int)w, false); }
DI f32x2_t dec_hi(unsigned w) { return __builtin_amdgcn_cvt_pk_f32_fp8((int)w, true); }
#define PCHUNK 16
#define NPCHUNK (NTOK / PCHUNK)
#define DPP_XOR1 0xB1
#define DPP_XOR2 0x4E
#define DPP_HALF_MIRROR 0x141
#define DPP_ROR8 0x128
template <int CTRL> DI int dpp_i(int v) { return __builtin_amdgcn_mov_dpp(v, CTRL, 0xF, 0xF, true); }
template <int CTRL> DI float dpp_f(float v) { return __builtin_bit_cast(float, __builtin_amdgcn_mov_dpp(__builtin_bit_cast(int, v), CTRL, 0xF, 0xF, true)); }
DI void phase4(const MP& p, char* smem) {
  const int lane = threadIdx.x & 63, w = __builtin_amdgcn_readfirstlane(threadIdx.x >> 6), g = lane >> 3, i = lane & 7;
  const unsigned xcc = xb_xcc_id() & 7u;
  const unsigned loff = 16u * (unsigned)i;
  char* stg = smem + w * 8192;
#pragma unroll 1
  for (int s = 0; s < 8; ++s) {
    const int slice = (int)((xcc + s) & 7u);
    unsigned* ctr = p.CTR + (size_t)slice * 64;
    const unsigned char* tbs = p.EU + (size_t)slice * 16384 * 128;
    _Float16* pre = (_Float16*)p.PRE + (size_t)slice * NTOK * 128 + 16 * g + 2 * i;
#pragma unroll 1
    for (;;) {
      unsigned c = 0;
      if (lane == 0) c = atomicAdd(ctr, 1u);
      c = (unsigned)__builtin_amdgcn_readfirstlane((int)c);
      if (c >= NPCHUNK) break;
      const size_t tokb = (size_t)c * PCHUNK;
      {
        const u32x4* ep = (const u32x4*)(p.E16 + tokb * 128) + lane;
        u32x4 ev[4], hv[2], lv[2];
#pragma unroll
        for (int j = 0; j < 4; ++j) ev[j] = ep[64 * j];
#pragma unroll
        for (int j = 0; j < 2; ++j) {
          const size_t xo = (tokb + 8 * j + (lane >> 3)) * 1024 + 128 * slice + loff;
          hv[j] = *(const u32x4*)(p.X8H + xo); lv[j] = *(const u32x4*)(p.X8L + xo);
        }
        __builtin_amdgcn_wave_barrier();
#pragma unroll
        for (int j = 0; j < 4; ++j) *(u32x4*)(stg + 1024 * j + 16 * lane) = ev[j];
#pragma unroll
        for (int j = 0; j < 2; ++j) { *(u32x4*)(stg + 4096 + 1024 * j + 16 * lane) = hv[j]; *(u32x4*)(stg + 6144 + 1024 * j + 16 * lane) = lv[j]; }
        __builtin_amdgcn_wave_barrier();
      }
#pragma unroll 1
      for (int tt = 0; tt < PCHUNK; ++tt) {
        const size_t tok = tokb + tt;
        const u32x4 pw0 = *(const u32x4*)(stg + 256 * tt + 32 * g), pw1 = *(const u32x4*)(stg + 256 * tt + 32 * g + 16);
        const u32x4 xh = *(const u32x4*)(stg + 4096 + 128 * tt + loff), xl = *(const u32x4*)(stg + 6144 + 128 * tt + loff);
        u32x4 ua[16];
#pragma unroll
        for (int k = 0; k < 16; ++k) {
          const unsigned e = __builtin_amdgcn_ubfe(k < 8 ? pw0[(k >> 1) & 3] : pw1[(k >> 1) & 3], 16 * (k & 1), 16);
          ua[k] = *(const u32x4*)(tbs + ((e << 7) | loff));
        }
        int v[16];
#pragma unroll
        for (int k = 0; k < 16; ++k) {
          int ah = 0, al = 0;
#pragma unroll
          for (int q = 0; q < 4; ++q) {
            ah = __builtin_amdgcn_sdot4((int)ua[k][q], (int)xh[q], ah, false);
            al = __builtin_amdgcn_sdot4((int)ua[k][q], (int)xl[q], al, false);
          }
          v[k] = (ah << 7) + al;
        }
        int a8[8], a4[4], a2[2];
        { const bool up = (lane & 4) != 0;
#pragma unroll
          for (int k = 0; k < 8; ++k) { const int keep = up ? v[8 + k] : v[k]; const int send = up ? v[k] : v[8 + k]; a8[k] = keep + dpp_i<DPP_HALF_MIRROR>(send); } }
        { const bool up = (lane & 2) != 0;
#pragma unroll
          for (int k = 0; k < 4; ++k) { const int keep = up ? a8[4 + k] : a8[k]; const int send = up ? a8[k] : a8[4 + k]; a4[k] = keep + dpp_i<DPP_XOR2>(send); } }
        { const bool up = (lane & 1) != 0;
#pragma unroll
          for (int k = 0; k < 2; ++k) { const int keep = up ? a4[2 + k] : a4[k]; const int send = up ? a4[k] : a4[2 + k]; a2[k] = keep + dpp_i<DPP_XOR1>(send); } }
        const float sc = 1.0f / 1048576.f;
        f16x2_t o2 = {(_Float16)((float)a2[0] * sc), (_Float16)((float)a2[1] * sc)};
        *(f16x2_t*)(pre + tok * 128) = o2;
      }
      __builtin_amdgcn_wave_barrier();
    }
  }
}
DI void phase5(const MP& p) {
  const long gtid = (long)blockIdx.x * NTHR + threadIdx.x;
  const long gsz = (long)gridDim.x * NTHR;
#pragma unroll 1
  for (long u = gtid; u < (long)NTOK * 32; u += gsz) {
    const long tok = u >> 5; const int q4 = (int)(u & 31) * 4;
    float4 s = make_float4(0.f, 0.f, 0.f, 0.f);
#pragma unroll
    for (int sl = 0; sl < 8; ++sl) {
      const u32x2 v = *(const u32x2*)((const _Float16*)p.PRE + ((size_t)sl * NTOK + tok) * 128 + q4);
      const f16x2_t v01 = as_h2(v[0]), v23 = as_h2(v[1]);
      s.x += (float)v01[0]; s.y += (float)v01[1]; s.z += (float)v23[0]; s.w += (float)v23[1];
    }
    const float ri = p.RINV2[tok];
    u32x4 pw = *(const u32x4*)(p.PAIRS + tok * 128 + q4);
    float4 a;
    a.x = gelu_f(s.x * ri) * bflo(pw[0]) * 16.f; a.y = gelu_f(s.y * ri) * bflo(pw[1]) * 16.f;
    a.z = gelu_f(s.z * ri) * bflo(pw[2]) * 16.f; a.w = gelu_f(s.w * ri) * bflo(pw[3]) * 16.f;
    int hw = __builtin_amdgcn_cvt_pk_fp8_f32(a.x, a.y, 0, false);
    hw = __builtin_amdgcn_cvt_pk_fp8_f32(a.z, a.w, hw, true);
    const f32x2_t d01 = __builtin_amdgcn_cvt_pk_f32_fp8(hw, false), d23 = __builtin_amdgcn_cvt_pk_f32_fp8(hw, true);
    int lw = __builtin_amdgcn_cvt_pk_fp8_f32((a.x - d01[0]) * 16.f, (a.y - d01[1]) * 16.f, 0, false);
    lw = __builtin_amdgcn_cvt_pk_fp8_f32((a.z - d23[0]) * 16.f, (a.w - d23[1]) * 16.f, lw, true);
    *(int*)(p.ACTH + tok * 128 + q4) = hw;
    *(int*)(p.ACTL + tok * 128 + q4) = lw;
  }
}
typedef int i32x8 __attribute__((ext_vector_type(8)));
struct V6Ctx {
  int lane, g, i, n, kq, bq, sc, tc, rg; bool valid; unsigned loff; unsigned sel[4]; int aoff;
};
DI void v6_load(const V6Ctx& c, u32x4 (&va)[16], u32x4& aw, unsigned*& xrow, const MP& p, const char* stg, const unsigned char* tbs, size_t tok, int tt, int slice) {
  aw = *(const u32x4*)(stg + c.aoff + 128 * tt);
  const u32x4 pw0 = *(const u32x4*)(stg + 256 * tt + 32 * c.g), pw1 = *(const u32x4*)(stg + 256 * tt + 32 * c.g + 16);
#pragma unroll
  for (int k = 0; k < 16; ++k) { const unsigned e = __builtin_amdgcn_ubfe(k < 8 ? pw0[(k >> 1) & 3] : pw1[(k >> 1) & 3], 16 * (k & 1), 16); va[k] = *(const u32x4*)(tbs + ((e << 7) | c.loff)); }
  xrow = (unsigned*)(p.OUTB + tok * 1024 + 128 * slice) + c.lane;
}
DI void v6_mma(const V6Ctx& c, const u32x4 (&va)[16], const u32x4 aw, float* red) {
  i32x8 B0, B1;
#pragma unroll
  for (int r = 0; r < 8; ++r) {
    B0[r] = (int)__builtin_amdgcn_perm(0u, aw[r >> 2], c.sel[r & 3]);
    B1[r] = (int)__builtin_amdgcn_perm(0u, aw[2 + (r >> 2)], c.sel[r & 3]);
  }
  float* dst = c.valid ? (red + (c.tc * 2 + c.sc) * 128 + 64 * (c.rg & 1) + c.bq) : (red + 512 + c.lane);
  const int st = c.valid ? 1 : 0;
#pragma unroll
  for (int q = 0; q < 4; ++q) {
    i32x8 A0, A1;
#pragma unroll
    for (int r = 0; r < 8; ++r) { A0[r] = (int)va[r][q]; A1[r] = (int)va[8 + r][q]; }
    f32x4 z = {0.f, 0.f, 0.f, 0.f};
    z = __builtin_amdgcn_mfma_scale_f32_16x16x128_f8f6f4(A0, B0, z, 0, 0, 0, 0x7f7f7f7f, 0, 0x7f7f7f7f);
    z = __builtin_amdgcn_mfma_scale_f32_16x16x128_f8f6f4(A1, B1, z, 0, 0, 0, 0x7f7f7f7f, 0, 0x7f7f7f7f);
#pragma unroll
    for (int r = 0; r < 4; ++r) {
      float v = z[r];
      asm volatile("" : "+v"(v));
      dst[st * (16 * r + 4 * q)] = v;
    }
  }
}
DI void v6_fin(const V6Ctx& c, const float* red, unsigned* xrow) {
  const f32x2_t h0 = *(const f32x2_t*)(red + 0 * 128 + 2 * c.lane), h1 = *(const f32x2_t*)(red + 1 * 128 + 2 * c.lane);
  const f32x2_t l0 = *(const f32x2_t*)(red + 2 * 128 + 2 * c.lane), l1 = *(const f32x2_t*)(red + 3 * 128 + 2 * c.lane);
  const float o0 = ((h0[0] + h1[0]) + (l0[0] + l1[0]) * (1.0f / 16.f)) * (1.0f / 64.f);
  const float o1 = ((h0[1] + h1[1]) + (l0[1] + l1[1]) * (1.0f / 16.f)) * (1.0f / 64.f);
  *xrow = cvtpk(o0, o1);
}
DI void phase6(const MP& p, char* smem) {
  V6Ctx c;
  c.lane = threadIdx.x & 63;
  const int w = __builtin_amdgcn_readfirstlane(threadIdx.x >> 6);
  c.g = c.lane >> 3; c.i = c.lane & 7; c.n = c.lane & 15; c.kq = c.lane >> 4; c.bq = c.n & 3; c.sc = (c.n >> 2) & 1; c.tc = c.n >> 3; c.rg = c.kq;
  c.loff = 16u * (unsigned)c.i;
  c.valid = ((c.rg >> 1) == c.sc);
#pragma unroll
  for (int j = 0; j < 4; ++j) c.sel[j] = (0x0c0c0c0cu & ~(0xffu << (8 * c.bq))) | ((unsigned)j << (8 * c.bq));
  c.aoff = 4096 + 2048 * c.tc + 16 * (2 * c.kq + c.sc);
  const unsigned xcc = xb_xcc_id() & 7u;
  float* redA = (float*)(smem + w * 4608);
  float* redB = redA + 576;
  char* stg = smem + 8 * 4608 + w * 8192;
#pragma unroll 1
  for (int s = 0; s < 8; ++s) {
    const int slice = (int)((xcc + s) & 7u);
    unsigned* ctr = p.CTR + (size_t)(8 + slice) * 64;
    const unsigned char* tbs = p.EV + (size_t)slice * 16384 * 128;
#pragma unroll 1
    for (;;) {
      unsigned cc = 0;
      if (c.lane == 0) cc = atomicAdd(ctr, 1u);
      cc = (unsigned)__builtin_amdgcn_readfirstlane((int)cc);
      if (cc >= NPCHUNK) break;
      const size_t tokb = (size_t)cc * PCHUNK;
      {
        const u32x4* ep = (const u32x4*)(p.E16 + tokb * 128) + c.lane;
        u32x4 ev[4], ah[2], al[2];
#pragma unroll
        for (int j = 0; j < 4; ++j) ev[j] = ep[64 * j];
#pragma unroll
        for (int j = 0; j < 2; ++j) { ah[j] = ((const u32x4*)(p.ACTH + tokb * 128))[64 * j + c.lane]; al[j] = ((const u32x4*)(p.ACTL + tokb * 128))[64 * j + c.lane]; }
        __builtin_amdgcn_wave_barrier();
#pragma unroll
        for (int j = 0; j < 4; ++j) *(u32x4*)(stg + 1024 * j + 16 * c.lane) = ev[j];
#pragma unroll
        for (int j = 0; j < 2; ++j) { *(u32x4*)(stg + 4096 + 1024 * j + 16 * c.lane) = ah[j]; *(u32x4*)(stg + 6144 + 1024 * j + 16 * c.lane) = al[j]; }
        __builtin_amdgcn_wave_barrier();
      }
#pragma unroll 1
      for (int tt = 0; tt < PCHUNK; tt += 2) {
        u32x4 vaA[16], vaB[16], awA, awB; unsigned *rowA, *rowB;
        v6_load(c, vaA, awA, rowA, p, stg, tbs, tokb + tt, tt, slice);
        v6_load(c, vaB, awB, rowB, p, stg, tbs, tokb + tt + 1, tt + 1, slice);
        v6_mma(c, vaA, awA, redA);
        v6_mma(c, vaB, awB, redB);
        __builtin_amdgcn_wave_barrier();
        v6_fin(c, redA, rowA);
        v6_fin(c, redB, rowB);
        __builtin_amdgcn_wave_barrier();
      }
    }
  }
}
DI void phase7(const MP& p) {
  const int lane = threadIdx.x & 63;
  const int gw = blockIdx.x * (NTHR / 64) + (threadIdx.x >> 6), nw = gridDim.x * (NTHR / 64);
  const float4* fp = (const float4*)p.fg + 4 * lane;
  float4 f[4];
#pragma unroll
  for (int q = 0; q < 4; ++q) f[q] = fp[q];
#pragma unroll 2
  for (int tok = gw; tok < NTOK; tok += nw) {
    const u32x4* xp = (const u32x4*)(p.X2B + (size_t)tok * 1024) + 2 * lane;
    const u32x4* op_ = (const u32x4*)(p.OUTB + (size_t)tok * 1024) + 2 * lane;
    const u32x4 a = xp[0], b = xp[1], oa = op_[0], ob = op_[1];
    float v[16];
#pragma unroll
    for (int q = 0; q < 4; ++q) {
      v[2 * q] = bflo(a[q]) + bflo(oa[q]); v[2 * q + 1] = bfhi(a[q]) + bfhi(oa[q]);
      v[8 + 2 * q] = bflo(b[q]) + bflo(ob[q]); v[8 + 2 * q + 1] = bfhi(b[q]) + bfhi(ob[q]);
    }
    float s = 0.f;
#pragma unroll
    for (int q = 0; q < 16; ++q) s = fmaf(v[q], v[q], s);
    for (int m = 32; m >= 1; m >>= 1) s += __shfl_xor(s, m, 64);
    const float r3 = rsqrtf(s * (1.0f / 1024.f) + 1e-6f);
    float4* op = (float4*)(p.out + (size_t)tok * 1024) + 4 * lane;
#pragma unroll
    for (int q = 0; q < 4; ++q)
      op[q] = make_float4(v[4 * q] * r3 * f[q].x, v[4 * q + 1] * r3 * f[q].y, v[4 * q + 2] * r3 * f[q].z, v[4 * q + 3] * r3 * f[q].w);
  }
}

#define SMEM_BYTES (ATILE_BYTES + 64 * 4 + 8 * 64 * 4)
__global__ void __launch_bounds__(NTHR) k_mega(MP p) {
  __shared__ __attribute__((aligned(16))) char smem[SMEM_BYTES];
  __shared__ uint4 xb_words;
  if (threadIdx.x == 0) xb_words = make_uint4(0u, 0u, 0u, 0u);
  __syncthreads();
  XcdBarrier gb = xcd_barrier_post(p.bar, (volatile LAS unsigned*)&xb_words);
  phase0(p, smem);
  xcd_barrier(gb);
  phase1(p, smem);
  xcd_barrier(gb);
  phase2(p, smem);
  xcd_barrier(gb);
  phase3(p, smem);
  xcd_barrier(gb);
  phase4(p, smem);
  xcd_barrier(gb);
  phase5(p);
  xcd_barrier(gb);
  phase6(p, smem);
  xcd_barrier(gb);
  phase7(p);
}

extern "C" void kernel_launch(void* const* d_in, const int* in_sizes, int n_in, void* d_out, int out_size, void* d_ws, size_t ws_size,
                              hipStream_t stream) {
  float* out = (float*)d_out;
  char* arena1 = (char*)d_ws;
  size_t o1 = 0;
  auto A1 = [&](size_t bytes) { void* r = arena1 + o1; o1 += (bytes + 255) & ~(size_t)255; return r; };
  MP p;
  memset(&p, 0, sizeof(p));
  p.x = (const float*)d_in[0]; p.g1 = (const float*)d_in[1]; p.w_in = (const float*)d_in[2]; p.a_re = (const float*)d_in[3];
  p.a_im = (const float*)d_in[4]; p.log_step = (const float*)d_in[5]; p.b_re = (const float*)d_in[6]; p.b_im = (const float*)d_in[7];
  p.c_re = (const float*)d_in[8]; p.c_im = (const float*)d_in[9]; p.ssm_d = (const float*)d_in[10]; p.w_glu = (const float*)d_in[11];
  p.w_f = (const float*)d_in[12]; p.w_out = (const float*)d_in[13]; p.g2 = (const float*)d_in[14]; p.w_q = (const float*)d_in[15];
  p.keys = (const float*)d_in[16]; p.eu = (const float*)d_in[17]; p.ev = (const float*)d_in[18]; p.fg = (const float*)d_in[19];
  p.out = out;
  p.U = (unsigned short*)A1((size_t)NTOK * 512 * 2);
  p.T = (unsigned short*)A1((size_t)NTOK * 1024 * 2);
  p.YF = (unsigned short*)A1((size_t)NTOK * 512 * 2);
  p.YB = (unsigned short*)A1((size_t)NTOK * 512 * 2);
  p.PAIRS = (unsigned*)A1((size_t)NTOK * 128 * 4);
  p.E16 = (unsigned short*)A1((size_t)NTOK * 128 * 2);
  p.EU = (unsigned char*)A1((size_t)16384 * 1024);
  p.EV = (unsigned char*)A1((size_t)16384 * 1024);
  p.WinF = (bf16x8*)A1((size_t)1024 * 1536 * 2);
  p.WgluF = (bf16x8*)A1((size_t)512 * 512 * 2);
  p.WoutF = (bf16x8*)A1((size_t)1024 * 1024 * 2);
  p.WqkF = (bf16x8*)A1((size_t)1024 * 2048 * 2);
  p.M1F = (bf16x8*)A1((size_t)128 * 128 * 2);
  p.M3T = (unsigned short*)A1((size_t)4096 * 128 * 2);
  p.s5lam = (float*)A1((size_t)64 * 64 * 2 * 4);
  p.s5B = (bf16x8*)A1((size_t)64 * 4 * 64 * 16);
  p.s5C = (bf16x8*)A1((size_t)64 * 4 * 64 * 16);
  p.bar = (unsigned*)A1((size_t)XCD_BAR_WORDS * 4);
  p.CTR = (unsigned*)A1((size_t)16 * 64 * 4);
  (void)hipMemsetAsync(p.bar, 0, (size_t)((char*)(p.CTR + 16 * 64) - (char*)p.bar), stream);
  p.RINV2 = (float*)A1((size_t)NTOK * 4);
  p.OUTB = (unsigned short*)A1((size_t)NTOK * 1024 * 2);
  p.X2B = (unsigned short*)A1((size_t)NTOK * 1024 * 2);
  p.ACTH = (unsigned char*)A1((size_t)NTOK * 128);
  p.ACTL = (unsigned char*)A1((size_t)NTOK * 128);
  p.X8H = (unsigned char*)A1((size_t)NTOK * 1024);
  p.X8L = (unsigned char*)A1((size_t)NTOK * 1024);
  p.PRE = (float*)A1((size_t)8 * NTOK * 128 * 2);
  static int grid_blocks = 0;
  if (!grid_blocks) {
    int dev = 0, cus = 0, per_cu = 0;
    (void)hipGetDevice(&dev);
    (void)hipDeviceGetAttribute(&cus, hipDeviceAttributeMultiprocessorCount, dev);
    (void)hipOccupancyMaxActiveBlocksPerMultiprocessor(&per_cu, k_mega, NTHR, 0);
    if (per_cu < 1) per_cu = 1;
    if (per_cu > 1) per_cu = 1;
    grid_blocks = cus * per_cu;
  }
  void* args[] = {&p};
  hipError_t e = hipLaunchCooperativeKernel((void*)k_mega, dim3(grid_blocks), dim3(NTHR), args, 0, stream);
  if (e != hipSuccess) fprintf(stderr, "cooperative launch failed: %s (grid %d)\n", hipGetErrorString(e), grid_blocks);
}
```

```cpp
#include <hip/hip_runtime.h>
#include <stdint.h>
#include <string.h>
#include <stdio.h>

#define NTOK 65536

__device__ __forceinline__ void dsincos(double x, double* s, double* c) {
  double q = rint(x * 0.63661977236758134308);
  double r = fma(-q, 1.57079632679489655800, x);
  r = fma(-q, 6.12323399573676603587e-17, r);
  double r2 = r * r;
  double sp = r * (1.0 + r2 * (-1.0 / 6 + r2 * (1.0 / 120 + r2 * (-1.0 / 5040 + r2 * (1.0 / 362880 + r2 * (-1.0 / 39916800 + r2 * (1.0 / 6227020800.0 + r2 * (-1.0 / 1307674368000.0))))))));
  double cp = 1.0 + r2 * (-0.5 + r2 * (1.0 / 24 + r2 * (-1.0 / 720 + r2 * (1.0 / 40320 + r2 * (-1.0 / 3628800 + r2 * (1.0 / 479001600.0 + r2 * (-1.0 / 87178291200.0)))))));
  long long qi = (long long)q;
  int m = (int)(qi & 3);
  double ss = (m == 0) ? sp : (m == 1) ? cp : (m == 2) ? -sp : -cp;
  double cc = (m == 0) ? cp : (m == 1) ? -sp : (m == 2) ? -cp : sp;
  *s = ss; *c = cc;
}

typedef short bf16x8 __attribute__((ext_vector_type(8)));
typedef float f32x16 __attribute__((ext_vector_type(16)));
typedef float f32x4 __attribute__((ext_vector_type(4)));
typedef unsigned u32x4 __attribute__((ext_vector_type(4)));
typedef unsigned u32x2 __attribute__((ext_vector_type(2)));
typedef float f32x2_t __attribute__((ext_vector_type(2)));
typedef __bf16 bf16x2_t __attribute__((ext_vector_type(2)));
typedef _Float16 f16x2_t __attribute__((ext_vector_type(2)));
typedef _Float16 f16x8_t __attribute__((ext_vector_type(8)));
__device__ __forceinline__ f16x2_t as_h2(unsigned v) { return __builtin_bit_cast(f16x2_t, v); }
#define DI __device__ __forceinline__
#define MFMA32(a, b, c) __builtin_amdgcn_mfma_f32_32x32x16_bf16((a), (b), (c), 0, 0, 0)
#define MFMA16(a, b, c) __builtin_amdgcn_mfma_f32_16x16x32_bf16((a), (b), (c), 0, 0, 0)
#define NTHR 512
#define ASTRIDE 2064
#define ATILE_BYTES (64 * ASTRIDE)

DI unsigned cvtpk(float lo, float hi) { f32x2_t v = {lo, hi}; bf16x2_t b = __builtin_convertvector(v, bf16x2_t); return __builtin_bit_cast(unsigned, b); }
DI unsigned short f2bf(float x) { return (unsigned short)(cvtpk(x, 0.f) & 0xffffu); }
DI float bf2f(unsigned h) { return __uint_as_float(h << 16); }
DI float bflo(unsigned w) { return __uint_as_float(w << 16); }
DI float bfhi(unsigned w) { return __uint_as_float(w & 0xffff0000u); }
DI int crow(int reg, int h) { return (reg & 3) + 8 * (reg >> 2) + 4 * h; }
DI f32x16 zero16() { f32x16 z; for (int i = 0; i < 16; ++i) z[i] = 0.f; return z; }

struct MP {
  const float *x, *g1, *w_in, *a_re, *a_im, *log_step, *b_re, *b_im, *c_re, *c_im, *ssm_d, *w_glu, *w_f, *w_out, *g2, *w_q, *keys, *eu, *ev, *fg;
  float* out;
  bf16x8 *WinF, *WgluF, *WoutF, *WqkF, *M1F, *s5B, *s5C;
  unsigned short *M3T, *U, *T, *YF, *YB;
  unsigned char *EU, *EV;
  float* s5lam;
  unsigned* PAIRS;
  unsigned short* E16;
  unsigned* bar;
  unsigned* CTR;
  float *RINV2, *PRE;
  unsigned short* OUTB;
  unsigned short* X2B;
  unsigned char *ACTH, *ACTL;
  unsigned char *X8H, *X8L;
};

DI void s5_params(const MP& p, int dg, int pp, float& lr, float& li, double& fr, double& fi) {
  double are = p.a_re[dg * 64 + pp], aim = p.a_im[dg * 64 + pp];
  double step = exp((double)p.log_step[dg]);
  double sn_, cs_;
  dsincos(aim * step, &sn_, &cs_);
  double mag = exp(are * step);
  double lrd = mag * cs_, lid = mag * sn_;
  double nr = lrd - 1.0, ni = lid;
  double den = are * are + aim * aim;
  fr = (nr * are + ni * aim) / den; fi = (ni * are - nr * aim) / den;
  lr = (float)lrd; li = (float)lid;
}

DI int opq(int v) { asm volatile("" : "+v"(v)); return v; }
DI unsigned opqu(unsigned v) { asm volatile("" : "+v"(v)); return v; }
DI unsigned opqs(unsigned v) { asm volatile("" : "+s"(v)); return v; }
DI void fold_dot8(float (&out)[8], const float* __restrict__ w0, size_t wstride, const float* lds, int stride, int n4) {
#pragma unroll
  for (int j = 0; j < 8; ++j) out[j] = 0.f;
#pragma unroll 2
  for (int m4 = 0; m4 < n4; ++m4) {
    const float l0 = lds[(4 * m4) * stride], l1 = lds[(4 * m4 + 1) * stride], l2 = lds[(4 * m4 + 2) * stride], l3 = lds[(4 * m4 + 3) * stride];
#pragma unroll
    for (int j = 0; j < 8; ++j) {
      const float4 wv = ((const float4*)(w0 + j * wstride))[m4];
      out[j] = fmaf(wv.x, l0, out[j]); out[j] = fmaf(wv.y, l1, out[j]); out[j] = fmaf(wv.z, l2, out[j]); out[j] = fmaf(wv.w, l3, out[j]);
    }
  }
}
DI void conv_frag(bf16x8* dst, const float* __restrict__ src, int ld, const float* __restrict__ kscale, int ntiles, int KS, long gtid, long gsz) {
  const long total = (long)ntiles * KS * 64;
#pragma unroll 1
  for (long u = gtid; u < total; u += gsz) {
    int lane = (int)(u & 63);
    long q = u >> 6;
    int ks = (int)(q % KS), nt = (int)(q / KS);
    int n = 32 * nt + (lane & 31), k0 = 16 * ks + 8 * (lane >> 5);
    u32x4 w;
#pragma unroll
    for (int jj = 0; jj < 4; ++jj) {
      int k = k0 + 2 * jj;
      float a = src[(size_t)k * ld + n], b = src[(size_t)(k + 1) * ld + n];
      if (kscale) { a *= kscale[k]; b *= kscale[k + 1]; }
      w[jj] = cvtpk(a, b);
    }
    dst[u] = __builtin_bit_cast(bf16x8, w);
  }
}

DI void late_prep(const MP& p, long gtid, long gsz) {
#pragma unroll 1
  for (long u = gtid; u < 4096 * 128; u += gsz) {
    int s2ri = (int)(u & 127), k = (int)(u >> 7);
    int ri = s2ri >> 6, s2 = s2ri & 63;
    const float rev = (float)((k * s2) & 4095) * (1.0f / 4096.f);
    p.M3T[u] = f2bf(ri ? __builtin_amdgcn_sinf(rev) : __builtin_amdgcn_cosf(rev));
  }
  const long NU = (long)16384 * 1024 / 16;
#pragma unroll 1
  for (long u0 = gtid; u0 < NU; u0 += 2 * gsz) {
    float4 a[2][4], b[2][4];
#pragma unroll
    for (int j = 0; j < 2; ++j) {
      const long u = min(u0 + j * gsz, NU - 1);
      const float4* s = (const float4*)(p.eu + u * 16);
      const float4* s2 = (const float4*)(p.ev + u * 16);
#pragma unroll
      for (int q = 0; q < 4; ++q) { a[j][q] = s[q]; b[j][q] = s2[q]; }
    }
#pragma unroll
    for (int j = 0; j < 2; ++j) {
      const long u = u0 + j * gsz;
      if (u < NU) {
        const int d0 = (int)((u * 16) & 1023);
        const float4* gq = (const float4*)(p.g2 + d0);
        u32x4 ou, ov;
#pragma unroll
        for (int q = 0; q < 4; ++q) {
          const float4 g = gq[q], av = a[j][q], bv = b[j][q];
          const float MG = 12582912.f;
          const float f0 = __builtin_amdgcn_fmed3f(fmaf(av.x * g.x, 1024.f, MG), MG - 127.f, MG + 127.f), f1 = __builtin_amdgcn_fmed3f(fmaf(av.y * g.y, 1024.f, MG), MG - 127.f, MG + 127.f);
          const float f2 = __builtin_amdgcn_fmed3f(fmaf(av.z * g.z, 1024.f, MG), MG - 127.f, MG + 127.f), f3 = __builtin_amdgcn_fmed3f(fmaf(av.w * g.w, 1024.f, MG), MG - 127.f, MG + 127.f);
          ou[q] = __builtin_amdgcn_perm(__float_as_uint(f1), __float_as_uint(f0), 0x0c0c0400u) | __builtin_amdgcn_perm(__float_as_uint(f3), __float_as_uint(f2), 0x04000c0cu);
          int w2 = __builtin_amdgcn_cvt_pk_fp8_f32(bv.x * 4.f, bv.y * 4.f, 0, false);
          w2 = __builtin_amdgcn_cvt_pk_fp8_f32(bv.z * 4.f, bv.w * 4.f, w2, true);
          ov[q] = (unsigned)w2;
        }
        const long e = u >> 6; const int c16 = (int)(u & 63);
        const size_t dst = (((size_t)(c16 >> 3) * 16384 + (size_t)e) * 128) + (size_t)(c16 & 7) * 16;
        *(u32x4*)(p.EU + dst) = ou;
        *(u32x4*)(p.EV + dst) = ov;
      }
    }
  }
}

DI void phase0(const MP& p, char* smem) {
  const int tid = threadIdx.x;
  const long gtid = (long)blockIdx.x * NTHR + tid;
  const long gsz = (long)gridDim.x * NTHR;
  conv_frag(p.WinF, p.w_in, 1024, p.g1, 16, 64, gtid, gsz);
  conv_frag(p.WgluF, p.w_glu, 512, nullptr, 16, 32, gtid, gsz);
  conv_frag(p.WoutF, p.w_out, 1024, nullptr, 32, 64, gtid, gsz);
#pragma unroll 1
  for (long u = gtid; u < 4 * 8 * 64; u += gsz) {
    int lane = (int)(u & 63), ks = (int)((u >> 6) & 7), mt = (int)(u >> 9);
    int row = 32 * mt + (lane & 31), h = lane >> 5;
    int ri = row >> 6, k1 = row & 63;
    u32x4 w;
#pragma unroll
    for (int jj = 0; jj < 4; ++jj) {
      float v2[2];
#pragma unroll
      for (int e = 0; e < 2; ++e) {
        int j = 2 * jj + e;
        int col = 16 * ks + 8 * (j >> 2) + 4 * h + (j & 3);
        int ab = col >> 6, s1 = col & 63;
        double sv, cv;
        dsincos(6.283185307179586476925 * (double)((k1 * s1) & 63) / 64.0, &sv, &cv);
        double val = (ri == 0) ? (ab == 0 ? cv : -sv) : (ab == 0 ? -sv : -cv);
        v2[e] = (float)val;
      }
      w[jj] = cvtpk(v2[0], v2[1]);
    }
    p.M1F[u] = __builtin_bit_cast(bf16x8, w);
  }
#pragma unroll 1
  for (long u = gtid; u < 64 * 64; u += gsz) {
    int pp = (int)(u & 63), dg = (int)(u >> 6);
    float lr, li; double fr, fi;
    s5_params(p, dg, pp, lr, li, fr, fi);
    p.s5lam[u * 2] = lr; p.s5lam[u * 2 + 1] = li;
  }
#pragma unroll 1
  for (long u = gtid; u < 64 * 4 * 64; u += gsz) {
    int lane = (int)(u & 63), nt = (int)((u >> 6) & 3), dg = (int)(u >> 8);
    int col = 32 * nt + (lane & 31), ri = col >> 6, pp = col & 63, h = lane >> 5;
    float lr, li; double fr, fi;
    s5_params(p, dg, pp, lr, li, fr, fi);
    const float* brp = p.b_re + ((size_t)dg * 64 + pp) * 16 + 8 * h;
    const float* bip = p.b_im + ((size_t)dg * 64 + pp) * 16 + 8 * h;
    u32x4 w;
#pragma unroll
    for (int jj = 0; jj < 4; ++jj) {
      double br0 = brp[2 * jj], bi0 = bip[2 * jj], br1 = brp[2 * jj + 1], bi1 = bip[2 * jj + 1];
      float v0 = (float)(ri ? (fr * bi0 + fi * br0) : (fr * br0 - fi * bi0));
      float v1 = (float)(ri ? (fr * bi1 + fi * br1) : (fr * br1 - fi * bi1));
      w[jj] = cvtpk(v0, v1);
    }
    p.s5B[u] = __builtin_bit_cast(bf16x8, w);
  }
#pragma unroll 1
  for (long u = gtid; u < 64 * 4 * 64; u += gsz) {
    int lane = (int)(u & 63), ks = (int)((u >> 6) & 3), dg = (int)(u >> 8);
    int c = lane & 15;
    u32x4 w;
#pragma unroll
    for (int jj = 0; jj < 4; ++jj) {
      int kk = 32 * ks + 8 * (lane >> 4) + 2 * jj;
      int pt = kk >> 6, pq = (kk & 63) >> 1;
      int pp = 32 * pt + pq;
      float vre = p.c_re[((size_t)dg * 16 + c) * 64 + pp];
      float vim = -p.c_im[((size_t)dg * 16 + c) * 64 + pp];
      w[jj] = cvtpk(vre, vim);
    }
    p.s5C[u] = __builtin_bit_cast(bf16x8, w);
  }
  {
    float* AB = (float*)smem;
    float* tab = AB + 128 * 32;
    const float nrm = 1.0f / sqrtf(4096.f * 128.f);
#pragma unroll 1
    for (int task = blockIdx.x; task < 128; task += gridDim.x) {
      int ntp = task >> 2, kq = task & 3;
      int ab = ntp >> 4, chbase = (ntp & 15) * 32, g = chbase >> 7, d0 = chbase & 127;
      __syncthreads();
      if (tid < 128) {
        double sv, cv;
        dsincos(6.283185307179586476925 * (double)tid / 128.0, &sv, &cv);
        tab[tid] = (float)(ab ? sv : cv);
      }
      __syncthreads();
#pragma unroll 1
      for (int o = tid; o < 128 * 32; o += NTHR) {
        int m = o >> 5, dd = o & 31;
        float s = 0.f;
#pragma unroll 4
        for (int c = 0; c < 128; ++c) s = fmaf(tab[(m * c) & 127], p.w_f[((size_t)g * 128 + c) * 128 + d0 + dd], s);
        AB[o] = s * nrm;
      }
      __syncthreads();
#pragma unroll 1
      for (int uu = tid; uu < 16 * 64; uu += NTHR) {
        int lane = uu & 63, ks = kq * 16 + (uu >> 6);
        int dd = lane & 31, h = lane >> 5;
        u32x4 w;
        {
          const int k0 = 16 * ks + 8 * h;
          float sv[8];
          fold_dot8(sv, p.w_in + (size_t)k0 * 1024 + 512 + 128 * g, 1024, AB + dd, 32, 32);
#pragma unroll
          for (int jj = 0; jj < 4; ++jj) w[jj] = cvtpk(sv[2 * jj] * p.g1[k0 + 2 * jj], sv[2 * jj + 1] * p.g1[k0 + 2 * jj + 1]);
        }
        p.WinF[((size_t)(16 + ntp) * 64 + ks) * 64 + lane] = __builtin_bit_cast(bf16x8, w);
      }
    }
  }
  {
    float* Ks = (float*)smem;
#pragma unroll 1
    for (int task = (int)((blockIdx.x + gridDim.x / 2) % gridDim.x); task < 128; task += gridDim.x) {
      int hp = task >> 3, kt = (task >> 1) & 3, chalf = task & 1;
      __syncthreads();
#pragma unroll 1
      for (int o = tid; o < 32 * 128; o += NTHR) {
        int kk = o >> 7, d = o & 127;
        Ks[kk * 129 + d] = p.keys[((size_t)hp * 128 + kt * 32 + kk) * 128 + d];
      }
      __syncthreads();
#pragma unroll 1
      for (int uu = tid; uu < 32 * 64; uu += NTHR) {
        int lane = uu & 63, ks = chalf * 32 + (uu >> 6);
        int kk = lane & 31, h = lane >> 5;
        u32x4 w;
        {
          const int c0 = 16 * ks + 8 * h;
          float sv[8];
          fold_dot8(sv, p.w_q + (size_t)c0 * 2048 + hp * 128, 2048, Ks + kk * 129, 1, 32);
#pragma unroll
          for (int jj = 0; jj < 4; ++jj) w[jj] = cvtpk(sv[2 * jj] * p.g2[c0 + 2 * jj], sv[2 * jj + 1] * p.g2[c0 + 2 * jj + 1]);
        }
        p.WqkF[((size_t)(hp * 4 + kt) * 64 + ks) * 64 + lane] = __builtin_bit_cast(bf16x8, w);
      }
    }
  }
}

#define PD 4
template <int NT, int PDT>
DI void gemm_tile(f32x16 (&acc)[2][NT], const char* atile, int acol0, const bf16x8* __restrict__ wf, int KS, int nks, int lane, int stride2 = 2) {
  const char* abase = atile + (lane & 31) * ASTRIDE + (acol0 + 8 * (lane >> 5)) * 2;
  const char* wbase = (const char*)wf;
  const unsigned loff = (unsigned)lane * 16u;
  unsigned noff[NT];
#pragma unroll
  for (int nt = 0; nt < NT; ++nt) noff[nt] = (unsigned)(((nt & 1) + (nt >> 1) * stride2) * KS) * 1024u;
  bf16x8 bq[PDT][NT];
#pragma unroll
  for (int d = 0; d < PDT; ++d)
#pragma unroll
    for (int nt = 0; nt < NT; ++nt) bq[d][nt] = *(const bf16x8*)(wbase + (noff[nt] + (unsigned)d * 1024u) + loff);
#pragma unroll 1
  for (int ks0 = 0; ks0 < nks; ks0 += PDT) {
#pragma unroll
    for (int d = 0; d < PDT; ++d) {
      const int ks = ks0 + d;
      bf16x8 a0 = *(const bf16x8*)(abase + ks * 32);
      bf16x8 a1 = *(const bf16x8*)(abase + 32 * ASTRIDE + ks * 32);
      bf16x8 b[NT];
#pragma unroll
      for (int nt = 0; nt < NT; ++nt) b[nt] = bq[d][nt];
      const unsigned ksn = (unsigned)min(ks + PDT, nks - 1) * 1024u;
#pragma unroll
      for (int nt = 0; nt < NT; ++nt) bq[d][nt] = *(const bf16x8*)(wbase + (noff[nt] + ksn) + loff);
#pragma unroll
      for (int nt = 0; nt < NT; ++nt) {
        acc[0][nt] = MFMA32(a0, b[nt], acc[0][nt]);
        acc[1][nt] = MFMA32(a1, b[nt], acc[1][nt]);
      }
    }
  }
}

DI bf16x8 pack_step(const f32x16& x, int s) {
  u32x4 w;
  w[0] = cvtpk(x[8 * s + 0], x[8 * s + 1]); w[1] = cvtpk(x[8 * s + 2], x[8 * s + 3]);
  w[2] = cvtpk(x[8 * s + 4], x[8 * s + 5]); w[3] = cvtpk(x[8 * s + 6], x[8 * s + 7]);
  return __builtin_bit_cast(bf16x8, w);
}


template <typename PT>
DI void store_tile_pairs(const float (&vals)[16], PT base, unsigned rs, bool odd) {
#pragma unroll
  for (int r = 0; r < 16; r += 2) {
    const float send = odd ? vals[r] : vals[r + 1];
    const float recv = __builtin_bit_cast(float, __builtin_amdgcn_mov_dpp(__builtin_bit_cast(int, send), 0xB1, 0xF, 0xF, true));
    const float lo = odd ? recv : vals[r];
    const float hi = odd ? vals[r + 1] : recv;
    const int rc = (r & 3) + 8 * (r >> 2);
    *(unsigned*)(base + (size_t)rc * rs) = cvtpk(lo, hi);
  }
}
DI void phase1(const MP& p, char* smem) {
  const int tid = threadIdx.x, w = __builtin_amdgcn_readfirstlane(tid >> 6);
  char* atile = smem;
  float* rinv = (float*)(smem + ATILE_BYTES);
  for (int tt = blockIdx.x; tt < 1024; tt += gridDim.x) {
    const int b = tt >> 6, s2 = 8 * (tt & 7) + ((tt >> 3) & 7);
    const int lane = opq((int)threadIdx.x & 63), h = lane >> 5;
    __syncthreads();
    {
      float4 v[8][4];
#pragma unroll
      for (int rr = 0; rr < 8; ++rr) {
        const float4* xp = (const float4*)(p.x + ((size_t)b * 4096 + 64 * (w * 8 + rr) + s2) * 1024);
#pragma unroll
        for (int i = 0; i < 4; ++i) v[rr][i] = xp[lane + 64 * i];
      }
#pragma unroll
      for (int rr = 0; rr < 8; ++rr) {
        const int r = w * 8 + rr;
        float s = 0.f;
#pragma unroll
        for (int i = 0; i < 4; ++i) s += v[rr][i].x * v[rr][i].x + v[rr][i].y * v[rr][i].y + v[rr][i].z * v[rr][i].z + v[rr][i].w * v[rr][i].w;
        for (int m = 32; m >= 1; m >>= 1) s += __shfl_xor(s, m, 64);
        if (lane == 0) rinv[r] = rsqrtf(s * (1.0f / 1024.f) + 1e-6f);
#pragma unroll
        for (int i = 0; i < 4; ++i) {
          u32x2 pk; pk[0] = cvtpk(v[rr][i].x, v[rr][i].y); pk[1] = cvtpk(v[rr][i].z, v[rr][i].w);
          *(u32x2*)(atile + r * ASTRIDE + (lane + 64 * i) * 8) = pk;
        }
      }
    }
    __syncthreads();
    {
      f32x16 acc[2][2];
#pragma unroll
      for (int i = 0; i < 2; ++i)
#pragma unroll
        for (int j = 0; j < 2; ++j) acc[i][j] = zero16();
      gemm_tile<2, 4>(acc, atile, 0, p.WinF + (size_t)(2 * w) * 64 * 64, 64, 64, lane);
      {
        const bool odd = (lane & 1) != 0;
        const unsigned ubase = (unsigned)((((size_t)((b >> 1) * 32 + 4 * w + ((lane & 31) >> 4)) * 4096 + s2 + 64 * (4 * h + (odd ? 1 : 0))) * 32 + (b & 1) * 16 + ((lane & 15) & ~1)) * 2);
#pragma unroll
        for (int mt = 0; mt < 2; ++mt)
#pragma unroll
          for (int nt = 0; nt < 2; ++nt) {
            const unsigned tb = opqu(ubase + (unsigned)((32 * mt * 64 * 32 + 2 * nt * 4096 * 32) * 2));
            const float* rvp = rinv + opq(32 * mt + 4 * h);
            float vals[16];
#pragma unroll
            for (int r = 0; r < 16; ++r) vals[r] = acc[mt][nt][r] * rvp[(r & 3) + 8 * (r >> 2)];
            store_tile_pairs(vals, (char*)p.U + tb, 64u * 32u * 2u, odd);
          }
      }
    }
    {
      bf16x8 xs[8][2];
      {
        f32x16 acc[2][4];
#pragma unroll
        for (int i = 0; i < 2; ++i)
#pragma unroll
          for (int j = 0; j < 4; ++j) acc[i][j] = zero16();
        gemm_tile<4, 2>(acc, atile, 0, p.WinF + (size_t)(16 + 2 * w) * 64 * 64, 64, 64, opq(lane), 16);
#pragma unroll
        for (int mt = 0; mt < 2; ++mt) {
#pragma unroll
          for (int c = 0; c < 4; ++c) {
            const float* rvp = rinv + opq(32 * mt + 4 * h);
#pragma unroll
            for (int r = 0; r < 16; ++r) acc[mt][c][r] *= rvp[(r & 3) + 8 * (r >> 2)];
            const int ab = c >> 1, nt = c & 1;
            xs[ab * 4 + mt * 2 + 0][nt] = pack_step(acc[mt][c], 0);
            xs[ab * 4 + mt * 2 + 1][nt] = pack_step(acc[mt][c], 1);
          }
        }
      }
#pragma unroll
      for (int mt = 0; mt < 4; ++mt) {
        f32x16 t0 = zero16(), t1 = zero16();
        const bf16x8* mf = p.M1F + (size_t)(opq(mt * 8)) * 64 + lane;
#pragma unroll
        for (int ks = 0; ks < 8; ++ks) {
          bf16x8 a = mf[ks * 64];
          t0 = MFMA32(a, xs[ks][0], t0);
          t1 = MFMA32(a, xs[ks][1], t1);
        }
        const int ri = mt >> 1;
        const bool odd = (lane & 1) != 0;
        const unsigned tbase = opqu((unsigned)(((((size_t)b * 64 + 32 * (mt & 1) + 4 * h + (odd ? 1 : 0)) * 128 + ri * 64 + s2) * 512 + 64 * w + ((lane & 31) & ~1)) * 2));
        float v0[16], v1[16];
#pragma unroll
        for (int r = 0; r < 16; ++r) { v0[r] = t0[r]; v1[r] = t1[r]; }
        store_tile_pairs(v0, (char*)p.T + tbase, 128u * 512u * 2u, odd);
        store_tile_pairs(v1, (char*)p.T + tbase + 64, 128u * 512u * 2u, odd);
      }
    }
  }
}

#define XS_STRIDE 336
#define XS_BYTES (32 * XS_STRIDE)
#define UPF 8
typedef volatile __attribute__((address_space(3))) int* ldsflag_t;
DI void flag_wait(ldsflag_t f, int target) { while (*f < target) __builtin_amdgcn_s_sleep(1); asm volatile("" ::: "memory"); }
DI void flag_set(ldsflag_t f, int v) { asm volatile("" ::: "memory"); *f = v; asm volatile("" ::: "memory"); }
DI void phase2(const MP& p, char* smem) {
  const int tid = threadIdx.x, lane = tid & 63, w = __builtin_amdgcn_readfirstlane(tid >> 6), h = lane >> 5;
  ldsflag_t flags = (ldsflag_t)(smem + 4 * XS_BYTES);
  if (tid < 8) flags[tid] = 0;
  *(u32x4*)(smem + (tid >> 2) * XS_STRIDE + 256 + 16 * (tid & 3)) = u32x4{0u, 0u, 0u, 0u};
  __syncthreads();
  if (w >= 6) {
    late_prep(p, ((long)blockIdx.x * 2 + (w - 6)) * 64 + lane, (long)gridDim.x * 2 * 64);
    return;
  }
  const int slot = (w < 4) ? (w >> 1) : (w - 4), role = (w < 4) ? (w & 1) : 2;
  ldsflag_t fA0 = flags + 3 * slot, fA1 = fA0 + 1, fB = fA0 + 2;
  char* xt = smem + slot * 2 * XS_BYTES;
  int round = 0;
#pragma unroll 1
  for (int t0 = blockIdx.x * 2; t0 < 512; t0 += gridDim.x * 2, ++round) {
    const int task = t0 + slot;
    if (task >= 512) break;
    const int dir = task & 1, bp = (task >> 1) & 7, g = (task >> 4) & 31;
    const int dg = dir * 32 + g;
    const int base = round * 256;
    if (role < 2) {
      const int pt = role;
      const bf16x8 bf_re = p.s5B[(size_t)(dg * 4 + 0 + pt) * 64 + lane], bf_im = p.s5B[(size_t)(dg * 4 + 2 + pt) * 64 + lane];
      const int pp = 32 * pt + (lane & 31);
      const float lr = p.s5lam[((size_t)dg * 64 + pp) * 2], li = p.s5lam[((size_t)dg * 64 + pp) * 2 + 1];
      const int rho = lane & 31;
      const int hr = (rho >> 2) & 1, rr = (rho & 3) + 4 * (rho >> 3);
      const size_t ubase = ((size_t)(bp * 32 + g) * 4096) * 32 + hr * 16 + 8 * h;
      float xr = 0.f, xi = 0.f;
      const float nli = -li;
      bf16x8 aq[UPF];
#pragma unroll
      for (int d = 0; d < UPF; ++d) { int q = 16 * d + rr; int tpos = dir ? (4095 - q) : q; aq[d] = *(const bf16x8*)(p.U + ubase + (size_t)tpos * 32); }
      ldsflag_t fmine = pt ? fA1 : fA0;
      f32x16 bacc[2][2];
      bacc[0][0] = MFMA32(aq[0], bf_re, zero16());
      bacc[0][1] = MFMA32(aq[0], bf_im, zero16());
      bf16x8 uc = aq[0];
      const unsigned uoff = (unsigned)((hr * 16 + rr) * XS_STRIDE + 256 + 16 * h);
      { int q = 16 * UPF + rr; int tpos = dir ? (4095 - q) : q; aq[0] = *(const bf16x8*)(p.U + ubase + (size_t)tpos * 32); }
#pragma unroll 1
      for (int step0 = 0; step0 < 256; step0 += UPF) {
#pragma unroll
        for (int d = 0; d < UPF; ++d) {
          const int step = step0 + d;
          const int cur = d & 1, nxt = cur ^ 1, sl = (d + 1) & (UPF - 1);
          const bf16x8 un = aq[sl];
          bacc[nxt][0] = MFMA32(un, bf_re, zero16());
          bacc[nxt][1] = MFMA32(un, bf_im, zero16());
          { int q = 16 * min(step + 1 + UPF, 255) + rr; int tpos = dir ? (4095 - q) : q; aq[sl] = *(const bf16x8*)(p.U + ubase + (size_t)tpos * 32); }
          flag_wait(fB, base + step - 1);
          char* xrow = xt + (d & 1) * XS_BYTES + (h * 16) * XS_STRIDE + (pt * 64 + 2 * (lane & 31)) * 2;
          if (pt == 0) *(bf16x8*)(xt + (d & 1) * XS_BYTES + uoff) = uc;
          uc = un;
#pragma unroll
          for (int r = 0; r < 16; ++r) {
            float ir = fmaf(nli, xi, bacc[cur][0][r]);
            float ii = fmaf(li, xr, bacc[cur][1][r]);
            asm volatile("" : "+v"(ir));
            asm volatile("" : "+v"(ii));
            float nr = fmaf(lr, xr, ir);
            float ni = fmaf(lr, xi, ii);
            asm volatile("" : "+v"(nr));
            asm volatile("" : "+v"(ni));
            xr = nr; xi = ni;
            *(unsigned*)(xrow + r * XS_STRIDE) = cvtpk(xr, xi);
          }
          flag_set(fmine, base + step + 1);
        }
      }
    } else {
      bf16x8 cf[5];
#pragma unroll
      for (int ks = 0; ks < 4; ++ks) cf[ks] = p.s5C[(size_t)(dg * 4 + ks) * 64 + lane];
      {
        const float dv = dir ? 0.f : p.ssm_d[g * 16 + (lane & 15)];
        u32x4 cw;
#pragma unroll
        for (int q = 0; q < 4; ++q) {
          const int k0 = 8 * (lane >> 4) + 2 * q;
          cw[q] = cvtpk(k0 == (lane & 15) ? dv : 0.f, k0 + 1 == (lane & 15) ? dv : 0.f);
        }
        cf[4] = __builtin_bit_cast(bf16x8, cw);
      }
      unsigned short* yo = dir ? p.YB : p.YF;
      const bool odd = (lane & 1) != 0;
      const unsigned xoff = (unsigned)((lane & 15) * XS_STRIDE + (8 * (lane >> 4)) * 2);
      auto fetch = [&](bf16x8 (&xa)[2][5], int step) {
        flag_wait(fA0, base + step + 1);
        flag_wait(fA1, base + step + 1);
        const char* xb = xt + (step & 1) * XS_BYTES + xoff;
#pragma unroll
        for (int mt = 0; mt < 2; ++mt)
#pragma unroll
          for (int ks = 0; ks < 5; ++ks) xa[mt][ks] = *(const bf16x8*)(xb + (mt * 16) * XS_STRIDE + (32 * ks) * 2);
        flag_set(fB, base + step + 1);
      };
      auto mma = [&](const bf16x8 (&xa)[2][5], f32x4 (&y)[2]) {
#pragma unroll
        for (int mt = 0; mt < 2; ++mt) y[mt] = f32x4{0.f, 0.f, 0.f, 0.f};
#pragma unroll
        for (int ks = 0; ks < 5; ++ks)
#pragma unroll
          for (int mt = 0; mt < 2; ++mt) y[mt] = MFMA16(xa[mt][ks], cf[ks], y[mt]);
      };
      auto emit = [&](const f32x4 (&y)[2], int step) {
#pragma unroll
        for (int mt = 0; mt < 2; ++mt)
#pragma unroll
          for (int r = 0; r < 4; r += 2) {
            const float send = odd ? y[mt][r] : y[mt][r + 1];
            const float recv = __builtin_bit_cast(float, __builtin_amdgcn_mov_dpp(__builtin_bit_cast(int, send), 0xB1, 0xF, 0xF, true));
            const float lo = odd ? recv : y[mt][r], hi = odd ? y[mt][r + 1] : recv;
            const int q = 16 * step + 4 * (lane >> 4) + r + (odd ? 1 : 0);
            const int tpos = dir ? (4095 - q) : q;
            *(unsigned*)(yo + ((size_t)(2 * bp + mt) * 4096 + tpos) * 512 + g * 16 + ((lane & 15) & ~1)) = cvtpk(lo, hi);
          }
      };
      bf16x8 xe[2][5], xo[2][5];
      f32x4 ye[2], yd[2];
      fetch(xe, 0);
      mma(xe, ye);
      fetch(xo, 1);
#pragma unroll 1
      for (int step = 1; step < 255; step += 2) {
        mma(xo, yd);
        emit(ye, step - 1);
        fetch(xe, step + 1);
        mma(xe, ye);
        emit(yd, step);
        fetch(xo, step + 2);
      }
      mma(xo, yd);
      emit(ye, 254);
      emit(yd, 255);
    }
  }
}

DI int f2key(float f) { return __float_as_int(__builtin_amdgcn_fmed3f(f, -60.f, 60.f) + 64.f); }
DI float key2f(int k) { return __int_as_float(k) - 64.f; }
#define CE_DESC(a, b) { int mx_ = max(a, b), mn_ = min(a, b); a = mx_; b = mn_; }
#define CE_ASC(a, b) { int mx_ = max(a, b), mn_ = min(a, b); a = mn_; b = mx_; }

#define S16(i, j) CE_DESC(v[i], v[j])
DI void sort16_desc(int (&v)[16]) {
  S16(0,13) S16(1,12) S16(2,15) S16(3,14) S16(4,8) S16(5,6) S16(7,11) S16(9,10)
  S16(0,5) S16(1,7) S16(2,9) S16(3,4) S16(6,13) S16(8,14) S16(10,15) S16(11,12)
  S16(0,1) S16(2,3) S16(4,5) S16(6,8) S16(7,9) S16(10,11) S16(12,13) S16(14,15)
  S16(0,2) S16(1,3) S16(4,10) S16(5,11) S16(6,7) S16(8,9) S16(12,14) S16(13,15)
  S16(1,2) S16(3,12) S16(4,6) S16(5,7) S16(8,10) S16(9,11) S16(13,14)
  S16(1,4) S16(2,6) S16(5,8) S16(7,10) S16(9,13) S16(11,14)
  S16(2,4) S16(3,6) S16(9,12) S16(11,13)
  S16(3,5) S16(6,8) S16(7,9) S16(10,12)
  S16(3,4) S16(5,6) S16(7,8) S16(9,10) S16(11,12)
  S16(6,7) S16(8,9)
}
DI void merge16_desc(int (&a)[16], const int (&b)[16]) {
#pragma unroll
  for (int i = 0; i < 16; ++i) a[i] = max(a[i], b[15 - i]);
#pragma unroll
  for (int j = 8; j > 0; j >>= 1) {
#pragma unroll
    for (int i = 0; i < 16; ++i) {
      const int l = i ^ j;
      if (l > i) { CE_DESC(a[i], a[l]); }
    }
  }
}
DI void top16_of_64(const int (&k)[64], int (&out)[16]) {
  int g1[16], g2[16], g3[16];
#pragma unroll
  for (int i = 0; i < 16; ++i) { out[i] = k[i]; g1[i] = k[16 + i]; g2[i] = k[32 + i]; g3[i] = k[48 + i]; }
  sort16_desc(out); sort16_desc(g1); sort16_desc(g2); sort16_desc(g3);
  merge16_desc(out, g1); merge16_desc(g2, g3); merge16_desc(out, g2);
}

DI float reduce_scatter32(float (&v)[32], int lane) {
  float a[16];
  {
    const bool up = (lane & 16) != 0;
#pragma unroll
    for (int i = 0; i < 16; ++i) { float keep = up ? v[16 + i] : v[i]; float send = up ? v[i] : v[16 + i]; a[i] = keep + __shfl_xor(send, 16, 64); }
  }
  float b[8];
  {
    const bool up = (lane & 8) != 0;
#pragma unroll
    for (int i = 0; i < 8; ++i) { float keep = up ? a[8 + i] : a[i]; float send = up ? a[i] : a[8 + i]; b[i] = keep + __shfl_xor(send, 8, 64); }
  }
  float c[4];
  {
    const bool up = (lane & 4) != 0;
#pragma unroll
    for (int i = 0; i < 4; ++i) { float keep = up ? b[4 + i] : b[i]; float send = up ? b[i] : b[4 + i]; c[i] = keep + __shfl_xor(send, 4, 64); }
  }
  float d[2];
  {
    const bool up = (lane & 2) != 0;
#pragma unroll
    for (int i = 0; i < 2; ++i) { float keep = up ? c[2 + i] : c[i]; float send = up ? c[i] : c[2 + i]; d[i] = keep + __shfl_xor(send, 2, 64); }
  }
  {
    const bool up = (lane & 1) != 0;
    float keep = up ? d[1] : d[0]; float send = up ? d[0] : d[1];
    return keep + __shfl_xor(send, 1, 64);
  }
}
DI float reduce_scatter64(float (&v)[64], int lane) {
  float a[32];
  const bool up = (lane & 32) != 0;
#pragma unroll
  for (int i = 0; i < 32; ++i) { float keep = up ? v[32 + i] : v[i]; float send = up ? v[i] : v[32 + i]; a[i] = keep + __shfl_xor(send, 32, 64); }
  return reduce_scatter32(a, lane);
}

__host__ __device__ constexpr int cand_ij(int c) {
  int n = 0;
  for (int a = 0; a < 16; ++a)
    for (int b = 0; b < 16; ++b)
      if ((a + 1) * (b + 1) <= 16) { if (n == c) return a * 16 + b; ++n; }
  return 0;
}
__host__ __device__ constexpr int cand_index(int i, int j) {
  int n = 0;
  for (int a = 0; a < 16; ++a)
    for (int b = 0; b < 16; ++b)
      if ((a + 1) * (b + 1) <= 16) { if (a == i && b == j) return n; ++n; }
  return n;
}
static_assert(cand_index(15, 0) == 49, "50 candidates");
DI float erf_as(float z) {
  const float az = fabsf(z);
  const float t = __builtin_amdgcn_rcpf(fmaf(0.3275911f, az, 1.0f));
  float pl = fmaf(1.061405429f, t, -1.453152027f);
  pl = fmaf(pl, t, 1.421413741f);
  pl = fmaf(pl, t, -0.284496736f);
  pl = fmaf(pl, t, 0.254829592f);
  pl *= t;
  const float ex = __expf(-az * az);
  const float r = fmaf(-pl, ex, 1.0f);
  return copysignf(r, z);
}
DI float gelu_f(float x) { return 0.5f * x * (1.0f + erf_as(x * 0.70710678118654752440f)); }

DI void phase3(const MP& p, char* smem) {
  const int tid = threadIdx.x, lane = tid & 63, w = __builtin_amdgcn_readfirstlane(tid >> 6), h = lane >> 5;
  char* atile = smem;
  float* rinv2 = (float*)(smem + ATILE_BYTES);
  float* part = rinv2 + 64;
  for (int tt = blockIdx.x; tt < 1024; tt += gridDim.x) {
    const int b = tt >> 6, k1 = tt & 63;
    const size_t tok0 = (size_t)b * 4096 + k1;
    __syncthreads();
#pragma unroll
    for (int it = 0; it < 8; ++it) {
      int chunk = opq(tid + NTHR * it);
      int r = chunk >> 6, c8 = chunk & 63;
      size_t off = (tok0 + 64 * (size_t)r) * 512 + c8 * 8;
      u32x4 yf = *(const u32x4*)(p.YF + off), yb = *(const u32x4*)(p.YB + off);
      u32x4 o;
#pragma unroll
      for (int q = 0; q < 4; ++q) {
        float lo = bflo(yf[q]) + bflo(yb[q]);
        float hi = bfhi(yf[q]) + bfhi(yb[q]);
        o[q] = cvtpk(gelu_f(lo), gelu_f(hi));
      }
      *(u32x4*)(atile + r * ASTRIDE + c8 * 16) = o;
    }
    __syncthreads();
    f32x16 gacc[2][2];
#pragma unroll
    for (int i = 0; i < 2; ++i)
#pragma unroll
      for (int j = 0; j < 2; ++j) gacc[i][j] = zero16();
    gemm_tile<2, 4>(gacc, atile, 0, p.WgluF + (size_t)(2 * w) * 32 * 64, 32, 32, opq(lane));
    {
      f32x16 facc[2][2];
#pragma unroll
      for (int i = 0; i < 2; ++i)
#pragma unroll
        for (int j = 0; j < 2; ++j) facc[i][j] = zero16();
      const int lnf = opq(lane);
      const unsigned short* m3 = p.M3T + ((size_t)k1 + 64 * (size_t)(lnf & 31)) * 128 + 8 * (lnf >> 5);
      const unsigned short* tb = p.T + (((size_t)b * 64 + k1) * 128 + 8 * (lnf >> 5)) * 512 + 64 * w + (lnf & 31);
#pragma unroll 4
      for (int ks = 0; ks < 8; ++ks) {
        bf16x8 a0 = *(const bf16x8*)(m3 + 16 * ks);
        bf16x8 a1 = *(const bf16x8*)(m3 + (size_t)32 * 64 * 128 + 16 * ks);
        bf16x8 b0, b1;
#pragma unroll
        for (int j = 0; j < 8; ++j) {
          b0[j] = (short)tb[((size_t)16 * ks + j) * 512];
          b1[j] = (short)tb[((size_t)16 * ks + j) * 512 + 32];
        }
        facc[0][0] = MFMA32(a0, b0, facc[0][0]); facc[1][0] = MFMA32(a1, b0, facc[1][0]);
        facc[0][1] = MFMA32(a0, b1, facc[0][1]); facc[1][1] = MFMA32(a1, b1, facc[1][1]);
      }
#pragma unroll
      for (int mt = 0; mt < 2; ++mt)
#pragma unroll
        for (int nt = 0; nt < 2; ++nt)
#pragma unroll
          for (int r = 0; r < 16; ++r) {
            int row = 32 * mt + crow(r, lnf >> 5), col = 512 + 64 * w + 32 * nt + (lnf & 31);
            *(unsigned short*)(atile + row * ASTRIDE + col * 2) = f2bf(facc[mt][nt][r]);
          }
    }
    __syncthreads();
    {
    const int lng = opq(lane);
#pragma unroll
    for (int mt = 0; mt < 2; ++mt)
#pragma unroll
      for (int nt = 0; nt < 2; ++nt)
#pragma unroll
        for (int r = 0; r < 16; ++r) {
          int row = 32 * mt + crow(r, lng >> 5), col = 64 * w + 32 * nt + (lng & 31);
          unsigned short* q = (unsigned short*)(atile + row * ASTRIDE + col * 2);
          float yv = bf2f(*q);
          *q = f2bf(yv / (1.0f + __expf(-gacc[mt][nt][r])));
        }
    }
    __syncthreads();
    {
      f32x16 acc[2][4];
#pragma unroll
      for (int i = 0; i < 2; ++i)
#pragma unroll
        for (int j = 0; j < 4; ++j) acc[i][j] = zero16();
      float pfx[4];
      {
        const int t_ = opq(tid);
#pragma unroll
        for (int q = 0; q < 4; ++q) { const int ln = t_ + NTHR * q; pfx[q] = p.x[(tok0 + 64 * (size_t)(ln >> 5)) * 1024 + (ln & 31) * 32]; }
      }
      gemm_tile<4, 2>(acc, atile, 0, p.WoutF + (size_t)(4 * w) * 64 * 64, 64, 64, opq(lane));
      asm volatile("" :: "v"(pfx[0]), "v"(pfx[1]), "v"(pfx[2]), "v"(pfx[3]));
      __syncthreads();
      float ss[32];
#pragma unroll
      for (int i = 0; i < 32; ++i) ss[i] = 0.f;
      {
        const int lnd = opq(lane);
        const unsigned gbase = (unsigned)(((tok0 + 256 * (lnd >> 5)) * 1024 + 128 * w + (lnd & 31)) * 4);
#pragma unroll
        for (int mt = 0; mt < 2; ++mt)
#pragma unroll
          for (int nt = 0; nt < 4; ++nt) {
            const unsigned gb = opqu(gbase + (unsigned)((32 * mt * 64 * 1024 + 32 * nt) * 4));
            const bool odd = (lnd & 1) != 0;
            char* lb = atile + opq((32 * mt + 4 * (lnd >> 5) + (odd ? 1 : 0)) * ASTRIDE + (128 * w + 32 * nt + ((lnd & 31) & ~1)) * 2);
#pragma unroll
            for (int r = 0; r < 16; r += 2) {
              const int rc = (r & 3) + 8 * (r >> 2);
              const unsigned go0 = gb + (unsigned)(rc * 64 * 1024 * 4), go1 = gb + (unsigned)((rc + 1) * 64 * 1024 * 4);
              const float v0 = *(const float*)((const char*)p.x + go0) + acc[mt][nt][r];
              const float v1 = *(const float*)((const char*)p.x + go1) + acc[mt][nt][r + 1];
              ss[mt * 16 + r] = fmaf(v0, v0, ss[mt * 16 + r]);
              ss[mt * 16 + r + 1] = fmaf(v1, v1, ss[mt * 16 + r + 1]);
              const float send = odd ? v0 : v1;
              const float recv = __builtin_bit_cast(float, __builtin_amdgcn_mov_dpp(__builtin_bit_cast(int, send), 0xB1, 0xF, 0xF, true));
              *(unsigned*)(lb + rc * ASTRIDE) = cvtpk(odd ? recv : v0, odd ? v1 : recv);
            }
          }
      }
      float tot = reduce_scatter32(ss, lane);
      {
        int L = lane & 31;
        part[w * 64 + 32 * (L >> 4) + crow(L & 15, h)] = tot;
      }
    }
    __syncthreads();
#pragma unroll 4
    for (int it = 0; it < 16; ++it) {
      const int chunk = opq(tid + NTHR * it);
      const int r = chunk >> 7, c8 = chunk & 127;
      const u32x4 xb = *(const u32x4*)(atile + r * ASTRIDE + c8 * 16);
      const size_t go = (tok0 + 64 * (size_t)r) * 1024 + c8 * 8;
      *(u32x4*)(p.X2B + go) = xb;
      unsigned hw[2], lw[2];
#pragma unroll
      for (int q = 0; q < 2; ++q) {
        hw[q] = 0u; lw[q] = 0u;
#pragma unroll
        for (int e = 0; e < 4; ++e) {
          const unsigned wv = xb[2 * q + (e >> 1)];
          const float x8 = ((e & 1) ? bfhi(wv) : bflo(wv)) * 8.f;
          const float hf = rintf(__builtin_amdgcn_fmed3f(x8, -127.f, 127.f));
          const float lf = rintf(__builtin_amdgcn_fmed3f((x8 - hf) * 128.f, -127.f, 127.f));
          hw[q] |= ((unsigned)((int)hf & 0xff)) << (8 * e);
          lw[q] |= ((unsigned)((int)lf & 0xff)) << (8 * e);
        }
      }
      u32x2 hv = {hw[0], hw[1]}, lv = {lw[0], lw[1]};
      *(u32x2*)(p.X8H + go) = hv;
      *(u32x2*)(p.X8L + go) = lv;
    }
    if (tid < 64) {
      float s = 0.f;
#pragma unroll
      for (int i = 0; i < 8; ++i) s += part[i * 64 + tid];
      rinv2[tid] = rsqrtf(s * (1.0f / 1024.f) + 1e-6f);
    }
    __syncthreads();
    int sk[2][16];
#pragma unroll
    for (int pq = 0; pq < 2; ++pq) {
      int run[2][16];
#pragma unroll
      for (int half = 0; half < 2; ++half) {
        f32x16 acc[2][2];
#pragma unroll
        for (int i = 0; i < 2; ++i)
#pragma unroll
          for (int j = 0; j < 2; ++j) acc[i][j] = zero16();
        {
          const int ln = opq(lane);
          const char* bbase = atile + (ln & 31) * ASTRIDE + (8 * (ln >> 5)) * 2;
          const char* wq = (const char*)(p.WqkF + (size_t)(8 * w + 4 * pq + 2 * half) * 64 * 64);
          const unsigned loff = (unsigned)ln * 16u;
          bf16x8 aq[PD][2];
#pragma unroll
          for (int d = 0; d < PD; ++d) { aq[d][0] = *(const bf16x8*)(wq + (unsigned)d * 1024u + loff); aq[d][1] = *(const bf16x8*)(wq + (unsigned)(64 + d) * 1024u + loff); }
#pragma unroll 1
          for (int ks0 = 0; ks0 < 64; ks0 += PD) {
#pragma unroll
            for (int d = 0; d < PD; ++d) {
              const int ks = ks0 + d;
              bf16x8 x0 = *(const bf16x8*)(bbase + ks * 32);
              bf16x8 x1 = *(const bf16x8*)(bbase + 32 * ASTRIDE + ks * 32);
              bf16x8 a0 = aq[d][0], a1 = aq[d][1];
              const unsigned ksn = opqs((unsigned)min(ks + PD, 63) * 1024u);
              aq[d][0] = *(const bf16x8*)(wq + ksn + loff); aq[d][1] = *(const bf16x8*)(wq + (ksn + 65536u) + loff);
              acc[0][0] = MFMA32(a0, x0, acc[0][0]); acc[0][1] = MFMA32(a0, x1, acc[0][1]);
              acc[1][0] = MFMA32(a1, x0, acc[1][0]); acc[1][1] = MFMA32(a1, x1, acc[1][1]);
            }
          }
        }
#pragma unroll
        for (int nt = 0; nt < 2; ++nt) {
#pragma unroll
          for (int mt = 0; mt < 2; ++mt) {
            int g[16];
            const int hb = opq(4 * h);
#pragma unroll
            for (int r = 0; r < 16; ++r) g[r] = (f2key(acc[mt][nt][r]) & ~0x7f) | (32 * (2 * half + mt) + (r & 3) + 8 * (r >> 2)) | hb;
            sort16_desc(g);
            if (half == 0 && mt == 0) {
#pragma unroll
              for (int i = 0; i < 16; ++i) run[nt][i] = g[i];
            } else {
              merge16_desc(run[nt], g);
            }
          }
        }
      }
      {
        int mine[16], other[16];
#pragma unroll
        for (int i = 0; i < 16; ++i) {
          const int give = h ? run[0][i] : run[1][i];
          mine[i] = h ? run[1][i] : run[0][i];
          other[i] = __shfl_xor(give, 32, 64);
        }
        merge16_desc(mine, other);
#pragma unroll
        for (int i = 0; i < 16; ++i) sk[pq][i] = mine[i];
      }
    }
    {
      float v0[16], v1[16];
      unsigned i0p[4], i1p[4];
      {
        int s0[16], s1[16];
#pragma unroll
        for (int i = 0; i < 16; ++i) { s0[i] = sk[0][i]; s1[i] = sk[1][i]; }
        const float sc = rinv2[32 * h + (lane & 31)];
#pragma unroll
        for (int i = 0; i < 16; ++i) { v0[i] = key2f(s0[i] & ~0x7f) * sc; v1[i] = key2f(s1[i] & ~0x7f) * sc; }
#pragma unroll
        for (int q = 0; q < 4; ++q) {
          i0p[q] = (unsigned)(s0[4 * q] & 0x7f) | ((unsigned)(s0[4 * q + 1] & 0x7f) << 8) | ((unsigned)(s0[4 * q + 2] & 0x7f) << 16) | ((unsigned)(s0[4 * q + 3] & 0x7f) << 24);
          i1p[q] = (unsigned)(s1[4 * q] & 0x7f) | ((unsigned)(s1[4 * q + 1] & 0x7f) << 8) | ((unsigned)(s1[4 * q + 2] & 0x7f) << 16) | ((unsigned)(s1[4 * q + 3] & 0x7f) << 24);
        }
      }
      int top[16];
#pragma unroll
      for (int grp = 0; grp < 4; ++grp) {
        int g[16];
#pragma unroll
        for (int t = 0; t < 16; ++t) {
          const int c = 16 * grp + t;
          if (c < 50) { const int ij = cand_ij(c); g[t] = (f2key(v0[ij >> 4] + v1[ij & 15]) & ~0xff) | ij; }
          else g[t] = (int)0x80000000;
        }
        sort16_desc(g);
        if (grp == 0) {
#pragma unroll
          for (int t = 0; t < 16; ++t) top[t] = g[t];
        } else {
          merge16_desc(top, g);
        }
      }
      float sum = 0.f;
      float mx = key2f(top[0] & ~0xff);
      float ev[16];
#pragma unroll
      for (int r = 0; r < 16; ++r) { ev[r] = __expf(key2f(top[r] & ~0xff) - mx); sum += ev[r]; }
      const float inv = 1.0f / sum;
      u32x4 o[4];
#pragma unroll
      for (int r = 0; r < 16; ++r) {
        int code = top[r] & 0xff, ci = code >> 4, cj = code & 15;
        unsigned w0 = (ci >> 2) == 0 ? i0p[0] : (ci >> 2) == 1 ? i0p[1] : (ci >> 2) == 2 ? i0p[2] : i0p[3];
        unsigned w1 = (cj >> 2) == 0 ? i1p[0] : (cj >> 2) == 1 ? i1p[1] : (cj >> 2) == 2 ? i1p[2] : i1p[3];
        unsigned e0 = (w0 >> ((ci & 3) * 8)) & 0x7f, e1 = (w1 >> ((cj & 3) * 8)) & 0x7f;
        unsigned e = e0 * 128 + e1;
        o[r >> 2][r & 3] = (e << 16) | (cvtpk(ev[r] * inv, 0.f) & 0xffffu);
      }
      const int lnp = opq(lane);
      unsigned* pr = p.PAIRS + (tok0 + 64 * (size_t)(32 * (lnp >> 5) + (lnp & 31))) * 128 + w * 16;
#pragma unroll
      for (int q = 0; q < 4; ++q) *(u32x4*)(pr + 4 * q) = o[q];
      {
        u32x4 e0, e1;
#pragma unroll
        for (int q = 0; q < 4; ++q) {
          e0[q] = (o[q >> 1][2 * (q & 1)] >> 16) | (o[q >> 1][2 * (q & 1) + 1] & 0xffff0000u);
          e1[q] = (o[2 + (q >> 1)][2 * (q & 1)] >> 16) | (o[2 + (q >> 1)][2 * (q & 1) + 1] & 0xffff0000u);
        }
        unsigned short* er = p.E16 + (tok0 + 64 * (size_t)(32 * (lnp >> 5) + (lnp & 31))) * 128 + w * 16;
        *(u32x4*)er = e0; *(u32x4*)(er + 8) = e1;
      }
    }
    if (tid < 64) p.RINV2[tok0 + 64 * (size_t)tid] = rinv2[tid];
  }
}


#define XB_TMO      128
#define XB_XCNT(j)  (256  + 64 * (j))
#define XB_XSUB(j)  (1280 + 64 * (j))
#define XB_XGEN(j)  (2304 + 64 * (j))
#define XB_TOP      3328
#define XB_TOPGEN   3392
#define XCD_BAR_WORDS 3456
#define XB_SPIN_CAP (1u << 22)
#define LAS __attribute__((address_space(3)))
DI unsigned xb_ld(unsigned* p) { return __hip_atomic_load(p, __ATOMIC_RELAXED, __HIP_MEMORY_SCOPE_AGENT); }
DI unsigned xb_add(unsigned* p, unsigned v) { return __hip_atomic_fetch_add(p, v, __ATOMIC_RELAXED, __HIP_MEMORY_SCOPE_AGENT); }
DI unsigned xb_xcc_id() { return (unsigned)__builtin_amdgcn_s_getreg((3 << 11) | 20) & 0xFu; }
#define XB_SPIN(cond, bar) do { unsigned _sp = 0; while (cond) { __builtin_amdgcn_s_sleep(1); \
    if ((++_sp & 255u) == 0u) { if (xb_ld(&(bar)[XB_TMO])) break; if (_sp > XB_SPIN_CAP) { atomicAdd(&(bar)[XB_TMO], 1u); break; } } } } while (0)
struct XcdBarrier { unsigned* bar; unsigned x; volatile LAS unsigned* st; };
DI XcdBarrier xcd_barrier_post(unsigned* bar, volatile LAS unsigned* st) {
  XcdBarrier b; b.bar = bar; b.x = xb_xcc_id(); b.st = st;
  if (threadIdx.x == 0) (void)xb_add(&bar[XB_XCNT(b.x)], 1u);
  return b;
}
DI void xcd_barrier_complete(unsigned* bar, unsigned x, unsigned& nloc, unsigned& nx) {
  const unsigned G = gridDim.x * gridDim.y * gridDim.z;
  unsigned sum, cnt, mine, sp = 0u;
  for (;;) {
    sum = 0u; cnt = 0u; mine = 0u;
#pragma unroll
    for (unsigned j = 0; j < 16; ++j) { const unsigned c = xb_ld(&bar[XB_XCNT(j)]); sum += c; cnt += (c > 0u) ? 1u : 0u; mine = (j == x) ? c : mine; }
    if (sum == G) break;
    __builtin_amdgcn_s_sleep(1);
    if ((++sp & 255u) == 0u) { if (xb_ld(&bar[XB_TMO])) break; if (sp > XB_SPIN_CAP) { atomicAdd(&bar[XB_TMO], 1u); break; } }
  }
  nloc = mine > 0u ? mine : 1u; nx = cnt > 0u ? cnt : 1u;
}
DI void xcd_barrier(const XcdBarrier& b) {
  asm volatile("s_waitcnt vmcnt(0)" ::: "memory");
  __syncthreads();
  if (threadIdx.x == 0) {
    unsigned* bar = b.bar;
    __builtin_amdgcn_s_waitcnt(0);
    unsigned nloc = b.st[0], nx = b.st[1];
    if (nloc == 0u) { xcd_barrier_complete(bar, b.x, nloc, nx); b.st[0] = nloc; b.st[1] = nx; }
    const unsigned old = xb_add(&bar[XB_XSUB(b.x)], 1u);
    const unsigned gen = old / nloc;
    if (old + 1u == (gen + 1u) * nloc) {
      __builtin_amdgcn_fence(__ATOMIC_RELEASE, "agent");
      asm volatile("s_waitcnt vmcnt(0)" ::: "memory");
      const unsigned og = xb_add(&bar[XB_TOP], 1u);
      const unsigned tg = og / nx;
      if (og + 1u == (tg + 1u) * nx) xb_add(&bar[XB_TOPGEN], 1u);
      else XB_SPIN(xb_ld(&bar[XB_TOPGEN]) == tg, bar);
      __builtin_amdgcn_fence(__ATOMIC_ACQUIRE, "agent");
      xb_add(&bar[XB_XGEN(b.x)], 1u);
      asm volatile("s_waitcnt vmcnt(0)" ::: "memory");
    } else {
      XB_SPIN(xb_ld(&bar[XB_XGEN(b.x)]) == gen, bar);
      __builtin_amdgcn_fence(__ATOMIC_ACQUIRE, "agent");
      asm volatile("s_waitcnt vmcnt(0)" ::: "memory");
    }
  }
  __syncthreads();
}

DI f32x2_t dec_lo(unsigned w) { return __builtin_amdgcn_cvt_pk_f32_fp8((int)w, false); }
DI f32x2_t dec_hi(unsigned w) { return __builtin_amdgcn_cvt_pk_f32_fp8((int)w, true); }
#define PCHUNK 16
#define NPCHUNK (NTOK / PCHUNK)
#define DPP_XOR1 0xB1
#define DPP_XOR2 0x4E
#define DPP_HALF_MIRROR 0x141
#define DPP_ROR8 0x128
template <int CTRL> DI int dpp_i(int v) { return __builtin_amdgcn_mov_dpp(v, CTRL, 0xF, 0xF, true); }
template <int CTRL> DI float dpp_f(float v) { return __builtin_bit_cast(float, __builtin_amdgcn_mov_dpp(__builtin_bit_cast(int, v), CTRL, 0xF, 0xF, true)); }
DI void phase4(const MP& p, char* smem) {
  const int lane = threadIdx.x & 63, w = __builtin_amdgcn_readfirstlane(threadIdx.x >> 6), g = lane >> 3, i = lane & 7;
  const unsigned xcc = xb_xcc_id() & 7u;
  const unsigned loff = 16u * (unsigned)i;
  char* stg = smem + w * 8192;
#pragma unroll 1
  for (int s = 0; s < 8; ++s) {
    const int slice = (int)((xcc + s) & 7u);
    unsigned* ctr = p.CTR + (size_t)slice * 64;
    const unsigned char* tbs = p.EU + (size_t)slice * 16384 * 128;
    _Float16* pre = (_Float16*)p.PRE + (size_t)slice * NTOK * 128 + 16 * g + 2 * i;
#pragma unroll 1
    for (;;) {
      unsigned c = 0;
      if (lane == 0) c = atomicAdd(ctr, 1u);
      c = (unsigned)__builtin_amdgcn_readfirstlane((int)c);
      if (c >= NPCHUNK) break;
      const size_t tokb = (size_t)c * PCHUNK;
      {
        const u32x4* ep = (const u32x4*)(p.E16 + tokb * 128) + lane;
        u32x4 ev[4], hv[2], lv[2];
#pragma unroll
        for (int j = 0; j < 4; ++j) ev[j] = ep[64 * j];
#pragma unroll
        for (int j = 0; j < 2; ++j) {
          const size_t xo = (tokb + 8 * j + (lane >> 3)) * 1024 + 128 * slice + loff;
          hv[j] = *(const u32x4*)(p.X8H + xo); lv[j] = *(const u32x4*)(p.X8L + xo);
        }
        __builtin_amdgcn_wave_barrier();
#pragma unroll
        for (int j = 0; j < 4; ++j) *(u32x4*)(stg + 1024 * j + 16 * lane) = ev[j];
#pragma unroll
        for (int j = 0; j < 2; ++j) { *(u32x4*)(stg + 4096 + 1024 * j + 16 * lane) = hv[j]; *(u32x4*)(stg + 6144 + 1024 * j + 16 * lane) = lv[j]; }
        __builtin_amdgcn_wave_barrier();
      }
#pragma unroll 1
      for (int tt = 0; tt < PCHUNK; ++tt) {
        const size_t tok = tokb + tt;
        const u32x4 pw0 = *(const u32x4*)(stg + 256 * tt + 32 * g), pw1 = *(const u32x4*)(stg + 256 * tt + 32 * g + 16);
        const u32x4 xh = *(const u32x4*)(stg + 4096 + 128 * tt + loff), xl = *(const u32x4*)(stg + 6144 + 128 * tt + loff);
        u32x4 ua[16];
#pragma unroll
        for (int k = 0; k < 16; ++k) {
          const unsigned e = __builtin_amdgcn_ubfe(k < 8 ? pw0[(k >> 1) & 3] : pw1[(k >> 1) & 3], 16 * (k & 1), 16);
          ua[k] = *(const u32x4*)(tbs + ((e << 7) | loff));
        }
        int v[16];
#pragma unroll
        for (int k = 0; k < 16; ++k) {
          int ah = 0, al = 0;
#pragma unroll
          for (int q = 0; q < 4; ++q) {
            ah = __builtin_amdgcn_sdot4((int)ua[k][q], (int)xh[q], ah, false);
            al = __builtin_amdgcn_sdot4((int)ua[k][q], (int)xl[q], al, false);
          }
          v[k] = (ah << 7) + al;
        }
        int a8[8], a4[4], a2[2];
        { const bool up = (lane & 4) != 0;
#pragma unroll
          for (int k = 0; k < 8; ++k) { const int keep = up ? v[8 + k] : v[k]; const int send = up ? v[k] : v[8 + k]; a8[k] = keep + dpp_i<DPP_HALF_MIRROR>(send); } }
        { const bool up = (lane & 2) != 0;
#pragma unroll
          for (int k = 0; k < 4; ++k) { const int keep = up ? a8[4 + k] : a8[k]; const int send = up ? a8[k] : a8[4 + k]; a4[k] = keep + dpp_i<DPP_XOR2>(send); } }
        { const bool up = (lane & 1) != 0;
#pragma unroll
          for (int k = 0; k < 2; ++k) { const int keep = up ? a4[2 + k] : a4[k]; const int send = up ? a4[k] : a4[2 + k]; a2[k] = keep + dpp_i<DPP_XOR1>(send); } }
        const float sc = 1.0f / 1048576.f;
        f16x2_t o2 = {(_Float16)((float)a2[0] * sc), (_Float16)((float)a2[1] * sc)};
        *(f16x2_t*)(pre + tok * 128) = o2;
      }
      __builtin_amdgcn_wave_barrier();
    }
  }
}
DI void phase5(const MP& p) {
  const long gtid = (long)blockIdx.x * NTHR + threadIdx.x;
  const long gsz = (long)gridDim.x * NTHR;
#pragma unroll 1
  for (long u = gtid; u < (long)NTOK * 32; u += gsz) {
    const long tok = u >> 5; const int q4 = (int)(u & 31) * 4;
    float4 s = make_float4(0.f, 0.f, 0.f, 0.f);
#pragma unroll
    for (int sl = 0; sl < 8; ++sl) {
      const u32x2 v = *(const u32x2*)((const _Float16*)p.PRE + ((size_t)sl * NTOK + tok) * 128 + q4);
      const f16x2_t v01 = as_h2(v[0]), v23 = as_h2(v[1]);
      s.x += (float)v01[0]; s.y += (float)v01[1]; s.z += (float)v23[0]; s.w += (float)v23[1];
    }
    const float ri = p.RINV2[tok];
    u32x4 pw = *(const u32x4*)(p.PAIRS + tok * 128 + q4);
    float4 a;
    a.x = gelu_f(s.x * ri) * bflo(pw[0]) * 16.f; a.y = gelu_f(s.y * ri) * bflo(pw[1]) * 16.f;
    a.z = gelu_f(s.z * ri) * bflo(pw[2]) * 16.f; a.w = gelu_f(s.w * ri) * bflo(pw[3]) * 16.f;
    int hw = __builtin_amdgcn_cvt_pk_fp8_f32(a.x, a.y, 0, false);
    hw = __builtin_amdgcn_cvt_pk_fp8_f32(a.z, a.w, hw, true);
    const f32x2_t d01 = __builtin_amdgcn_cvt_pk_f32_fp8(hw, false), d23 = __builtin_amdgcn_cvt_pk_f32_fp8(hw, true);
    int lw = __builtin_amdgcn_cvt_pk_fp8_f32((a.x - d01[0]) * 16.f, (a.y - d01[1]) * 16.f, 0, false);
    lw = __builtin_amdgcn_cvt_pk_fp8_f32((a.z - d23[0]) * 16.f, (a.w - d23[1]) * 16.f, lw, true);
    *(int*)(p.ACTH + tok * 128 + q4) = hw;
    *(int*)(p.ACTL + tok * 128 + q4) = lw;
  }
}
typedef int i32x8 __attribute__((ext_vector_type(8)));
struct V6Ctx {
  int lane, g, i, n, kq, bq, sc, tc, rg; bool valid; unsigned loff; unsigned sel[4]; int aoff;
};
DI void v6_load(const V6Ctx& c, u32x4 (&va)[16], u32x4& aw, unsigned*& xrow, const MP& p, const char* stg, const unsigned char* tbs, size_t tok, int tt, int slice) {
  aw = *(const u32x4*)(stg + c.aoff + 128 * tt);
  const u32x4 pw0 = *(const u32x4*)(stg + 256 * tt + 32 * c.g), pw1 = *(const u32x4*)(stg + 256 * tt + 32 * c.g + 16);
#pragma unroll
  for (int k = 0; k < 16; ++k) { const unsigned e = __builtin_amdgcn_ubfe(k < 8 ? pw0[(k >> 1) & 3] : pw1[(k >> 1) & 3], 16 * (k & 1), 16); va[k] = *(const u32x4*)(tbs + ((e << 7) | c.loff)); }
  xrow = (unsigned*)(p.OUTB + tok * 1024 + 128 * slice) + c.lane;
}
DI void v6_mma(const V6Ctx& c, const u32x4 (&va)[16], const u32x4 aw, float* red) {
  i32x8 B0, B1;
#pragma unroll
  for (int r = 0; r < 8; ++r) {
    B0[r] = (int)__builtin_amdgcn_perm(0u, aw[r >> 2], c.sel[r & 3]);
    B1[r] = (int)__builtin_amdgcn_perm(0u, aw[2 + (r >> 2)], c.sel[r & 3]);
  }
  float* dst = c.valid ? (red + (c.tc * 2 + c.sc) * 128 + 64 * (c.rg & 1) + c.bq) : (red + 512 + c.lane);
  const int st = c.valid ? 1 : 0;
#pragma unroll
  for (int q = 0; q < 4; ++q) {
    i32x8 A0, A1;
#pragma unroll
    for (int r = 0; r < 8; ++r) { A0[r] = (int)va[r][q]; A1[r] = (int)va[8 + r][q]; }
    f32x4 z = {0.f, 0.f, 0.f, 0.f};
    z = __builtin_amdgcn_mfma_scale_f32_16x16x128_f8f6f4(A0, B0, z, 0, 0, 0, 0x7f7f7f7f, 0, 0x7f7f7f7f);
    z = __builtin_amdgcn_mfma_scale_f32_16x16x128_f8f6f4(A1, B1, z, 0, 0, 0, 0x7f7f7f7f, 0, 0x7f7f7f7f);
#pragma unroll
    for (int r = 0; r < 4; ++r) {
      float v = z[r];
      asm volatile("" : "+v"(v));
      dst[st * (16 * r + 4 * q)] = v;
    }
  }
}
DI void v6_fin(const V6Ctx& c, const float* red, unsigned* xrow) {
  const f32x2_t h0 = *(const f32x2_t*)(red + 0 * 128 + 2 * c.lane), h1 = *(const f32x2_t*)(red + 1 * 128 + 2 * c.lane);
  const f32x2_t l0 = *(const f32x2_t*)(red + 2 * 128 + 2 * c.lane), l1 = *(const f32x2_t*)(red + 3 * 128 + 2 * c.lane);
  const float o0 = ((h0[0] + h1[0]) + (l0[0] + l1[0]) * (1.0f / 16.f)) * (1.0f / 64.f);
  const float o1 = ((h0[1] + h1[1]) + (l0[1] + l1[1]) * (1.0f / 16.f)) * (1.0f / 64.f);
  *xrow = cvtpk(o0, o1);
}
DI void phase6(const MP& p, char* smem) {
  V6Ctx c;
  c.lane = threadIdx.x & 63;
  const int w = __builtin_amdgcn_readfirstlane(threadIdx.x >> 6);
  c.g = c.lane >> 3; c.i = c.lane & 7; c.n = c.lane & 15; c.kq = c.lane >> 4; c.bq = c.n & 3; c.sc = (c.n >> 2) & 1; c.tc = c.n >> 3; c.rg = c.kq;
  c.loff = 16u * (unsigned)c.i;
  c.valid = ((c.rg >> 1) == c.sc);
#pragma unroll
  for (int j = 0; j < 4; ++j) c.sel[j] = (0x0c0c0c0cu & ~(0xffu << (8 * c.bq))) | ((unsigned)j << (8 * c.bq));
  c.aoff = 4096 + 2048 * c.tc + 16 * (2 * c.kq + c.sc);
  const unsigned xcc = xb_xcc_id() & 7u;
  float* redA = (float*)(smem + w * 4608);
  float* redB = redA + 576;
  char* stg = smem + 8 * 4608 + w * 8192;
#pragma unroll 1
  for (int s = 0; s < 8; ++s) {
    const int slice = (int)((xcc + s) & 7u);
    unsigned* ctr = p.CTR + (size_t)(8 + slice) * 64;
    const unsigned char* tbs = p.EV + (size_t)slice * 16384 * 128;
#pragma unroll 1
    for (;;) {
      unsigned cc = 0;
      if (c.lane == 0) cc = atomicAdd(ctr, 1u);
      cc = (unsigned)__builtin_amdgcn_readfirstlane((int)cc);
      if (cc >= NPCHUNK) break;
      const size_t tokb = (size_t)cc * PCHUNK;
      {
        const u32x4* ep = (const u32x4*)(p.E16 + tokb * 128) + c.lane;
        u32x4 ev[4], ah[2], al[2];
#pragma unroll
        for (int j = 0; j < 4; ++j) ev[j] = ep[64 * j];
#pragma unroll
        for (int j = 0; j < 2; ++j) { ah[j] = ((const u32x4*)(p.ACTH + tokb * 128))[64 * j + c.lane]; al[j] = ((const u32x4*)(p.ACTL + tokb * 128))[64 * j + c.lane]; }
        __builtin_amdgcn_wave_barrier();
#pragma unroll
        for (int j = 0; j < 4; ++j) *(u32x4*)(stg + 1024 * j + 16 * c.lane) = ev[j];
#pragma unroll
        for (int j = 0; j < 2; ++j) { *(u32x4*)(stg + 4096 + 1024 * j + 16 * c.lane) = ah[j]; *(u32x4*)(stg + 6144 + 1024 * j + 16 * c.lane) = al[j]; }
        __builtin_amdgcn_wave_barrier();
      }
#pragma unroll 1
      for (int tt = 0; tt < PCHUNK; tt += 2) {
        u32x4 vaA[16], vaB[16], awA, awB; unsigned *rowA, *rowB;
        v6_load(c, vaA, awA, rowA, p, stg, tbs, tokb + tt, tt, slice);
        v6_load(c, vaB, awB, rowB, p, stg, tbs, tokb + tt + 1, tt + 1, slice);
        v6_mma(c, vaA, awA, redA);
        v6_mma(c, vaB, awB, redB);
        __builtin_amdgcn_wave_barrier();
        v6_fin(c, redA, rowA);
        v6_fin(c, redB, rowB);
        __builtin_amdgcn_wave_barrier();
      }
    }
  }
}
DI void phase7(const MP& p) {
  const int lane = threadIdx.x & 63;
  const int gw = blockIdx.x * (NTHR / 64) + (threadIdx.x >> 6), nw = gridDim.x * (NTHR / 64);
  const float4* fp = (const float4*)p.fg + 4 * lane;
  float4 f[4];
#pragma unroll
  for (int q = 0; q < 4; ++q) f[q] = fp[q];
#pragma unroll 2
  for (int tok = gw; tok < NTOK; tok += nw) {
    const u32x4* xp = (const u32x4*)(p.X2B + (size_t)tok * 1024) + 2 * lane;
    const u32x4* op_ = (const u32x4*)(p.OUTB + (size_t)tok * 1024) + 2 * lane;
    const u32x4 a = xp[0], b = xp[1], oa = op_[0], ob = op_[1];
    float v[16];
#pragma unroll
    for (int q = 0; q < 4; ++q) {
      v[2 * q] = bflo(a[q]) + bflo(oa[q]); v[2 * q + 1] = bfhi(a[q]) + bfhi(oa[q]);
      v[8 + 2 * q] = bflo(b[q]) + bflo(ob[q]); v[8 + 2 * q + 1] = bfhi(b[q]) + bfhi(ob[q]);
    }
    float s = 0.f;
#pragma unroll
    for (int q = 0; q < 16; ++q) s = fmaf(v[q], v[q], s);
    for (int m = 32; m >= 1; m >>= 1) s += __shfl_xor(s, m, 64);
    const float r3 = rsqrtf(s * (1.0f / 1024.f) + 1e-6f);
    float4* op = (float4*)(p.out + (size_t)tok * 1024) + 4 * lane;
#pragma unroll
    for (int q = 0; q < 4; ++q)
      op[q] = make_float4(v[4 * q] * r3 * f[q].x, v[4 * q + 1] * r3 * f[q].y, v[4 * q + 2] * r3 * f[q].z, v[4 * q + 3] * r3 * f[q].w);
  }
}

#define SMEM_BYTES (ATILE_BYTES + 64 * 4 + 8 * 64 * 4)
__global__ void __launch_bounds__(NTHR) k_mega(MP p) {
  __shared__ __attribute__((aligned(16))) char smem[SMEM_BYTES];
  __shared__ uint4 xb_words;
  if (threadIdx.x == 0) xb_words = make_uint4(0u, 0u, 0u, 0u);
  __syncthreads();
  XcdBarrier gb = xcd_barrier_post(p.bar, (volatile LAS unsigned*)&xb_words);
  phase0(p, smem);
  xcd_barrier(gb);
  phase1(p, smem);
  xcd_barrier(gb);
  phase2(p, smem);
  xcd_barrier(gb);
  phase3(p, smem);
  xcd_barrier(gb);
  phase4(p, smem);
  xcd_barrier(gb);
  phase5(p);
  xcd_barrier(gb);
  phase6(p, smem);
  xcd_barrier(gb);
  phase7(p);
}

extern "C" void kernel_launch(void* const* d_in, const int* in_sizes, int n_in, void* d_out, int out_size, void* d_ws, size_t ws_size,
                              hipStream_t stream) {
  float* out = (float*)d_out;
  char* arena1 = (char*)d_ws;
  size_t o1 = 0;
  auto A1 = [&](size_t bytes) { void* r = arena1 + o1; o1 += (bytes + 255) & ~(size_t)255; return r; };
  MP p;
  memset(&p, 0, sizeof(p));
  p.x = (const float*)d_in[0]; p.g1 = (const float*)d_in[1]; p.w_in = (const float*)d_in[2]; p.a_re = (const float*)d_in[3];
  p.a_im = (const float*)d_in[4]; p.log_step = (const float*)d_in[5]; p.b_re = (const float*)d_in[6]; p.b_im = (const float*)d_in[7];
  p.c_re = (const float*)d_in[8]; p.c_im = (const float*)d_in[9]; p.ssm_d = (const float*)d_in[10]; p.w_glu = (const float*)d_in[11];
  p.w_f = (const float*)d_in[12]; p.w_out = (const float*)d_in[13]; p.g2 = (const float*)d_in[14]; p.w_q = (const float*)d_in[15];
  p.keys = (const float*)d_in[16]; p.eu = (const float*)d_in[17]; p.ev = (const float*)d_in[18]; p.fg = (const float*)d_in[19];
  p.out = out;
  p.U = (unsigned short*)A1((size_t)NTOK * 512 * 2);
  p.T = (unsigned short*)A1((size_t)NTOK * 1024 * 2);
  p.YF = (unsigned short*)A1((size_t)NTOK * 512 * 2);
  p.YB = (unsigned short*)A1((size_t)NTOK * 512 * 2);
  p.PAIRS = (unsigned*)A1((size_t)NTOK * 128 * 4);
  p.E16 = (unsigned short*)A1((size_t)NTOK * 128 * 2);
  p.EU = (unsigned char*)A1((size_t)16384 * 1024);
  p.EV = (unsigned char*)A1((size_t)16384 * 1024);
  p.WinF = (bf16x8*)A1((size_t)1024 * 1536 * 2);
  p.WgluF = (bf16x8*)A1((size_t)512 * 512 * 2);
  p.WoutF = (bf16x8*)A1((size_t)1024 * 1024 * 2);
  p.WqkF = (bf16x8*)A1((size_t)1024 * 2048 * 2);
  p.M1F = (bf16x8*)A1((size_t)128 * 128 * 2);
  p.M3T = (unsigned short*)A1((size_t)4096 * 128 * 2);
  p.s5lam = (float*)A1((size_t)64 * 64 * 2 * 4);
  p.s5B = (bf16x8*)A1((size_t)64 * 4 * 64 * 16);
  p.s5C = (bf16x8*)A1((size_t)64 * 4 * 64 * 16);
  p.bar = (unsigned*)A1((size_t)XCD_BAR_WORDS * 4);
  p.CTR = (unsigned*)A1((size_t)16 * 64 * 4);
  (void)hipMemsetAsync(p.bar, 0, (size_t)((char*)(p.CTR + 16 * 64) - (char*)p.bar), stream);
  p.RINV2 = (float*)A1((size_t)NTOK * 4);
  p.OUTB = (unsigned short*)A1((size_t)NTOK * 1024 * 2);
  p.X2B = (unsigned short*)A1((size_t)NTOK * 1024 * 2);
  p.ACTH = (unsigned char*)A1((size_t)NTOK * 128);
  p.ACTL = (unsigned char*)A1((size_t)NTOK * 128);
  p.X8H = (unsigned char*)A1((size_t)NTOK * 1024);
  p.X8L = (unsigned char*)A1((size_t)NTOK * 1024);
  p.PRE = (float*)A1((size_t)8 * NTOK * 128 * 2);
  static int grid_blocks = 0;
  if (!grid_blocks) {
    int dev = 0, cus = 0, per_cu = 0;
    (void)hipGetDevice(&dev);
    (void)hipDeviceGetAttribute(&cus, hipDeviceAttributeMultiprocessorCount, dev);
    (void)hipOccupancyMaxActiveBlocksPerMultiprocessor(&per_cu, k_mega, NTHR, 0);
    if (per_cu < 1) per_cu = 1;
    if (per_cu > 1) per_cu = 1;
    grid_blocks = cus * per_cu;
  }
  void* args[] = {&p};
  hipError_t e = hipLaunchCooperativeKernel((void*)k_mega, dim3(grid_blocks), dim3(NTHR), args, 0, stream);
  if (e != hipSuccess) fprintf(stderr, "cooperative launch failed: %s (grid %d)\n", hipGetErrorString(e), grid_blocks);
}
```

```cpp
#include <hip/hip_runtime.h>
#include <stdint.h>
#include <string.h>
#include <stdio.h>

#define NTOK 65536
#define XPF 2
#define SK_STASH 14

__device__ __forceinline__ void dsincos(double x, double* s, double* c) {
  double q = rint(x * 0.63661977236758134308);
  double r = fma(-q, 1.57079632679489655800, x);
  r = fma(-q, 6.12323399573676603587e-17, r);
  double r2 = r * r;
  double sp = r * (1.0 + r2 * (-1.0 / 6 + r2 * (1.0 / 120 + r2 * (-1.0 / 5040 + r2 * (1.0 / 362880 + r2 * (-1.0 / 39916800 + r2 * (1.0 / 6227020800.0 + r2 * (-1.0 / 1307674368000.0))))))));
  double cp = 1.0 + r2 * (-0.5 + r2 * (1.0 / 24 + r2 * (-1.0 / 720 + r2 * (1.0 / 40320 + r2 * (-1.0 / 3628800 + r2 * (1.0 / 479001600.0 + r2 * (-1.0 / 87178291200.0)))))));
  long long qi = (long long)q;
  int m = (int)(qi & 3);
  double ss = (m == 0) ? sp : (m == 1) ? cp : (m == 2) ? -sp : -cp;
  double cc = (m == 0) ? cp : (m == 1) ? -sp : (m == 2) ? -cp : sp;
  *s = ss; *c = cc;
}

typedef short bf16x8 __attribute__((ext_vector_type(8)));
typedef float f32x16 __attribute__((ext_vector_type(16)));
typedef float f32x4 __attribute__((ext_vector_type(4)));
typedef unsigned u32x4 __attribute__((ext_vector_type(4)));
typedef unsigned u32x2 __attribute__((ext_vector_type(2)));
typedef float f32x2_t __attribute__((ext_vector_type(2)));
typedef __bf16 bf16x2_t __attribute__((ext_vector_type(2)));
typedef _Float16 f16x2_t __attribute__((ext_vector_type(2)));
typedef _Float16 f16x8_t __attribute__((ext_vector_type(8)));
__device__ __forceinline__ f16x2_t as_h2(unsigned v) { return __builtin_bit_cast(f16x2_t, v); }
#define DI __device__ __forceinline__
#define MFMA32(a, b, c) __builtin_amdgcn_mfma_f32_32x32x16_bf16((a), (b), (c), 0, 0, 0)
#define MFMA16(a, b, c) __builtin_amdgcn_mfma_f32_16x16x32_bf16((a), (b), (c), 0, 0, 0)
#define NTHR 512
#define ASTRIDE 2064
#define ATILE_BYTES (64 * ASTRIDE)

DI unsigned cvtpk(float lo, float hi) { f32x2_t v = {lo, hi}; bf16x2_t b = __builtin_convertvector(v, bf16x2_t); return __builtin_bit_cast(unsigned, b); }
DI unsigned short f2bf(float x) { return (unsigned short)(cvtpk(x, 0.f) & 0xffffu); }
DI float bf2f(unsigned h) { return __uint_as_float(h << 16); }
DI float bflo(unsigned w) { return __uint_as_float(w << 16); }
DI float bfhi(unsigned w) { return __uint_as_float(w & 0xffff0000u); }
DI int crow(int reg, int h) { return (reg & 3) + 8 * (reg >> 2) + 4 * h; }
DI f32x16 zero16() { f32x16 z; for (int i = 0; i < 16; ++i) z[i] = 0.f; return z; }

struct MP {
  const float *x, *g1, *w_in, *a_re, *a_im, *log_step, *b_re, *b_im, *c_re, *c_im, *ssm_d, *w_glu, *w_f, *w_out, *g2, *w_q, *keys, *eu, *ev, *fg;
  float* out;
  bf16x8 *WinF, *WgluF, *WoutF, *WqkF, *M1F, *s5B, *s5C;
  unsigned short *M3T, *U, *T, *YF, *YB;
  unsigned char *EU, *EV;
  float* s5lam;
  unsigned* PAIRS;
  unsigned short* E16;
  unsigned* bar;
  unsigned* CTR;
  float *RINV2, *PRE;
  unsigned short* OUTB;
  unsigned short* X2B;
  unsigned char *ACTH, *ACTL;
  unsigned char *X8H, *X8L;
};

DI void s5_params(const MP& p, int dg, int pp, float& lr, float& li, double& fr, double& fi) {
  double are = p.a_re[dg * 64 + pp], aim = p.a_im[dg * 64 + pp];
  double step = exp((double)p.log_step[dg]);
  double sn_, cs_;
  dsincos(aim * step, &sn_, &cs_);
  double mag = exp(are * step);
  double lrd = mag * cs_, lid = mag * sn_;
  double nr = lrd - 1.0, ni = lid;
  double den = are * are + aim * aim;
  fr = (nr * are + ni * aim) / den; fi = (ni * are - nr * aim) / den;
  lr = (float)lrd; li = (float)lid;
}

typedef unsigned v4u_t __attribute__((ext_vector_type(4)));
DI bf16x8 ldbuf(__amdgpu_buffer_rsrc_t rs, unsigned voff, unsigned soff) { return __builtin_bit_cast(bf16x8, __builtin_amdgcn_raw_buffer_load_b128(rs, voff, soff, 0)); }
DI int opq(int v) { asm volatile("" : "+v"(v)); return v; }
DI unsigned opqu(unsigned v) { asm volatile("" : "+v"(v)); return v; }
DI unsigned opqs(unsigned v) { asm volatile("" : "+s"(v)); return v; }
DI void fold_dot8(float (&out)[8], const float* __restrict__ w0, size_t wstride, const float* lds, int stride, int n4) {
#pragma unroll
  for (int j = 0; j < 8; ++j) out[j] = 0.f;
#pragma unroll 2
  for (int m4 = 0; m4 < n4; ++m4) {
    const float l0 = lds[(4 * m4) * stride], l1 = lds[(4 * m4 + 1) * stride], l2 = lds[(4 * m4 + 2) * stride], l3 = lds[(4 * m4 + 3) * stride];
#pragma unroll
    for (int j = 0; j < 8; ++j) {
      const float4 wv = ((const float4*)(w0 + j * wstride))[m4];
      out[j] = fmaf(wv.x, l0, out[j]); out[j] = fmaf(wv.y, l1, out[j]); out[j] = fmaf(wv.z, l2, out[j]); out[j] = fmaf(wv.w, l3, out[j]);
    }
  }
}
#define WSS 132
DI void fold_stage(float* ws, const float* __restrict__ src, size_t ld, int tid) {
  float4 v[8];
#pragma unroll
  for (int q = 0; q < 8; ++q) { const int o = tid + NTHR * q; v[q] = *(const float4*)(src + (size_t)(o >> 5) * ld + (o & 31) * 4); }
#pragma unroll
  for (int q = 0; q < 8; ++q) { const int o = tid + NTHR * q; *(float4*)(ws + (o >> 5) * WSS + (o & 31) * 4) = v[q]; }
}
DI void conv_frag(bf16x8* dst, const float* __restrict__ src, int ld, const float* __restrict__ kscale, int ntiles, int KS, long gtid, long gsz) {
  const long total = (long)ntiles * KS * 64;
#pragma unroll 1
  for (long u = gtid; u < total; u += gsz) {
    int lane = (int)(u & 63);
    long q = u >> 6;
    int ks = (int)(q % KS), nt = (int)(q / KS);
    int n = 32 * nt + (lane & 31), k0 = 16 * ks + 8 * (lane >> 5);
    u32x4 w;
#pragma unroll
    for (int jj = 0; jj < 4; ++jj) {
      int k = k0 + 2 * jj;
      float a = src[(size_t)k * ld + n], b = src[(size_t)(k + 1) * ld + n];
      if (kscale) { a *= kscale[k]; b *= kscale[k + 1]; }
      w[jj] = cvtpk(a, b);
    }
    dst[u] = __builtin_bit_cast(bf16x8, w);
  }
}

DI void conv_frag16(bf16x8* dst, const float* __restrict__ src, int ld, int ntiles, int KS, long gtid, long gsz, const float* __restrict__ kscale = nullptr) {
  const long total = (long)ntiles * KS * 64;
#pragma unroll 1
  for (long u = gtid; u < total; u += gsz) {
    int lane = (int)(u & 63);
    long q = u >> 6;
    int ks = (int)(q % KS), nt = (int)(q / KS);
    int n = 16 * nt + (lane & 15), k0 = 32 * ks + 8 * (lane >> 4);
    u32x4 w;
#pragma unroll
    for (int jj = 0; jj < 4; ++jj) {
      int k = k0 + 2 * jj;
      float a = src[(size_t)k * ld + n], b = src[(size_t)(k + 1) * ld + n];
      if (kscale) { a *= kscale[k]; b *= kscale[k + 1]; }
      w[jj] = cvtpk(a, b);
    }
    dst[u] = __builtin_bit_cast(bf16x8, w);
  }
}

DI void late_prep(const MP& p, long gtid, long gsz) {
#pragma unroll 1
  for (long u = gtid; u < 4096 * 128; u += gsz) {
    int s2ri = (int)(u & 127), k = (int)(u >> 7);
    int ri = s2ri & 1, s2 = s2ri >> 1;
    const float rev = (float)((k * s2) & 4095) * (1.0f / 4096.f);
    p.M3T[u] = f2bf(ri ? __builtin_amdgcn_sinf(rev) : __builtin_amdgcn_cosf(rev));
  }
  const long NU = (long)16384 * 1024 / 16;
#pragma unroll 1
  for (long u0 = gtid; u0 < NU; u0 += 2 * gsz) {
    float4 a[2][4], b[2][4];
#pragma unroll
    for (int j = 0; j < 2; ++j) {
      const long u = min(u0 + j * gsz, NU - 1);
      const float4* s = (const float4*)(p.eu + u * 16);
      const float4* s2 = (const float4*)(p.ev + u * 16);
#pragma unroll
      for (int q = 0; q < 4; ++q) { a[j][q] = s[q]; b[j][q] = s2[q]; }
    }
#pragma unroll
    for (int j = 0; j < 2; ++j) {
      const long u = u0 + j * gsz;
      if (u < NU) {
        const int d0 = (int)((u * 16) & 1023);
        const float4* gq = (const float4*)(p.g2 + d0);
        u32x4 ou, ov;
#pragma unroll
        for (int q = 0; q < 4; ++q) {
          const float4 g = gq[q], av = a[j][q], bv = b[j][q];
          const float MG = 12582912.f;
          const float f0 = __builtin_amdgcn_fmed3f(fmaf(av.x * g.x, 1024.f, MG), MG - 127.f, MG + 127.f), f1 = __builtin_amdgcn_fmed3f(fmaf(av.y * g.y, 1024.f, MG), MG - 127.f, MG + 127.f);
          const float f2 = __builtin_amdgcn_fmed3f(fmaf(av.z * g.z, 1024.f, MG), MG - 127.f, MG + 127.f), f3 = __builtin_amdgcn_fmed3f(fmaf(av.w * g.w, 1024.f, MG), MG - 127.f, MG + 127.f);
          ou[q] = __builtin_amdgcn_perm(__float_as_uint(f1), __float_as_uint(f0), 0x0c0c0400u) | __builtin_amdgcn_perm(__float_as_uint(f3), __float_as_uint(f2), 0x04000c0cu);
          int w2 = __builtin_amdgcn_cvt_pk_fp8_f32(bv.x * 4.f, bv.y * 4.f, 0, false);
          w2 = __builtin_amdgcn_cvt_pk_fp8_f32(bv.z * 4.f, bv.w * 4.f, w2, true);
          ov[q] = (unsigned)w2;
        }
        const long e = u >> 6; const int c16 = (int)(u & 63);
        const size_t dst = (((size_t)(c16 >> 3) * 16384 + (size_t)e) * 128) + (size_t)(c16 & 7) * 16;
        *(u32x4*)(p.EU + dst) = ou;
        *(u32x4*)(p.EV + dst) = ov;
      }
    }
  }
}

DI void phase0(const MP& p, char* smem) {
  const int tid = threadIdx.x;
  const long gtid = (long)blockIdx.x * NTHR + tid;
  const long gsz = (long)gridDim.x * NTHR;
  conv_frag16(p.WinF, p.w_in, 1024, 32, 32, gtid, gsz, p.g1);
  conv_frag(p.WgluF, p.w_glu, 512, nullptr, 16, 32, gtid, gsz);
  conv_frag16(p.WoutF, p.w_out, 1024, 64, 32, gtid, gsz);
#pragma unroll 1
  for (long u = gtid; u < 8 * 4 * 64; u += gsz) {
    int lane = (int)(u & 63), ks = (int)((u >> 6) & 3), mt = (int)(u >> 8);
    int row = 16 * mt + (lane & 15), h = lane >> 4;
    int ri = row >> 6, k1 = row & 63;
    u32x4 w;
#pragma unroll
    for (int jj = 0; jj < 4; ++jj) {
      float v2[2];
#pragma unroll
      for (int e = 0; e < 2; ++e) {
        int j = 2 * jj + e;
        int ab = ks >> 1, s1 = 32 * (ks & 1) + 16 * (j >> 2) + 4 * h + (j & 3);
        double sv, cv;
        dsincos(6.283185307179586476925 * (double)((k1 * s1) & 63) / 64.0, &sv, &cv);
        double val = (ri == 0) ? (ab == 0 ? cv : -sv) : (ab == 0 ? -sv : -cv);
        v2[e] = (float)val;
      }
      w[jj] = cvtpk(v2[0], v2[1]);
    }
    p.M1F[u] = __builtin_bit_cast(bf16x8, w);
  }
#pragma unroll 1
  for (long u = gtid; u < 64 * 64; u += gsz) {
    int pp = (int)(u & 63), dg = (int)(u >> 6);
    float lr, li; double fr, fi;
    s5_params(p, dg, pp, lr, li, fr, fi);
    p.s5lam[u * 2] = lr; p.s5lam[u * 2 + 1] = li;
  }
#pragma unroll 1
  for (long u = gtid; u < 64 * 4 * 64; u += gsz) {
    int lane = (int)(u & 63), nt = (int)((u >> 6) & 3), dg = (int)(u >> 8);
    int col = 32 * nt + (lane & 31), ri = col >> 6, pp = col & 63, h = lane >> 5;
    float lr, li; double fr, fi;
    s5_params(p, dg, pp, lr, li, fr, fi);
    const float* brp = p.b_re + ((size_t)dg * 64 + pp) * 16 + 8 * h;
    const float* bip = p.b_im + ((size_t)dg * 64 + pp) * 16 + 8 * h;
    u32x4 w;
#pragma unroll
    for (int jj = 0; jj < 4; ++jj) {
      double br0 = brp[2 * jj], bi0 = bip[2 * jj], br1 = brp[2 * jj + 1], bi1 = bip[2 * jj + 1];
      float v0 = (float)(ri ? (fr * bi0 + fi * br0) : (fr * br0 - fi * bi0));
      float v1 = (float)(ri ? (fr * bi1 + fi * br1) : (fr * br1 - fi * bi1));
      w[jj] = cvtpk(v0, v1);
    }
    p.s5B[u] = __builtin_bit_cast(bf16x8, w);
  }
#pragma unroll 1
  for (long u = gtid; u < 64 * 4 * 64; u += gsz) {
    int lane = (int)(u & 63), ks = (int)((u >> 6) & 3), dg = (int)(u >> 8);
    int c = lane & 15;
    u32x4 w;
#pragma unroll
    for (int jj = 0; jj < 4; ++jj) {
      int kk = 32 * ks + 8 * (lane >> 4) + 2 * jj;
      int pt = kk >> 6, pq = (kk & 63) >> 1;
      int pp = 32 * pt + pq;
      float vre = p.c_re[((size_t)dg * 16 + c) * 64 + pp];
      float vim = -p.c_im[((size_t)dg * 16 + c) * 64 + pp];
      w[jj] = cvtpk(vre, vim);
    }
    p.s5C[u] = __builtin_bit_cast(bf16x8, w);
  }
  {
    float* Lm = (float*)smem;
    float* tab = Lm + 4224;
    float* WS = tab + 128;
    const int lane = tid & 63, h = lane >> 5, ksl = tid >> 6;
    const float nrm = 1.0f / sqrtf(4096.f * 128.f);
#pragma unroll 1
    for (int task = blockIdx.x; task < 128; task += gridDim.x) {
      int ntp = task >> 2, kq = task & 3;
      int ab = ntp >> 4, chbase = (ntp & 15) * 32, g = chbase >> 7, d0 = chbase & 127;
      __syncthreads();
      if (tid < 128) {
        double sv, cv;
        dsincos(6.283185307179586476925 * (double)tid / 128.0, &sv, &cv);
        tab[tid] = (float)(ab ? sv : cv);
      }
#pragma unroll
      for (int q = 0; q < 8; ++q) { const int o = tid + NTHR * q; WS[o] = p.w_f[((size_t)g * 128 + (o >> 5)) * 128 + d0 + (o & 31)]; }
      __syncthreads();
#pragma unroll 1
      for (int o = tid; o < 128 * 32; o += NTHR) {
        int m = o >> 5, dd = o & 31;
        float s = 0.f;
#pragma unroll 8
        for (int c2 = 0; c2 < 128; ++c2) s = fmaf(tab[(m * c2) & 127], WS[c2 * 32 + dd], s);
        Lm[o] = s * nrm;
      }
#pragma unroll 1
      for (int chunk = 0; chunk < 2; ++chunk) {
        const int krow0 = kq * 256 + chunk * 128;
        __syncthreads();
        fold_stage(WS, p.w_in + (size_t)krow0 * 1024 + 512 + 128 * g, 1024, tid);
        __syncthreads();
        float sv[8];
        fold_dot8(sv, WS + (ksl * 16 + 8 * h) * WSS, WSS, Lm + (lane & 31), 32, 32);
        const int ks = (krow0 >> 4) + ksl, k0 = 16 * ks + 8 * h;
        u32x4 w;
#pragma unroll
        for (int jj = 0; jj < 4; ++jj) w[jj] = cvtpk(sv[2 * jj] * p.g1[k0 + 2 * jj], sv[2 * jj + 1] * p.g1[k0 + 2 * jj + 1]);
        const int dd = lane & 31;
        p.WinF[(size_t)65536 + ((size_t)(2 * ntp + (dd >> 4)) * 32 + (ks >> 1)) * 64 + (dd & 15) + 16 * (2 * (ks & 1) + h)] = __builtin_bit_cast(bf16x8, w);
      }
    }
#pragma unroll 1
    for (int task = (int)((blockIdx.x + gridDim.x / 2) % gridDim.x); task < 128; task += gridDim.x) {
      int hp = task >> 3, kt = (task >> 1) & 3, chalf = task & 1;
      __syncthreads();
#pragma unroll 1
      for (int o = tid; o < 32 * 128; o += NTHR) {
        int kk = o >> 7, d = o & 127;
        Lm[kk * 129 + d] = p.keys[((size_t)hp * 128 + kt * 32 + kk) * 128 + d];
      }
#pragma unroll 1
      for (int chunk = 0; chunk < 4; ++chunk) {
        const int crow0 = chalf * 512 + chunk * 128;
        __syncthreads();
        fold_stage(WS, p.w_q + (size_t)crow0 * 2048 + hp * 128, 2048, tid);
        __syncthreads();
        float sv[8];
        fold_dot8(sv, WS + (ksl * 16 + 8 * h) * WSS, WSS, Lm + (lane & 31) * 129, 1, 32);
        const int ks = (crow0 >> 4) + ksl, c0 = 16 * ks + 8 * h;
        u32x4 w;
#pragma unroll
        for (int jj = 0; jj < 4; ++jj) w[jj] = cvtpk(sv[2 * jj] * p.g2[c0 + 2 * jj], sv[2 * jj + 1] * p.g2[c0 + 2 * jj + 1]);
        {
          const int kk = lane & 31;
          p.WqkF[((size_t)(hp * 8 + 2 * kt + (kk >> 4)) * 32 + (ks >> 1)) * 64 + (kk & 15) + 16 * (2 * (ks & 1) + h)] = __builtin_bit_cast(bf16x8, w);
        }
      }
    }
  }
}

#define PD 4
template <int NT, int PDT>
DI void gemm_tile(f32x16 (&acc)[2][NT], const char* atile, int acol0, const bf16x8* __restrict__ wf, int KS, int nks, int lane, int stride2 = 2) {
  const char* abase = atile + (lane & 31) * ASTRIDE + (acol0 + 8 * (lane >> 5)) * 2;
  const char* wbase = (const char*)wf;
  const unsigned loff = (unsigned)lane * 16u;
  unsigned noff[NT];
#pragma unroll
  for (int nt = 0; nt < NT; ++nt) noff[nt] = (unsigned)(((nt & 1) + (nt >> 1) * stride2) * KS) * 1024u;
  bf16x8 bq[PDT][NT];
#pragma unroll
  for (int d = 0; d < PDT; ++d)
#pragma unroll
    for (int nt = 0; nt < NT; ++nt) bq[d][nt] = *(const bf16x8*)(wbase + (noff[nt] + (unsigned)d * 1024u) + loff);
#pragma unroll 1
  for (int ks0 = 0; ks0 < nks; ks0 += PDT) {
#pragma unroll
    for (int d = 0; d < PDT; ++d) {
      const int ks = ks0 + d;
      bf16x8 a0 = *(const bf16x8*)(abase + ks * 32);
      bf16x8 a1 = *(const bf16x8*)(abase + 32 * ASTRIDE + ks * 32);
      const unsigned ksn = opqs((unsigned)min(ks + PDT, nks - 1) * 1024u);
#pragma unroll
      for (int nt = 0; nt < NT; ++nt) {
        acc[0][nt] = MFMA32(a0, bq[d][nt], acc[0][nt]);
        acc[1][nt] = MFMA32(a1, bq[d][nt], acc[1][nt]);
        bq[d][nt] = *(const bf16x8*)(wbase + (noff[nt] + ksn) + loff);
      }
    }
  }
}

DI bf16x8 pack_step(const f32x16& x, int s) {
  u32x4 w;
  w[0] = cvtpk(x[8 * s + 0], x[8 * s + 1]); w[1] = cvtpk(x[8 * s + 2], x[8 * s + 3]);
  w[2] = cvtpk(x[8 * s + 4], x[8 * s + 5]); w[3] = cvtpk(x[8 * s + 6], x[8 * s + 7]);
  return __builtin_bit_cast(bf16x8, w);
}


template <typename PT>
DI void store_tile_pairs(const float (&vals)[16], PT base, unsigned rs, bool odd) {
#pragma unroll
  for (int r = 0; r < 16; r += 2) {
    const float send = odd ? vals[r] : vals[r + 1];
    const float recv = __builtin_bit_cast(float, __builtin_amdgcn_mov_dpp(__builtin_bit_cast(int, send), 0xB1, 0xF, 0xF, true));
    const float lo = odd ? recv : vals[r];
    const float hi = odd ? vals[r + 1] : recv;
    const int rc = (r & 3) + 8 * (r >> 2);
    *(unsigned*)(base + (size_t)rc * rs) = cvtpk(lo, hi);
  }
}
DI void phase1(const MP& p, char* smem) {
  const int tid = threadIdx.x, w = __builtin_amdgcn_readfirstlane(tid >> 6);
  char* atile = smem;
  float* rinv = (float*)(smem + ATILE_BYTES);
  float4 vp[XPF][4];
  auto fetch_x4 = [&](int tt_) {
    const int b_ = tt_ >> 6, s2_ = 8 * (tt_ & 7) + ((tt_ >> 3) & 7);
    const int ln_ = opq((int)threadIdx.x & 63);
#pragma unroll
    for (int rr = 0; rr < XPF; ++rr) {
      const float4* xp = (const float4*)(p.x + ((size_t)b_ * 4096 + 64 * (w * 8 + rr) + s2_) * 1024);
#pragma unroll
      for (int i = 0; i < 4; ++i) vp[rr][i] = xp[ln_ + 64 * i];
    }
    asm volatile("" ::: "memory");
  };
  if ((int)blockIdx.x < 1024) fetch_x4(blockIdx.x);
  for (int tt = blockIdx.x; tt < 1024; tt += gridDim.x) {
    const int b = tt >> 6, s2 = 8 * (tt & 7) + ((tt >> 3) & 7);
    const int lane = opq((int)threadIdx.x & 63), h = lane >> 5;
    __syncthreads();
    {
      float4 v[8][4];
#pragma unroll
      for (int rr = XPF; rr < 8; ++rr) {
        const float4* xp = (const float4*)(p.x + ((size_t)b * 4096 + 64 * (w * 8 + rr) + s2) * 1024);
#pragma unroll
        for (int i = 0; i < 4; ++i) v[rr][i] = xp[lane + 64 * i];
      }
#pragma unroll
      for (int rr = 0; rr < XPF; ++rr)
#pragma unroll
        for (int i = 0; i < 4; ++i) v[rr][i] = vp[rr][i];
#pragma unroll
      for (int rr = 0; rr < 8; ++rr) {
        const int r = w * 8 + rr;
        float s = 0.f;
#pragma unroll
        for (int i = 0; i < 4; ++i) s += v[rr][i].x * v[rr][i].x + v[rr][i].y * v[rr][i].y + v[rr][i].z * v[rr][i].z + v[rr][i].w * v[rr][i].w;
        for (int m = 32; m >= 1; m >>= 1) s += __shfl_xor(s, m, 64);
        if (lane == 0) rinv[r] = rsqrtf(s * (1.0f / 1024.f) + 1e-6f);
#pragma unroll
        for (int i = 0; i < 4; ++i) {
          u32x2 pk; pk[0] = cvtpk(v[rr][i].x, v[rr][i].y); pk[1] = cvtpk(v[rr][i].z, v[rr][i].w);
          *(u32x2*)(atile + r * ASTRIDE + (lane + 64 * i) * 8) = pk;
        }
      }
    }
    __syncthreads();
    {
      f32x4 acc[4][4];
#pragma unroll
      for (int i = 0; i < 4; ++i)
#pragma unroll
        for (int j = 0; j < 4; ++j) acc[i][j] = f32x4{0.f, 0.f, 0.f, 0.f};
      {
        const char* abase = atile + (lane & 15) * ASTRIDE + (8 * (lane >> 4)) * 2;
        const char* wb = (const char*)(p.WinF + (size_t)(4 * w) * 32 * 64);
        const __amdgpu_buffer_rsrc_t rs_wb = __builtin_amdgcn_make_buffer_rsrc((void*)wb, (short)0, 0x40000000, 0x00020000);
        const unsigned loff = (unsigned)lane * 16u;
        bf16x8 bq[4][4];
#pragma unroll
        for (int d = 0; d < 4; ++d)
#pragma unroll
          for (int nt = 0; nt < 4; ++nt) bq[d][nt] = ldbuf(rs_wb, loff, (unsigned)(nt * 32 + d) * 1024u);
#pragma unroll 1
        for (int ks0 = 0; ks0 < 32; ks0 += 4) {
#pragma unroll
          for (int d = 0; d < 4; ++d) {
            const int ks = ks0 + d;
            bf16x8 af[4];
#pragma unroll
            for (int mt = 0; mt < 4; ++mt) af[mt] = *(const bf16x8*)(abase + (16 * mt) * ASTRIDE + ks * 64);
            const unsigned ksn = opqs((unsigned)min(ks + 4, 31) * 1024u);
#pragma unroll
            for (int nt = 0; nt < 4; ++nt) {
#pragma unroll
              for (int mt = 0; mt < 4; ++mt) acc[mt][nt] = MFMA16(af[mt], bq[d][nt], acc[mt][nt]);
              bq[d][nt] = ldbuf(rs_wb, loff, (unsigned)(nt * 32) * 1024u + ksn);
            }
          }
        }
      }
      {
        const bool odd = (lane & 1) != 0;
        const int gq = lane >> 4;
        const unsigned ubase = (unsigned)((((size_t)((b >> 1) * 32 + 4 * w) * 4096 + s2 + 64 * (4 * gq + (odd ? 1 : 0))) * 32 + (b & 1) * 16 + ((lane & 15) & ~1)) * 2);
#pragma unroll
        for (int mt = 0; mt < 4; ++mt) {
          const float* rvp = rinv + opq(16 * mt + 4 * gq);
#pragma unroll
          for (int nt = 0; nt < 4; ++nt) {
            const unsigned tb = opqu(ubase + (unsigned)((16 * mt * 64 * 32 + nt * 4096 * 32) * 2));
#pragma unroll
            for (int r = 0; r < 4; r += 2) {
              const float v0 = acc[mt][nt][r] * rvp[r], v1 = acc[mt][nt][r + 1] * rvp[r + 1];
              const float send = odd ? v0 : v1;
              const float recv = __builtin_bit_cast(float, __builtin_amdgcn_mov_dpp(__builtin_bit_cast(int, send), 0xB1, 0xF, 0xF, true));
              *(unsigned*)((char*)p.U + tb + (unsigned)(r * 64 * 32 * 2)) = cvtpk(odd ? recv : v0, odd ? v1 : recv);
            }
          }
        }
      }
    }
    {
      bf16x8 xs[4][4];
      {
        f32x4 acc[4][8];
#pragma unroll
        for (int i = 0; i < 4; ++i)
#pragma unroll
          for (int j = 0; j < 8; ++j) acc[i][j] = f32x4{0.f, 0.f, 0.f, 0.f};
        {
          const int ln = opq(lane);
          const char* abase = atile + (ln & 15) * ASTRIDE + (8 * (ln >> 4)) * 2;
          const char* wb = (const char*)(p.WinF + 65536 + (size_t)(4 * w) * 32 * 64);
          const __amdgpu_buffer_rsrc_t rs_wb = __builtin_amdgcn_make_buffer_rsrc((void*)wb, (short)0, 0x40000000, 0x00020000);
          const unsigned loff = (unsigned)ln * 16u;
          bf16x8 bq[2][8];
#pragma unroll
          for (int d = 0; d < 2; ++d)
#pragma unroll
            for (int c = 0; c < 8; ++c) bq[d][c] = ldbuf(rs_wb, loff, (unsigned)(((c >> 2) * 32 + (c & 3)) * 32 + d) * 1024u);
#pragma unroll 1
          for (int ks0 = 0; ks0 < 32; ks0 += 2) {
#pragma unroll
            for (int d = 0; d < 2; ++d) {
              const int ks = ks0 + d;
              bf16x8 af[4];
#pragma unroll
              for (int mt = 0; mt < 4; ++mt) af[mt] = *(const bf16x8*)(abase + (16 * mt) * ASTRIDE + ks * 64);
              const unsigned ksn = opqs((unsigned)min(ks + 2, 31) * 1024u);
#pragma unroll
              for (int c = 0; c < 8; ++c) {
#pragma unroll
                for (int mt = 0; mt < 4; ++mt) acc[mt][c] = MFMA16(af[mt], bq[d][c], acc[mt][c]);
                bq[d][c] = ldbuf(rs_wb, loff, (unsigned)(((c >> 2) * 32 + (c & 3)) * 32) * 1024u + ksn);
              }
            }
          }
        }
        {
          const float* rvp = rinv + opq(4 * (lane >> 4));
          float rs[4][4];
#pragma unroll
          for (int mt = 0; mt < 4; ++mt)
#pragma unroll
            for (int r = 0; r < 4; ++r) rs[mt][r] = rvp[16 * mt + r];
#pragma unroll
          for (int ab = 0; ab < 2; ++ab)
#pragma unroll
            for (int t = 0; t < 2; ++t)
#pragma unroll
              for (int nt = 0; nt < 4; ++nt) {
                u32x4 wv;
#pragma unroll
                for (int jj = 0; jj < 4; ++jj) {
                  const int mt = 2 * t + (jj >> 1), r = 2 * (jj & 1);
                  wv[jj] = cvtpk(acc[mt][ab * 4 + nt][r] * rs[mt][r], acc[mt][ab * 4 + nt][r + 1] * rs[mt][r + 1]);
                }
                xs[ab * 2 + t][nt] = __builtin_bit_cast(bf16x8, wv);
              }
        }
      }
      if (tt + (int)gridDim.x < 1024) fetch_x4(tt + gridDim.x);
#pragma unroll
      for (int mh = 0; mh < 4; ++mh) {
        f32x4 t[2][4];
#pragma unroll
        for (int i = 0; i < 2; ++i)
#pragma unroll
          for (int j = 0; j < 4; ++j) t[i][j] = f32x4{0.f, 0.f, 0.f, 0.f};
        const bf16x8* mf = p.M1F + (size_t)(opq(mh * 4)) * 64 + lane;
#pragma unroll
        for (int ks = 0; ks < 4; ++ks) {
          const bf16x8 a0 = mf[ks * 64], a1 = mf[(16 + ks) * 64];
#pragma unroll
          for (int nt = 0; nt < 4; ++nt) { t[0][nt] = MFMA16(a0, xs[ks][nt], t[0][nt]); t[1][nt] = MFMA16(a1, xs[ks][nt], t[1][nt]); }
        }
        const unsigned tbase = opqu((unsigned)(((((size_t)b * 64 + 16 * mh + 4 * (lane >> 4)) * 64 + s2) * 512 + 64 * w + (lane & 15)) * 4));
#pragma unroll
        for (int nt = 0; nt < 4; ++nt)
#pragma unroll
          for (int r = 0; r < 4; ++r)
            *(unsigned*)((char*)p.T + tbase + (unsigned)(r * 64 * 512 * 4 + nt * 64)) = cvtpk(t[0][nt][r], t[1][nt][r]);
      }
    }
  }
}

#define XS_STRIDE 336
#define XS_BYTES (32 * XS_STRIDE)
#define UPF 8
typedef volatile __attribute__((address_space(3))) int* ldsflag_t;
DI void flag_wait(ldsflag_t f, int target) { while (*f < target) __builtin_amdgcn_s_sleep(1); asm volatile("" ::: "memory"); }
DI void flag_set(ldsflag_t f, int v) { asm volatile("" ::: "memory"); *f = v; asm volatile("" ::: "memory"); }
DI void phase2(const MP& p, char* smem) {
  const int tid = opq((int)threadIdx.x), lane = tid & 63, w = __builtin_amdgcn_readfirstlane(tid >> 6), h = lane >> 5;
  ldsflag_t flags = (ldsflag_t)(smem + 4 * XS_BYTES);
  if (tid < 8) flags[tid] = 0;
  *(u32x4*)(smem + (tid >> 2) * XS_STRIDE + 256 + 16 * (tid & 3)) = u32x4{0u, 0u, 0u, 0u};
  __syncthreads();
  if (w >= 6) {
    late_prep(p, ((long)blockIdx.x * 2 + (w - 6)) * 64 + lane, (long)gridDim.x * 2 * 64);
    return;
  }
  const int slot = (w < 4) ? (w >> 1) : (w - 4), role = (w < 4) ? (w & 1) : 2;
  ldsflag_t fA0 = flags + 3 * slot, fA1 = fA0 + 1, fB = fA0 + 2;
  char* xt = smem + slot * 2 * XS_BYTES;
  int round = 0;
#pragma unroll 1
  for (int t0 = blockIdx.x * 2; t0 < 512; t0 += gridDim.x * 2, ++round) {
    const int task = t0 + slot;
    if (task >= 512) break;
    const int dir = task & 1, bp = (task >> 1) & 7, g = (task >> 4) & 31;
    const int dg = dir * 32 + g;
    const int base = round * 256;
    if (role < 2) {
      const int pt = role;
      const bf16x8 bf_re = p.s5B[(size_t)(dg * 4 + 0 + pt) * 64 + lane], bf_im = p.s5B[(size_t)(dg * 4 + 2 + pt) * 64 + lane];
      const int pp = 32 * pt + (lane & 31);
      const float lr = p.s5lam[((size_t)dg * 64 + pp) * 2], li = p.s5lam[((size_t)dg * 64 + pp) * 2 + 1];
      const int rho = lane & 31;
      const int hr = (rho >> 2) & 1, rr = (rho & 3) + 4 * (rho >> 3);
      const size_t ubase = ((size_t)(bp * 32 + g) * 4096) * 32 + hr * 16 + 8 * h;
      float xr = 0.f, xi = 0.f;
      const float nli = -li;
      bf16x8 aq[UPF];
#pragma unroll
      for (int d = 0; d < UPF; ++d) { int q = 16 * d + rr; int tpos = dir ? (4095 - q) : q; aq[d] = *(const bf16x8*)(p.U + ubase + (size_t)tpos * 32); }
      ldsflag_t fmine = pt ? fA1 : fA0;
      f32x16 bacc[2][2];
      bacc[0][0] = MFMA32(aq[0], bf_re, zero16());
      bacc[0][1] = MFMA32(aq[0], bf_im, zero16());
      bf16x8 uc = aq[0];
      const unsigned uoff = (unsigned)((hr * 16 + rr) * XS_STRIDE + 256 + 16 * h);
      { int q = 16 * UPF + rr; int tpos = dir ? (4095 - q) : q; aq[0] = *(const bf16x8*)(p.U + ubase + (size_t)tpos * 32); }
#pragma unroll 1
      for (int step0 = 0; step0 < 256; step0 += UPF) {
#pragma unroll
        for (int d = 0; d < UPF; ++d) {
          const int step = step0 + d;
          const int cur = d & 1, nxt = cur ^ 1, sl = (d + 1) & (UPF - 1);
          const bf16x8 un = aq[sl];
          bacc[nxt][0] = MFMA32(un, bf_re, zero16());
          bacc[nxt][1] = MFMA32(un, bf_im, zero16());
          { int q = 16 * min(step + 1 + UPF, 255) + rr; int tpos = dir ? (4095 - q) : q; aq[sl] = *(const bf16x8*)(p.U + ubase + (size_t)tpos * 32); }
          flag_wait(fB, base + step - 1);
          char* xrow = xt + (d & 1) * XS_BYTES + (h * 16) * XS_STRIDE + (pt * 64 + 2 * (lane & 31)) * 2;
          if (pt == 0) *(bf16x8*)(xt + (d & 1) * XS_BYTES + uoff) = uc;
          uc = un;
#pragma unroll
          for (int r = 0; r < 16; ++r) {
            float ir = fmaf(nli, xi, bacc[cur][0][r]);
            float ii = fmaf(li, xr, bacc[cur][1][r]);
            asm volatile("" : "+v"(ir));
            asm volatile("" : "+v"(ii));
            float nr = fmaf(lr, xr, ir);
            float ni = fmaf(lr, xi, ii);
            asm volatile("" : "+v"(nr));
            asm volatile("" : "+v"(ni));
            xr = nr; xi = ni;
            *(unsigned*)(xrow + r * XS_STRIDE) = cvtpk(xr, xi);
          }
          flag_set(fmine, base + step + 1);
        }
      }
    } else {
      bf16x8 cf[5];
#pragma unroll
      for (int ks = 0; ks < 4; ++ks) cf[ks] = p.s5C[(size_t)(dg * 4 + ks) * 64 + lane];
      {
        const float dv = dir ? 0.f : p.ssm_d[g * 16 + (lane & 15)];
        u32x4 cw;
#pragma unroll
        for (int q = 0; q < 4; ++q) {
          const int k0 = 8 * (lane >> 4) + 2 * q;
          cw[q] = cvtpk(k0 == (lane & 15) ? dv : 0.f, k0 + 1 == (lane & 15) ? dv : 0.f);
        }
        cf[4] = __builtin_bit_cast(bf16x8, cw);
      }
      unsigned short* yo = dir ? p.YB : p.YF;
      const bool odd = (lane & 1) != 0;
      const unsigned xoff = (unsigned)((lane & 15) * XS_STRIDE + (8 * (lane >> 4)) * 2);
      auto fetch = [&](bf16x8 (&xa)[2][5], int step) {
        flag_wait(fA0, base + step + 1);
        flag_wait(fA1, base + step + 1);
        const char* xb = xt + (step & 1) * XS_BYTES + xoff;
#pragma unroll
        for (int mt = 0; mt < 2; ++mt)
#pragma unroll
          for (int ks = 0; ks < 5; ++ks) xa[mt][ks] = *(const bf16x8*)(xb + (mt * 16) * XS_STRIDE + (32 * ks) * 2);
        flag_set(fB, base + step + 1);
      };
      auto mma = [&](const bf16x8 (&xa)[2][5], f32x4 (&y)[2]) {
#pragma unroll
        for (int mt = 0; mt < 2; ++mt) y[mt] = f32x4{0.f, 0.f, 0.f, 0.f};
#pragma unroll
        for (int ks = 0; ks < 5; ++ks)
#pragma unroll
          for (int mt = 0; mt < 2; ++mt) y[mt] = MFMA16(xa[mt][ks], cf[ks], y[mt]);
      };
      auto emit = [&](const f32x4 (&y)[2], int step) {
#pragma unroll
        for (int mt = 0; mt < 2; ++mt)
#pragma unroll
          for (int r = 0; r < 4; r += 2) {
            const float send = odd ? y[mt][r] : y[mt][r + 1];
            const float recv = __builtin_bit_cast(float, __builtin_amdgcn_mov_dpp(__builtin_bit_cast(int, send), 0xB1, 0xF, 0xF, true));
            const float lo = odd ? recv : y[mt][r], hi = odd ? y[mt][r + 1] : recv;
            const int q = 16 * step + 4 * (lane >> 4) + r + (odd ? 1 : 0);
            const int tpos = dir ? (4095 - q) : q;
            *(unsigned*)(yo + ((size_t)(2 * bp + mt) * 4096 + tpos) * 512 + g * 16 + ((lane & 15) & ~1)) = cvtpk(lo, hi);
          }
      };
      bf16x8 xe[2][5], xo[2][5];
      f32x4 ye[2], yd[2];
      fetch(xe, 0);
      mma(xe, ye);
      fetch(xo, 1);
#pragma unroll 1
      for (int step = 1; step < 255; step += 2) {
        mma(xo, yd);
        emit(ye, step - 1);
        fetch(xe, step + 1);
        mma(xe, ye);
        emit(yd, step);
        fetch(xo, step + 2);
      }
      mma(xo, yd);
      emit(ye, 254);
      emit(yd, 255);
    }
  }
}

DI int f2key(float f) { return __float_as_int(__builtin_amdgcn_fmed3f(f, -60.f, 60.f) + 64.f); }
DI float key2f(int k) { return __int_as_float(k) - 64.f; }
#define CE_DESC(a, b) { int mx_ = max(a, b), mn_ = min(a, b); a = mx_; b = mn_; }
#define CE_ASC(a, b) { int mx_ = max(a, b), mn_ = min(a, b); a = mn_; b = mx_; }

#define S16(i, j) CE_DESC(v[i], v[j])
DI void sort16_desc(int (&v)[16]) {
  S16(0,13) S16(1,12) S16(2,15) S16(3,14) S16(4,8) S16(5,6) S16(7,11) S16(9,10)
  S16(0,5) S16(1,7) S16(2,9) S16(3,4) S16(6,13) S16(8,14) S16(10,15) S16(11,12)
  S16(0,1) S16(2,3) S16(4,5) S16(6,8) S16(7,9) S16(10,11) S16(12,13) S16(14,15)
  S16(0,2) S16(1,3) S16(4,10) S16(5,11) S16(6,7) S16(8,9) S16(12,14) S16(13,15)
  S16(1,2) S16(3,12) S16(4,6) S16(5,7) S16(8,10) S16(9,11) S16(13,14)
  S16(1,4) S16(2,6) S16(5,8) S16(7,10) S16(9,13) S16(11,14)
  S16(2,4) S16(3,6) S16(9,12) S16(11,13)
  S16(3,5) S16(6,8) S16(7,9) S16(10,12)
  S16(3,4) S16(5,6) S16(7,8) S16(9,10) S16(11,12)
  S16(6,7) S16(8,9)
}
DI void merge16_desc(int (&a)[16], const int (&b)[16]) {
#pragma unroll
  for (int i = 0; i < 16; ++i) a[i] = max(a[i], b[15 - i]);
#pragma unroll
  for (int j = 8; j > 0; j >>= 1) {
#pragma unroll
    for (int i = 0; i < 16; ++i) {
      const int l = i ^ j;
      if (l > i) { CE_DESC(a[i], a[l]); }
    }
  }
}
DI void top16_of_64(const int (&k)[64], int (&out)[16]) {
  int g1[16], g2[16], g3[16];
#pragma unroll
  for (int i = 0; i < 16; ++i) { out[i] = k[i]; g1[i] = k[16 + i]; g2[i] = k[32 + i]; g3[i] = k[48 + i]; }
  sort16_desc(out); sort16_desc(g1); sort16_desc(g2); sort16_desc(g3);
  merge16_desc(out, g1); merge16_desc(g2, g3); merge16_desc(out, g2);
}

DI float reduce_scatter32(float (&v)[32], int lane) {
  float a[16];
  {
    const bool up = (lane & 16) != 0;
#pragma unroll
    for (int i = 0; i < 16; ++i) { float keep = up ? v[16 + i] : v[i]; float send = up ? v[i] : v[16 + i]; a[i] = keep + __shfl_xor(send, 16, 64); }
  }
  float b[8];
  {
    const bool up = (lane & 8) != 0;
#pragma unroll
    for (int i = 0; i < 8; ++i) { float keep = up ? a[8 + i] : a[i]; float send = up ? a[i] : a[8 + i]; b[i] = keep + __shfl_xor(send, 8, 64); }
  }
  float c[4];
  {
    const bool up = (lane & 4) != 0;
#pragma unroll
    for (int i = 0; i < 4; ++i) { float keep = up ? b[4 + i] : b[i]; float send = up ? b[i] : b[4 + i]; c[i] = keep + __shfl_xor(send, 4, 64); }
  }
  float d[2];
  {
    const bool up = (lane & 2) != 0;
#pragma unroll
    for (int i = 0; i < 2; ++i) { float keep = up ? c[2 + i] : c[i]; float send = up ? c[i] : c[2 + i]; d[i] = keep + __shfl_xor(send, 2, 64); }
  }
  {
    const bool up = (lane & 1) != 0;
    float keep = up ? d[1] : d[0]; float send = up ? d[0] : d[1];
    return keep + __shfl_xor(send, 1, 64);
  }
}
DI float reduce_scatter64(float (&v)[64], int lane) {
  float a[32];
  const bool up = (lane & 32) != 0;
#pragma unroll
  for (int i = 0; i < 32; ++i) { float keep = up ? v[32 + i] : v[i]; float send = up ? v[i] : v[32 + i]; a[i] = keep + __shfl_xor(send, 32, 64); }
  return reduce_scatter32(a, lane);
}

__host__ __device__ constexpr int cand_ij(int c) {
  int n = 0;
  for (int a = 0; a < 16; ++a)
    for (int b = 0; b < 16; ++b)
      if ((a + 1) * (b + 1) <= 16) { if (n == c) return a * 16 + b; ++n; }
  return 0;
}
__host__ __device__ constexpr int cand_index(int i, int j) {
  int n = 0;
  for (int a = 0; a < 16; ++a)
    for (int b = 0; b < 16; ++b)
      if ((a + 1) * (b + 1) <= 16) { if (a == i && b == j) return n; ++n; }
  return n;
}
static_assert(cand_index(15, 0) == 49, "50 candidates");
DI float erf_as(float z) {
  const float az = fabsf(z);
  const float t = __builtin_amdgcn_rcpf(fmaf(0.3275911f, az, 1.0f));
  float pl = fmaf(1.061405429f, t, -1.453152027f);
  pl = fmaf(pl, t, 1.421413741f);
  pl = fmaf(pl, t, -0.284496736f);
  pl = fmaf(pl, t, 0.254829592f);
  pl *= t;
  const float ex = __expf(-az * az);
  const float r = fmaf(-pl, ex, 1.0f);
  return copysignf(r, z);
}
DI float gelu_f(float x) { return 0.5f * x * (1.0f + erf_as(x * 0.70710678118654752440f)); }

DI void phase3(const MP& p, char* smem) {
  const int tid = opq((int)threadIdx.x), lane = tid & 63, w = __builtin_amdgcn_readfirstlane(tid >> 6), h = lane >> 5;
  char* atile = smem;
  float* rinv2 = (float*)(smem + ATILE_BYTES);
  float* part = rinv2 + 64;
  for (int tt = blockIdx.x; tt < 1024; tt += gridDim.x) {
    const int b = tt >> 6, k1 = tt & 63;
    const size_t tok0 = (size_t)b * 4096 + k1;
    __syncthreads();
#pragma unroll
    for (int it = 0; it < 8; ++it) {
      int chunk = opq(tid + NTHR * it);
      int r = chunk >> 6, c8 = chunk & 63;
      size_t off = (tok0 + 64 * (size_t)r) * 512 + c8 * 8;
      u32x4 yf = *(const u32x4*)(p.YF + off), yb = *(const u32x4*)(p.YB + off);
      u32x4 o;
#pragma unroll
      for (int q = 0; q < 4; ++q) {
        float lo = bflo(yf[q]) + bflo(yb[q]);
        float hi = bfhi(yf[q]) + bfhi(yb[q]);
        o[q] = cvtpk(gelu_f(lo), gelu_f(hi));
      }
      *(u32x4*)(atile + r * ASTRIDE + c8 * 16) = o;
    }
    __syncthreads();
    f32x16 gacc[2][2];
#pragma unroll
    for (int i = 0; i < 2; ++i)
#pragma unroll
      for (int j = 0; j < 2; ++j) gacc[i][j] = zero16();
    gemm_tile<2, 4>(gacc, atile, 0, p.WgluF + (size_t)(2 * w) * 32 * 64, 32, 32, opq(lane));
    {
      f32x16 facc[2][2];
#pragma unroll
      for (int i = 0; i < 2; ++i)
#pragma unroll
        for (int j = 0; j < 2; ++j) facc[i][j] = zero16();
      const int lnf = opq(lane);
      const unsigned short* m3 = p.M3T + ((size_t)k1 + 64 * (size_t)(lnf & 31)) * 128 + 8 * (lnf >> 5);
      const unsigned* tb = (const unsigned*)p.T + (((size_t)b * 64 + k1) * 64 + 4 * (lnf >> 5)) * 512 + 64 * w + (lnf & 31);
#pragma unroll 4
      for (int ks = 0; ks < 8; ++ks) {
        bf16x8 a0 = *(const bf16x8*)(m3 + 16 * ks);
        bf16x8 a1 = *(const bf16x8*)(m3 + (size_t)32 * 64 * 128 + 16 * ks);
        u32x4 b0w, b1w;
#pragma unroll
        for (int jj = 0; jj < 4; ++jj) {
          b0w[jj] = tb[((size_t)8 * ks + jj) * 512];
          b1w[jj] = tb[((size_t)8 * ks + jj) * 512 + 32];
        }
        const bf16x8 b0 = __builtin_bit_cast(bf16x8, b0w), b1 = __builtin_bit_cast(bf16x8, b1w);
        facc[0][0] = MFMA32(a0, b0, facc[0][0]); facc[1][0] = MFMA32(a1, b0, facc[1][0]);
        facc[0][1] = MFMA32(a0, b1, facc[0][1]); facc[1][1] = MFMA32(a1, b1, facc[1][1]);
      }
#pragma unroll
      for (int mt = 0; mt < 2; ++mt)
#pragma unroll
        for (int nt = 0; nt < 2; ++nt)
#pragma unroll
          for (int r = 0; r < 16; ++r) {
            int row = 32 * mt + crow(r, lnf >> 5), col = 512 + 64 * w + 32 * nt + (lnf & 31);
            *(unsigned short*)(atile + row * ASTRIDE + col * 2) = f2bf(facc[mt][nt][r]);
          }
    }
    __syncthreads();
    {
    const int lng = opq(lane);
#pragma unroll
    for (int mt = 0; mt < 2; ++mt)
#pragma unroll
      for (int nt = 0; nt < 2; ++nt)
#pragma unroll
        for (int r = 0; r < 16; ++r) {
          int row = 32 * mt + crow(r, lng >> 5), col = 64 * w + 32 * nt + (lng & 31);
          unsigned short* q = (unsigned short*)(atile + row * ASTRIDE + col * 2);
          float yv = bf2f(*q);
          *q = f2bf(yv / (1.0f + __expf(-gacc[mt][nt][r])));
        }
    }
    __syncthreads();
    {
      f32x4 acc[4][8];
#pragma unroll
      for (int i = 0; i < 4; ++i)
#pragma unroll
        for (int j = 0; j < 8; ++j) acc[i][j] = f32x4{0.f, 0.f, 0.f, 0.f};
      {
        const int ln = opq(lane);
        const char* abase = atile + (ln & 15) * ASTRIDE + (8 * (ln >> 4)) * 2;
        const char* wb = (const char*)(p.WoutF + (size_t)(8 * w) * 32 * 64);
        const __amdgpu_buffer_rsrc_t rs_wb = __builtin_amdgcn_make_buffer_rsrc((void*)wb, (short)0, 0x40000000, 0x00020000);
        const unsigned loff = (unsigned)ln * 16u;
        bf16x8 bq[2][8];
#pragma unroll
        for (int d = 0; d < 2; ++d)
#pragma unroll
          for (int nt = 0; nt < 8; ++nt) bq[d][nt] = ldbuf(rs_wb, loff, (unsigned)(nt * 32 + d) * 1024u);
#pragma unroll 1
        for (int ks0 = 0; ks0 < 32; ks0 += 2) {
#pragma unroll
          for (int d = 0; d < 2; ++d) {
            const int ks = ks0 + d;
            bf16x8 af[4];
#pragma unroll
            for (int mt = 0; mt < 4; ++mt) af[mt] = *(const bf16x8*)(abase + (16 * mt) * ASTRIDE + ks * 64);
            const unsigned ksn = opqs((unsigned)min(ks + 2, 31) * 1024u);
#pragma unroll
            for (int nt = 0; nt < 8; ++nt) {
#pragma unroll
              for (int mt = 0; mt < 4; ++mt) acc[mt][nt] = MFMA16(af[mt], bq[d][nt], acc[mt][nt]);
              bq[d][nt] = ldbuf(rs_wb, loff, (unsigned)(nt * 32) * 1024u + ksn);
            }
          }
        }
      }
      __syncthreads();
      {
        const int lnd = opq(lane);
        const bool odd = (lnd & 1) != 0;
#pragma unroll
        for (int mt = 0; mt < 4; ++mt)
#pragma unroll
          for (int nt = 0; nt < 8; ++nt) {
            char* lb = atile + opq((16 * mt + 4 * (lnd >> 4) + (odd ? 1 : 0)) * ASTRIDE + (128 * w + 16 * nt + ((lnd & 15) & ~1)) * 2);
#pragma unroll
            for (int r = 0; r < 4; r += 2) {
              const float v0 = acc[mt][nt][r], v1 = acc[mt][nt][r + 1];
              const float send = odd ? v0 : v1;
              const float recv = __builtin_bit_cast(float, __builtin_amdgcn_mov_dpp(__builtin_bit_cast(int, send), 0xB1, 0xF, 0xF, true));
              *(unsigned*)(lb + r * ASTRIDE) = cvtpk(odd ? recv : v0, odd ? v1 : recv);
            }
          }
      }
    }
    __syncthreads();
#pragma unroll 4
    for (int it = 0; it < 16; ++it) {
      const int chunk = opq(tid + NTHR * it);
      const int r = chunk >> 7, c8 = chunk & 127;
      char* lp = atile + r * ASTRIDE + c8 * 16;
      const u32x4 mb = *(const u32x4*)lp;
      const size_t go = (tok0 + 64 * (size_t)r) * 1024 + c8 * 8;
      const float4 xa = *(const float4*)(p.x + go), xc = *(const float4*)(p.x + go + 4);
      float v[8] = {xa.x + bflo(mb[0]), xa.y + bfhi(mb[0]), xa.z + bflo(mb[1]), xa.w + bfhi(mb[1]),
                    xc.x + bflo(mb[2]), xc.y + bfhi(mb[2]), xc.z + bflo(mb[3]), xc.w + bfhi(mb[3])};
      float sq = 0.f;
#pragma unroll
      for (int e = 0; e < 8; ++e) sq = fmaf(v[e], v[e], sq);
      for (int m = 32; m >= 1; m >>= 1) sq += __shfl_xor(sq, m, 64);
      if (lane == 0) part[(w & 1) * 64 + r] = sq;
      u32x4 xb;
#pragma unroll
      for (int q = 0; q < 4; ++q) xb[q] = cvtpk(v[2 * q], v[2 * q + 1]);
      *(u32x4*)lp = xb;
      *(u32x4*)(p.X2B + go) = xb;
      unsigned hw[2];
#pragma unroll
      for (int q = 0; q < 2; ++q) {
        hw[q] = 0u;
#pragma unroll
        for (int e = 0; e < 4; ++e) {
          const unsigned wv = xb[2 * q + (e >> 1)];
          const float x32 = ((e & 1) ? bfhi(wv) : bflo(wv)) * 32.f;
          const float hf = rintf(__builtin_amdgcn_fmed3f(x32, -127.f, 127.f));
          hw[q] |= ((unsigned)((int)hf & 0xff)) << (8 * e);
        }
      }
      u32x2 hv = {hw[0], hw[1]};
      *(u32x2*)(p.X8H + go) = hv;
    }
    __syncthreads();
    if (tid < 64) rinv2[tid] = rsqrtf((part[tid] + part[64 + tid]) * (1.0f / 1024.f) + 1e-6f);
    __syncthreads();
    int sk[2][16];
    {
    const int gq = lane >> 4;
    const bool hi2 = (gq & 2) != 0, hi1 = (gq & 1) != 0;
#pragma unroll
    for (int pq = 0; pq < 2; ++pq) {
      int run[16];
#pragma unroll
      for (int half = 0; half < 2; ++half) {
        f32x4 acc[4][4];
#pragma unroll
        for (int i = 0; i < 4; ++i)
#pragma unroll
          for (int j = 0; j < 4; ++j) acc[i][j] = f32x4{0.f, 0.f, 0.f, 0.f};
        {
          const int ln = opq(lane);
          const char* bbase = atile + (ln & 15) * ASTRIDE + (8 * (ln >> 4)) * 2;
          const char* wq = (const char*)(p.WqkF + (size_t)((2 * w + pq) * 8 + 4 * half) * 32 * 64);
          const __amdgpu_buffer_rsrc_t rs_wq = __builtin_amdgcn_make_buffer_rsrc((void*)wq, (short)0, 0x40000000, 0x00020000);
          const unsigned loff = (unsigned)ln * 16u;
          asm volatile("" ::: "memory");
          bf16x8 aq[2][4];
#pragma unroll
          for (int d = 0; d < 2; ++d)
#pragma unroll
            for (int mt = 0; mt < 4; ++mt) aq[d][mt] = ldbuf(rs_wq, loff, (unsigned)(mt * 32 + d) * 1024u);
#pragma unroll 1
          for (int ks0 = 0; ks0 < 32; ks0 += 2) {
#pragma unroll
            for (int d = 0; d < 2; ++d) {
              const int ks = ks0 + d;
              const unsigned ksn = opqs((unsigned)min(ks + 2, 31) * 1024u);
              {
                const bf16x8 x0 = *(const bf16x8*)(bbase + ks * 64), x1 = *(const bf16x8*)(bbase + 16 * ASTRIDE + ks * 64);
#pragma unroll
                for (int mt = 0; mt < 4; ++mt) { acc[mt][0] = MFMA16(aq[d][mt], x0, acc[mt][0]); acc[mt][1] = MFMA16(aq[d][mt], x1, acc[mt][1]); }
              }
              asm volatile("" ::: "memory");
              {
                const bf16x8 x2 = *(const bf16x8*)(bbase + 32 * ASTRIDE + ks * 64), x3 = *(const bf16x8*)(bbase + 48 * ASTRIDE + ks * 64);
#pragma unroll
                for (int mt = 0; mt < 4; ++mt) {
                  acc[mt][2] = MFMA16(aq[d][mt], x2, acc[mt][2]); acc[mt][3] = MFMA16(aq[d][mt], x3, acc[mt][3]);
                  aq[d][mt] = ldbuf(rs_wq, loff, (unsigned)(mt * 32) * 1024u + ksn);
                }
              }
            }
          }
        }
        {
          const int gb = opq(4 * gq);
          int kp2[2][16];
#pragma unroll
          for (int q = 0; q < 2; ++q) {
            int la[16], lb[16];
#pragma unroll
            for (int mt = 0; mt < 4; ++mt)
#pragma unroll
              for (int r = 0; r < 4; ++r) {
                la[4 * mt + r] = (f2key(acc[mt][q][r]) & ~0x7f) | (64 * half + 16 * mt + r) | gb;
                lb[4 * mt + r] = (f2key(acc[mt][2 + q][r]) & ~0x7f) | (64 * half + 16 * mt + r) | gb;
              }
            sort16_desc(la);
            sort16_desc(lb);
            int kp[16], other[16];
#pragma unroll
            for (int i = 0; i < 16; ++i) {
              const int give = hi2 ? la[i] : lb[i];
              kp[i] = hi2 ? lb[i] : la[i];
              other[i] = __shfl_xor(give, 32, 64);
            }
            merge16_desc(kp, other);
#pragma unroll
            for (int i = 0; i < 16; ++i) kp2[q][i] = kp[i];
          }
          int mine[16], oth2[16];
#pragma unroll
          for (int i = 0; i < 16; ++i) {
            const int give = hi1 ? kp2[0][i] : kp2[1][i];
            mine[i] = hi1 ? kp2[1][i] : kp2[0][i];
            oth2[i] = __shfl_xor(give, 16, 64);
          }
          merge16_desc(mine, oth2);
          if (half == 0) {
#pragma unroll
            for (int i = 0; i < 16; ++i) run[i] = mine[i];
          } else {
            merge16_desc(run, mine);
          }
        }
      }
#pragma unroll
      for (int i = 0; i < 16; ++i) sk[pq][i] = run[i];
      if (pq == 0) {
        int* st = (int*)(smem + ATILE_BYTES + 64 * 4 + 8 * 64 * 4) + tid;
#pragma unroll
        for (int i = 0; i < SK_STASH; ++i) { st[i * 512] = sk[0][i]; sk[0][i] = 0; }
        asm volatile("" ::: "memory");
      }
    }
    {
      const int* st = (const int*)(smem + ATILE_BYTES + 64 * 4 + 8 * 64 * 4) + tid;
      asm volatile("" ::: "memory");
#pragma unroll
      for (int i = 0; i < SK_STASH; ++i) sk[0][i] = st[i * 512];
    }
    }
    {
      float v0[16], v1[16];
      unsigned i0p[4], i1p[4];
      {
        int s0[16], s1[16];
#pragma unroll
        for (int i = 0; i < 16; ++i) { s0[i] = sk[0][i]; s1[i] = sk[1][i]; }
        const float sc = rinv2[32 * h + (lane & 31)];
#pragma unroll
        for (int i = 0; i < 16; ++i) { v0[i] = key2f(s0[i] & ~0x7f) * sc; v1[i] = key2f(s1[i] & ~0x7f) * sc; }
#pragma unroll
        for (int q = 0; q < 4; ++q) {
          i0p[q] = (unsigned)(s0[4 * q] & 0x7f) | ((unsigned)(s0[4 * q + 1] & 0x7f) << 8) | ((unsigned)(s0[4 * q + 2] & 0x7f) << 16) | ((unsigned)(s0[4 * q + 3] & 0x7f) << 24);
          i1p[q] = (unsigned)(s1[4 * q] & 0x7f) | ((unsigned)(s1[4 * q + 1] & 0x7f) << 8) | ((unsigned)(s1[4 * q + 2] & 0x7f) << 16) | ((unsigned)(s1[4 * q + 3] & 0x7f) << 24);
        }
      }
      int top[16];
#pragma unroll
      for (int grp = 0; grp < 4; ++grp) {
        int g[16];
#pragma unroll
        for (int t = 0; t < 16; ++t) {
          const int c = 16 * grp + t;
          if (c < 50) { const int ij = cand_ij(c); g[t] = (f2key(v0[ij >> 4] + v1[ij & 15]) & ~0xff) | ij; }
          else g[t] = (int)0x80000000;
        }
        sort16_desc(g);
        if (grp == 0) {
#pragma unroll
          for (int t = 0; t < 16; ++t) top[t] = g[t];
        } else {
          merge16_desc(top, g);
        }
      }
      float sum = 0.f;
      float mx = key2f(top[0] & ~0xff);
      float ev[16];
#pragma unroll
      for (int r = 0; r < 16; ++r) { ev[r] = __expf(key2f(top[r] & ~0xff) - mx); sum += ev[r]; }
      const float inv = 1.0f / sum;
      u32x4 o[4];
#pragma unroll
      for (int r = 0; r < 16; ++r) {
        int code = top[r] & 0xff, ci = code >> 4, cj = code & 15;
        unsigned w0 = (ci >> 2) == 0 ? i0p[0] : (ci >> 2) == 1 ? i0p[1] : (ci >> 2) == 2 ? i0p[2] : i0p[3];
        unsigned w1 = (cj >> 2) == 0 ? i1p[0] : (cj >> 2) == 1 ? i1p[1] : (cj >> 2) == 2 ? i1p[2] : i1p[3];
        unsigned e0 = (w0 >> ((ci & 3) * 8)) & 0x7f, e1 = (w1 >> ((cj & 3) * 8)) & 0x7f;
        unsigned e = e0 * 128 + e1;
        o[r >> 2][r & 3] = (e << 16) | (cvtpk(ev[r] * inv, 0.f) & 0xffffu);
      }
      const int lnp = opq(lane);
      unsigned* pr = p.PAIRS + (tok0 + 64 * (size_t)(32 * (lnp >> 5) + (lnp & 31))) * 128 + w * 16;
#pragma unroll
      for (int q = 0; q < 4; ++q) *(u32x4*)(pr + 4 * q) = o[q];
      {
        u32x4 e0, e1;
#pragma unroll
        for (int q = 0; q < 4; ++q) {
          e0[q] = (o[q >> 1][2 * (q & 1)] >> 16) | (o[q >> 1][2 * (q & 1) + 1] & 0xffff0000u);
          e1[q] = (o[2 + (q >> 1)][2 * (q & 1)] >> 16) | (o[2 + (q >> 1)][2 * (q & 1) + 1] & 0xffff0000u);
        }
        unsigned short* er = p.E16 + (tok0 + 64 * (size_t)(32 * (lnp >> 5) + (lnp & 31))) * 128 + w * 16;
        *(u32x4*)er = e0; *(u32x4*)(er + 8) = e1;
      }
    }
    if (tid < 64) p.RINV2[tok0 + 64 * (size_t)tid] = rinv2[tid];
  }
}


#define XB_TMO      128
#define XB_XCNT(j)  (256  + 64 * (j))
#define XB_XSUB(j)  (1280 + 64 * (j))
#define XB_XGEN(j)  (2304 + 64 * (j))
#define XB_TOP      3328
#define XB_TOPGEN   3392
#define XCD_BAR_WORDS 3456
#define XB_SPIN_CAP (1u << 22)
#define LAS __attribute__((address_space(3)))
DI unsigned xb_ld(unsigned* p) { return __hip_atomic_load(p, __ATOMIC_RELAXED, __HIP_MEMORY_SCOPE_AGENT); }
DI unsigned xb_add(unsigned* p, unsigned v) { return __hip_atomic_fetch_add(p, v, __ATOMIC_RELAXED, __HIP_MEMORY_SCOPE_AGENT); }
DI unsigned xb_xcc_id() { return (unsigned)__builtin_amdgcn_s_getreg((3 << 11) | 20) & 0xFu; }
#define XB_SPIN(cond, bar) do { unsigned _sp = 0; while (cond) { __builtin_amdgcn_s_sleep(1); \
    if ((++_sp & 255u) == 0u) { if (xb_ld(&(bar)[XB_TMO])) break; if (_sp > XB_SPIN_CAP) { atomicAdd(&(bar)[XB_TMO], 1u); break; } } } } while (0)
struct XcdBarrier { unsigned* bar; unsigned x; volatile LAS unsigned* st; };
DI XcdBarrier xcd_barrier_post(unsigned* bar, volatile LAS unsigned* st) {
  XcdBarrier b; b.bar = bar; b.x = xb_xcc_id(); b.st = st;
  if (threadIdx.x == 0) (void)xb_add(&bar[XB_XCNT(b.x)], 1u);
  return b;
}
DI void xcd_barrier_complete(unsigned* bar, unsigned x, unsigned& nloc, unsigned& nx) {
  const unsigned G = gridDim.x * gridDim.y * gridDim.z;
  unsigned sum, cnt, mine, sp = 0u;
  for (;;) {
    sum = 0u; cnt = 0u; mine = 0u;
#pragma unroll
    for (unsigned j = 0; j < 16; ++j) { const unsigned c = xb_ld(&bar[XB_XCNT(j)]); sum += c; cnt += (c > 0u) ? 1u : 0u; mine = (j == x) ? c : mine; }
    if (sum == G) break;
    __builtin_amdgcn_s_sleep(1);
    if ((++sp & 255u) == 0u) { if (xb_ld(&bar[XB_TMO])) break; if (sp > XB_SPIN_CAP) { atomicAdd(&bar[XB_TMO], 1u); break; } }
  }
  nloc = mine > 0u ? mine : 1u; nx = cnt > 0u ? cnt : 1u;
}
DI void xcd_barrier(const XcdBarrier& b) {
  asm volatile("s_waitcnt vmcnt(0)" ::: "memory");
  __syncthreads();
  if (threadIdx.x == 0) {
    unsigned* bar = b.bar;
    __builtin_amdgcn_s_waitcnt(0);
    unsigned nloc = b.st[0], nx = b.st[1];
    if (nloc == 0u) { xcd_barrier_complete(bar, b.x, nloc, nx); b.st[0] = nloc; b.st[1] = nx; }
    const unsigned old = xb_add(&bar[XB_XSUB(b.x)], 1u);
    const unsigned gen = old / nloc;
    if (old + 1u == (gen + 1u) * nloc) {
      __builtin_amdgcn_fence(__ATOMIC_RELEASE, "agent");
      asm volatile("s_waitcnt vmcnt(0)" ::: "memory");
      const unsigned og = xb_add(&bar[XB_TOP], 1u);
      const unsigned tg = og / nx;
      if (og + 1u == (tg + 1u) * nx) xb_add(&bar[XB_TOPGEN], 1u);
      else XB_SPIN(xb_ld(&bar[XB_TOPGEN]) == tg, bar);
      __builtin_amdgcn_fence(__ATOMIC_ACQUIRE, "agent");
      xb_add(&bar[XB_XGEN(b.x)], 1u);
      asm volatile("s_waitcnt vmcnt(0)" ::: "memory");
    } else {
      XB_SPIN(xb_ld(&bar[XB_XGEN(b.x)]) == gen, bar);
      __builtin_amdgcn_fence(__ATOMIC_ACQUIRE, "agent");
      asm volatile("s_waitcnt vmcnt(0)" ::: "memory");
    }
  }
  __syncthreads();
}

DI f32x2_t dec_lo(unsigned w) { return __builtin_amdgcn_cvt_pk_f32_fp8((int)w, false); }
DI f32x2_t dec_hi(unsigned w) { return __builtin_amdgcn_cvt_pk_f32_fp8((int)w, true); }
#define PCHUNK 16
#define NPCHUNK (NTOK / PCHUNK)
#define DPP_XOR1 0xB1
#define DPP_XOR2 0x4E
#define DPP_HALF_MIRROR 0x141
#define DPP_ROR8 0x128
template <int CTRL> DI int dpp_i(int v) { return __builtin_amdgcn_mov_dpp(v, CTRL, 0xF, 0xF, true); }
template <int CTRL> DI float dpp_f(float v) { return __builtin_bit_cast(float, __builtin_amdgcn_mov_dpp(__builtin_bit_cast(int, v), CTRL, 0xF, 0xF, true)); }
DI void phase4(const MP& p, char* smem) {
  const int tid4 = opq((int)threadIdx.x);
  const int lane = tid4 & 63, w = __builtin_amdgcn_readfirstlane(tid4 >> 6), g = lane >> 3, i = lane & 7;
  const unsigned xcc = xb_xcc_id() & 7u;
  const unsigned loff = 16u * (unsigned)i;
  char* stg = smem + w * 8192;
#pragma unroll 1
  for (int s = 0; s < 8; ++s) {
    const int slice = (int)((xcc + s) & 7u);
    unsigned* ctr = p.CTR + (size_t)slice * 64;
    const unsigned char* tbs = p.EU + (size_t)slice * 16384 * 128;
    _Float16* pre = (_Float16*)p.PRE + (size_t)slice * NTOK * 128 + 16 * g + 2 * i;
#pragma unroll 1
    for (;;) {
      unsigned c = 0;
      if (lane == 0) c = atomicAdd(ctr, 1u);
      c = (unsigned)__builtin_amdgcn_readfirstlane((int)c);
      if (c >= NPCHUNK) break;
      const size_t tokb = (size_t)c * PCHUNK;
      {
        const u32x4* ep = (const u32x4*)(p.E16 + tokb * 128) + lane;
        u32x4 ev[4], hv[2];
#pragma unroll
        for (int j = 0; j < 4; ++j) ev[j] = ep[64 * j];
#pragma unroll
        for (int j = 0; j < 2; ++j) {
          const size_t xo = (tokb + 8 * j + (lane >> 3)) * 1024 + 128 * slice + loff;
          hv[j] = *(const u32x4*)(p.X8H + xo);
        }
        __builtin_amdgcn_wave_barrier();
#pragma unroll
        for (int j = 0; j < 4; ++j) *(u32x4*)(stg + 1024 * j + 16 * lane) = ev[j];
#pragma unroll
        for (int j = 0; j < 2; ++j) *(u32x4*)(stg + 4096 + 1024 * j + 16 * lane) = hv[j];
        __builtin_amdgcn_wave_barrier();
      }
      auto ld_tok = [&](u32x4 (&ua)[16], int tt) {
        const u32x4 pw0 = *(const u32x4*)(stg + 256 * tt + 32 * g), pw1 = *(const u32x4*)(stg + 256 * tt + 32 * g + 16);
#pragma unroll
        for (int k = 0; k < 16; ++k) {
          const unsigned e = __builtin_amdgcn_ubfe(k < 8 ? pw0[(k >> 1) & 3] : pw1[(k >> 1) & 3], 16 * (k & 1), 16);
          ua[k] = *(const u32x4*)(tbs + ((e << 7) | loff));
        }
        asm volatile("" ::: "memory");
      };
      auto do_tok = [&](const u32x4 (&ua)[16], int tt) {
        const size_t tok = tokb + tt;
        const u32x4 xh = *(const u32x4*)(stg + 4096 + 128 * tt + loff);
        int v[16];
#pragma unroll
        for (int k = 0; k < 16; ++k) {
          int ah = 0;
#pragma unroll
          for (int q = 0; q < 4; ++q) ah = __builtin_amdgcn_sdot4((int)ua[k][q], (int)xh[q], ah, false);
          v[k] = ah;
        }
        int a8[8], a4[4], a2[2];
        { const bool up = (lane & 4) != 0;
#pragma unroll
          for (int k = 0; k < 8; ++k) { const int keep = up ? v[8 + k] : v[k]; const int send = up ? v[k] : v[8 + k]; a8[k] = keep + dpp_i<DPP_HALF_MIRROR>(send); } }
        { const bool up = (lane & 2) != 0;
#pragma unroll
          for (int k = 0; k < 4; ++k) { const int keep = up ? a8[4 + k] : a8[k]; const int send = up ? a8[k] : a8[4 + k]; a4[k] = keep + dpp_i<DPP_XOR2>(send); } }
        { const bool up = (lane & 1) != 0;
#pragma unroll
          for (int k = 0; k < 2; ++k) { const int keep = up ? a4[2 + k] : a4[k]; const int send = up ? a4[k] : a4[2 + k]; a2[k] = keep + dpp_i<DPP_XOR1>(send); } }
        const float sc = 1.0f / 32768.f;
        f16x2_t o2 = {(_Float16)((float)a2[0] * sc), (_Float16)((float)a2[1] * sc)};
        *(f16x2_t*)(pre + tok * 128) = o2;
      };
      {
        u32x4 uaA[16], uaB[16];
        ld_tok(uaA, 0);
#pragma unroll 1
        for (int tt = 0; tt < PCHUNK; tt += 2) {
          ld_tok(uaB, tt + 1);
          do_tok(uaA, tt);
          if (tt + 2 < PCHUNK) ld_tok(uaA, tt + 2);
          do_tok(uaB, tt + 1);
        }
      }
      __builtin_amdgcn_wave_barrier();
    }
  }
}
DI void phase5(const MP& p) {
  const long gtid = (long)blockIdx.x * NTHR + threadIdx.x;
  const long gsz = (long)gridDim.x * NTHR;
#pragma unroll 1
  for (long u = gtid; u < (long)NTOK * 32; u += gsz) {
    const long tok = u >> 5; const int q4 = (int)(u & 31) * 4;
    float4 s = make_float4(0.f, 0.f, 0.f, 0.f);
#pragma unroll
    for (int sl = 0; sl < 8; ++sl) {
      const u32x2 v = *(const u32x2*)((const _Float16*)p.PRE + ((size_t)sl * NTOK + tok) * 128 + q4);
      const f16x2_t v01 = as_h2(v[0]), v23 = as_h2(v[1]);
      s.x += (float)v01[0]; s.y += (float)v01[1]; s.z += (float)v23[0]; s.w += (float)v23[1];
    }
    const float ri = p.RINV2[tok];
    u32x4 pw = *(const u32x4*)(p.PAIRS + tok * 128 + q4);
    float4 a;
    a.x = gelu_f(s.x * ri) * bflo(pw[0]) * 16.f; a.y = gelu_f(s.y * ri) * bflo(pw[1]) * 16.f;
    a.z = gelu_f(s.z * ri) * bflo(pw[2]) * 16.f; a.w = gelu_f(s.w * ri) * bflo(pw[3]) * 16.f;
    int hw = __builtin_amdgcn_cvt_pk_fp8_f32(a.x, a.y, 0, false);
    hw = __builtin_amdgcn_cvt_pk_fp8_f32(a.z, a.w, hw, true);
    *(int*)(p.ACTH + tok * 128 + q4) = hw;
  }
}
typedef int i32x8 __attribute__((ext_vector_type(8)));
struct V6Ctx {
  int lane, g, i, n, kq, bq, sc, tc, rg; bool valid; unsigned loff; unsigned sel[4]; int aoff;
};
DI void v6_load(const V6Ctx& c, u32x4 (&va)[16], u32x4& aw, unsigned*& xrow, const MP& p, const char* stg, const unsigned char* tbs, size_t tok, int tt, int slice) {
  aw = *(const u32x4*)(stg + c.aoff + 128 * tt);
  const u32x4 pw0 = *(const u32x4*)(stg + 256 * tt + 32 * c.g), pw1 = *(const u32x4*)(stg + 256 * tt + 32 * c.g + 16);
#pragma unroll
  for (int k = 0; k < 16; ++k) { const unsigned e = __builtin_amdgcn_ubfe(k < 8 ? pw0[(k >> 1) & 3] : pw1[(k >> 1) & 3], 16 * (k & 1), 16); va[k] = *(const u32x4*)(tbs + ((e << 7) | c.loff)); }
  xrow = (unsigned*)(p.OUTB + tok * 1024 + 128 * slice) + c.lane;
}
DI void v6_mma(const V6Ctx& c, const u32x4 (&va)[16], const u32x4 aw, float* red) {
  i32x8 B0, B1;
#pragma unroll
  for (int r = 0; r < 8; ++r) {
    B0[r] = (int)__builtin_amdgcn_perm(0u, aw[r >> 2], c.sel[r & 3]);
    B1[r] = (int)__builtin_amdgcn_perm(0u, aw[2 + (r >> 2)], c.sel[r & 3]);
  }
  float* dst = c.valid ? (red + (c.tc * 2 + c.sc) * 128 + 64 * (c.rg & 1) + c.bq) : (red + 512 + c.lane);
  const int st = c.valid ? 1 : 0;
#pragma unroll
  for (int q = 0; q < 4; ++q) {
    i32x8 A0, A1;
#pragma unroll
    for (int r = 0; r < 8; ++r) { A0[r] = (int)va[r][q]; A1[r] = (int)va[8 + r][q]; }
    f32x4 z = {0.f, 0.f, 0.f, 0.f};
    z = __builtin_amdgcn_mfma_scale_f32_16x16x128_f8f6f4(A0, B0, z, 0, 0, 0, 0x7f7f7f7f, 0, 0x7f7f7f7f);
    z = __builtin_amdgcn_mfma_scale_f32_16x16x128_f8f6f4(A1, B1, z, 0, 0, 0, 0x7f7f7f7f, 0, 0x7f7f7f7f);
#pragma unroll
    for (int r = 0; r < 4; ++r) {
      float v = z[r];
      asm volatile("" : "+v"(v));
      dst[st * (16 * r + 4 * q)] = v;
    }
  }
}
DI void v6_fin(const V6Ctx& c, const float* red, unsigned* xrow) {
  const f32x2_t h0 = *(const f32x2_t*)(red + 0 * 128 + 2 * c.lane), h1 = *(const f32x2_t*)(red + 1 * 128 + 2 * c.lane);
  const float o0 = (h0[0] + h1[0]) * (1.0f / 64.f);
  const float o1 = (h0[1] + h1[1]) * (1.0f / 64.f);
  *xrow = cvtpk(o0, o1);
}
DI void phase6(const MP& p, char* smem) {
  V6Ctx c;
  const int tid6 = opq((int)threadIdx.x);
  c.lane = tid6 & 63;
  const int w = __builtin_amdgcn_readfirstlane(tid6 >> 6);
  c.g = c.lane >> 3; c.i = c.lane & 7; c.n = c.lane & 15; c.kq = c.lane >> 4; c.bq = c.n & 3; c.sc = (c.n >> 2) & 1; c.tc = c.n >> 3; c.rg = c.kq;
  c.loff = 16u * (unsigned)c.i;
  c.valid = ((c.rg >> 1) == c.sc);
#pragma unroll
  for (int j = 0; j < 4; ++j) c.sel[j] = (0x0c0c0c0cu & ~(0xffu << (8 * c.bq))) | ((unsigned)j << (8 * c.bq));
  c.aoff = 4096 + 2048 * c.tc + 16 * (2 * c.kq + c.sc);
  const unsigned xcc = xb_xcc_id() & 7u;
  float* redA = (float*)(smem + w * 4608);
  float* redB = redA + 576;
  char* stg = smem + 8 * 4608 + w * 8192;
#pragma unroll 1
  for (int s = 0; s < 8; ++s) {
    const int slice = (int)((xcc + s) & 7u);
    unsigned* ctr = p.CTR + (size_t)(8 + slice) * 64;
    const unsigned char* tbs = p.EV + (size_t)slice * 16384 * 128;
#pragma unroll 1
    for (;;) {
      unsigned cc = 0;
      if (c.lane == 0) cc = atomicAdd(ctr, 1u);
      cc = (unsigned)__builtin_amdgcn_readfirstlane((int)cc);
      if (cc >= NPCHUNK) break;
      const size_t tokb = (size_t)cc * PCHUNK;
      {
        const u32x4* ep = (const u32x4*)(p.E16 + tokb * 128) + c.lane;
        u32x4 ev[4], ah[2];
#pragma unroll
        for (int j = 0; j < 4; ++j) ev[j] = ep[64 * j];
#pragma unroll
        for (int j = 0; j < 2; ++j) ah[j] = ((const u32x4*)(p.ACTH + tokb * 128))[64 * j + c.lane];
        __builtin_amdgcn_wave_barrier();
#pragma unroll
        for (int j = 0; j < 4; ++j) *(u32x4*)(stg + 1024 * j + 16 * c.lane) = ev[j];
#pragma unroll
        for (int j = 0; j < 2; ++j) *(u32x4*)(stg + 4096 + 1024 * j + 16 * c.lane) = ah[j];
        __builtin_amdgcn_wave_barrier();
      }
#pragma unroll 1
      for (int tt = 0; tt < PCHUNK; tt += 2) {
        u32x4 vaA[16], vaB[16], awA, awB; unsigned *rowA, *rowB;
        v6_load(c, vaA, awA, rowA, p, stg, tbs, tokb + tt, tt, slice);
        v6_load(c, vaB, awB, rowB, p, stg, tbs, tokb + tt + 1, tt + 1, slice);
        v6_mma(c, vaA, awA, redA);
        v6_mma(c, vaB, awB, redB);
        __builtin_amdgcn_wave_barrier();
        v6_fin(c, redA, rowA);
        v6_fin(c, redB, rowB);
        __builtin_amdgcn_wave_barrier();
      }
    }
  }
}
DI void phase7(const MP& p) {
  const int lane = threadIdx.x & 63;
  const int gw = blockIdx.x * (NTHR / 64) + (threadIdx.x >> 6), nw = gridDim.x * (NTHR / 64);
  const float4* fp = (const float4*)p.fg + 4 * lane;
  float4 f[4];
#pragma unroll
  for (int q = 0; q < 4; ++q) f[q] = fp[q];
#pragma unroll 2
  for (int tok = gw; tok < NTOK; tok += nw) {
    const u32x4* xp = (const u32x4*)(p.X2B + (size_t)tok * 1024) + 2 * lane;
    const u32x4* op_ = (const u32x4*)(p.OUTB + (size_t)tok * 1024) + 2 * lane;
    const u32x4 a = xp[0], b = xp[1], oa = op_[0], ob = op_[1];
    float v[16];
#pragma unroll
    for (int q = 0; q < 4; ++q) {
      v[2 * q] = bflo(a[q]) + bflo(oa[q]); v[2 * q + 1] = bfhi(a[q]) + bfhi(oa[q]);
      v[8 + 2 * q] = bflo(b[q]) + bflo(ob[q]); v[8 + 2 * q + 1] = bfhi(b[q]) + bfhi(ob[q]);
    }
    float s = 0.f;
#pragma unroll
    for (int q = 0; q < 16; ++q) s = fmaf(v[q], v[q], s);
    for (int m = 32; m >= 1; m >>= 1) s += __shfl_xor(s, m, 64);
    const float r3 = rsqrtf(s * (1.0f / 1024.f) + 1e-6f);
    float4* op = (float4*)(p.out + (size_t)tok * 1024) + 4 * lane;
#pragma unroll
    for (int q = 0; q < 4; ++q)
      op[q] = make_float4(v[4 * q] * r3 * f[q].x, v[4 * q + 1] * r3 * f[q].y, v[4 * q + 2] * r3 * f[q].z, v[4 * q + 3] * r3 * f[q].w);
  }
}

#define SMEM_BYTES (ATILE_BYTES + 64 * 4 + 8 * 64 * 4 + SK_STASH * 512 * 4)
__global__ void __launch_bounds__(NTHR) k_mega(MP p) {
  __shared__ __attribute__((aligned(16))) char smem[SMEM_BYTES];
  __shared__ uint4 xb_words;
  if (threadIdx.x == 0) xb_words = make_uint4(0u, 0u, 0u, 0u);
  __syncthreads();
  XcdBarrier gb = xcd_barrier_post(p.bar, (volatile LAS unsigned*)&xb_words);
  phase0(p, smem);
  xcd_barrier(gb);
  phase1(p, smem);
  xcd_barrier(gb);
  phase2(p, smem);
  xcd_barrier(gb);
  phase3(p, smem);
  xcd_barrier(gb);
  phase4(p, smem);
  xcd_barrier(gb);
  phase5(p);
  xcd_barrier(gb);
  phase6(p, smem);
  xcd_barrier(gb);
  phase7(p);
}

extern "C" void kernel_launch(void* const* d_in, const int* in_sizes, int n_in, void* d_out, int out_size, void* d_ws, size_t ws_size,
                              hipStream_t stream) {
  float* out = (float*)d_out;
  char* arena1 = (char*)d_ws;
  size_t o1 = 0;
  auto A1 = [&](size_t bytes) { void* r = arena1 + o1; o1 += (bytes + 255) & ~(size_t)255; return r; };
  MP p;
  memset(&p, 0, sizeof(p));
  p.x = (const float*)d_in[0]; p.g1 = (const float*)d_in[1]; p.w_in = (const float*)d_in[2]; p.a_re = (const float*)d_in[3];
  p.a_im = (const float*)d_in[4]; p.log_step = (const float*)d_in[5]; p.b_re = (const float*)d_in[6]; p.b_im = (const float*)d_in[7];
  p.c_re = (const float*)d_in[8]; p.c_im = (const float*)d_in[9]; p.ssm_d = (const float*)d_in[10]; p.w_glu = (const float*)d_in[11];
  p.w_f = (const float*)d_in[12]; p.w_out = (const float*)d_in[13]; p.g2 = (const float*)d_in[14]; p.w_q = (const float*)d_in[15];
  p.keys = (const float*)d_in[16]; p.eu = (const float*)d_in[17]; p.ev = (const float*)d_in[18]; p.fg = (const float*)d_in[19];
  p.out = out;
  p.U = (unsigned short*)A1((size_t)NTOK * 512 * 2);
  p.T = (unsigned short*)A1((size_t)NTOK * 1024 * 2);
  p.YF = (unsigned short*)A1((size_t)NTOK * 512 * 2);
  p.YB = (unsigned short*)A1((size_t)NTOK * 512 * 2);
  p.PAIRS = (unsigned*)A1((size_t)NTOK * 128 * 4);
  p.E16 = (unsigned short*)A1((size_t)NTOK * 128 * 2);
  p.EU = (unsigned char*)A1((size_t)16384 * 1024);
  p.EV = (unsigned char*)A1((size_t)16384 * 1024);
  p.WinF = (bf16x8*)A1((size_t)1024 * 1536 * 2);
  p.WgluF = (bf16x8*)A1((size_t)512 * 512 * 2);
  p.WoutF = (bf16x8*)A1((size_t)1024 * 1024 * 2);
  p.WqkF = (bf16x8*)A1((size_t)1024 * 2048 * 2);
  p.M1F = (bf16x8*)A1((size_t)128 * 128 * 2);
  p.M3T = (unsigned short*)A1((size_t)4096 * 128 * 2);
  p.s5lam = (float*)A1((size_t)64 * 64 * 2 * 4);
  p.s5B = (bf16x8*)A1((size_t)64 * 4 * 64 * 16);
  p.s5C = (bf16x8*)A1((size_t)64 * 4 * 64 * 16);
  p.bar = (unsigned*)A1((size_t)XCD_BAR_WORDS * 4);
  p.CTR = (unsigned*)A1((size_t)16 * 64 * 4);
  (void)hipMemsetAsync(p.bar, 0, (size_t)((char*)(p.CTR + 16 * 64) - (char*)p.bar), stream);
  p.RINV2 = (float*)A1((size_t)NTOK * 4);
  p.OUTB = (unsigned short*)A1((size_t)NTOK * 1024 * 2);
  p.X2B = (unsigned short*)A1((size_t)NTOK * 1024 * 2);
  p.ACTH = (unsigned char*)A1((size_t)NTOK * 128);
  p.ACTL = (unsigned char*)A1((size_t)NTOK * 128);
  p.X8H = (unsigned char*)A1((size_t)NTOK * 1024);
  p.X8L = (unsigned char*)A1((size_t)NTOK * 1024);
  p.PRE = (float*)A1((size_t)8 * NTOK * 128 * 2);
  static int grid_blocks = 0;
  if (!grid_blocks) {
    int dev = 0, cus = 0, per_cu = 0;
    (void)hipGetDevice(&dev);
    (void)hipDeviceGetAttribute(&cus, hipDeviceAttributeMultiprocessorCount, dev);
    (void)hipOccupancyMaxActiveBlocksPerMultiprocessor(&per_cu, k_mega, NTHR, 0);
    if (per_cu < 1) per_cu = 1;
    if (per_cu > 1) per_cu = 1;
    grid_blocks = cus * per_cu;
  }
  void* args[] = {&p};
  hipError_t e = hipLaunchCooperativeKernel((void*)k_mega, dim3(grid_blocks), dim3(NTHR), args, 0, stream);
  if (e != hipSuccess) fprintf(stderr, "cooperative launch failed: %s (grid %d)\n", hipGetErrorString(e), grid_blocks);
}
```
